# Optimizing an MI355X kernel written in HIP

```python
import math
import jax, jax.numpy as jnp
from jax import lax
import numpy as np

D_MODEL = 1024
BATCH = 16
SEQ = 2048
DEPTH = 2

N_A_LAYERS = DEPTH // 2
N_B_LAYERS = DEPTH - N_A_LAYERS

RET_HEADS = 4
RET_QK_DIM = D_MODEL // RET_HEADS
RET_V_DIM = 2 * RET_QK_DIM
RET_CHUNK = 128
ROPE_BASE = 10000.0

DIL_WINDOWS = (128, 512, 2048)
DIL_RATES = (1, 4, 16)
N_GROUPS = 3
DIL_HEADS = 16
DIL_HEAD_DIM = D_MODEL // DIL_HEADS
SUB_BLOCK = 128

NUM_BUCKETS = 32
MAX_DISTANCE = 2048

MOE_GROUPS = 4
EXPERTS_PER_GROUP = 8
N_EXPERTS = MOE_GROUPS * EXPERTS_PER_GROUP
TOP_K_INNER = 2
EXPERT_FF = D_MODEL // 2
MOE_BLOCK = 256

EPS = 1e-6
NEG_INF = -1e30

kernel_name = "yoco_retention_dilated_hmoe"


def rmsnorm(x, g):
    xf = x.astype(jnp.float32)
    y = xf * lax.rsqrt(jnp.mean(xf * xf, axis=-1, keepdims=True) + EPS)
    return (y * g.astype(jnp.float32)).astype(x.dtype)


def head_rmsnorm(t, g):
    tf = t.astype(jnp.float32)
    y = tf * lax.rsqrt(jnp.mean(tf * tf, axis=-1, keepdims=True) + EPS)
    return (y * g.astype(jnp.float32)).astype(t.dtype)


def rotary(t, pos):
    half = t.shape[-1] // 2
    inv = 1.0 / (ROPE_BASE ** jnp.linspace(0.0, 1.0, half, dtype=jnp.float32))
    ang = pos[:, None] * inv[None, :]
    cos = jnp.cos(ang)[None, :, None, :]
    sin = jnp.sin(ang)[None, :, None, :]
    tf = t.astype(jnp.float32)
    t1, t2 = tf[..., :half], tf[..., half:]
    return jnp.concatenate([t1 * cos - t2 * sin, t1 * sin + t2 * cos], axis=-1).astype(t.dtype)


def retention(xn, w_in, w_out):
    B, S, D = xn.shape
    H, dk, dv, C = RET_HEADS, RET_QK_DIM, RET_V_DIM, RET_CHUNK
    nC = S // C
    proj = xn @ w_in
    q, k, v, gate = jnp.split(proj, [H * dk, 2 * H * dk, 2 * H * dk + H * dv], axis=-1)
    pos = jnp.arange(S, dtype=jnp.float32)
    q = rotary(q.reshape(B, S, H, dk), pos)
    k = rotary(k.reshape(B, S, H, dk), pos) * (dk ** -0.5)
    v = v.reshape(B, S, H, dv)

    log_g = jnp.log(1.0 - 2.0 ** (-5.0 - jnp.arange(H, dtype=jnp.float32)))
    idx = jnp.arange(C, dtype=jnp.float32)
    diff = idx[:, None] - idx[None, :]
    d_in = jnp.where(diff >= 0, jnp.exp(log_g[:, None, None] * jnp.maximum(diff, 0.0)), 0.0)
    xi = jnp.exp(log_g[:, None] * (idx + 1.0))
    zeta = jnp.exp(log_g[:, None] * (C - 1.0 - idx))
    chunk_decay = jnp.exp(log_g * C)

    def chunks(t):
        return t.reshape(B, nC, C, H, -1).transpose(1, 0, 3, 2, 4).astype(jnp.float32)

    def step(state, qkv):
        qc, kc, vc = qkv
        inner = jnp.einsum('bhnm,bhmv->bhnv', jnp.einsum('bhnd,bhmd->bhnm', qc, kc) * d_in, vc)
        cross = jnp.einsum('bhnd,bhdv->bhnv', qc, state) * xi[None, :, :, None]
        state = state * chunk_decay[None, :, None, None] + jnp.einsum(
            'bhmd,bhmv->bhdv', kc * zeta[None, :, :, None], vc)
        return state, inner + cross

    state0 = jnp.zeros((B, H, dk, dv), jnp.float32)
    _, o = lax.scan(step, state0, (chunks(q), chunks(k), chunks(v)))
    o = o.transpose(1, 0, 3, 2, 4).reshape(B, S, H, dv)
    o = o * lax.rsqrt(jnp.mean(o * o, axis=-1, keepdims=True) + EPS)
    y = jax.nn.silu(gate.astype(jnp.float32)) * o.reshape(B, S, H * dv)
    return y.astype(xn.dtype) @ w_out


def t5_bucket(n):
    max_exact = NUM_BUCKETS // 2
    nf = jnp.maximum(n, max_exact).astype(jnp.float32)
    large = max_exact + (jnp.log(nf / max_exact) / math.log(MAX_DISTANCE / max_exact)
                         * (NUM_BUCKETS - max_exact)).astype(jnp.int32)
    large = jnp.minimum(large, NUM_BUCKETS - 1)
    return jnp.where(n < max_exact, n, large)


def dilated_group(q, k, v, bias_table, rate, n_steps):
    B, S, H, dh = q.shape
    Bk = SUB_BLOCK
    L = S // rate
    nb = -(-L // Bk)
    Lp = nb * Bk

    def to_blocks(t):
        t = t.reshape(B, L, rate, H, dh).transpose(0, 2, 1, 3, 4)
        t = jnp.pad(t, ((0, 0), (0, 0), (0, Lp - L), (0, 0), (0, 0)))
        return t.reshape(B, rate, nb, Bk, H, dh)

    def with_prev(t):
        prev = jnp.pad(t[:, :, :-1], ((0, 0), (0, 0), (1, 0), (0, 0), (0, 0), (0, 0)))
        return jnp.concatenate([prev, t], axis=3)

    qb = to_blocks(q)
    kk = with_prev(to_blocks(k))
    vv = with_prev(to_blocks(v))

    ql = jnp.arange(Bk, dtype=jnp.int32)[:, None]
    kl = jnp.arange(2 * Bk, dtype=jnp.int32)[None, :]
    steps = ql + Bk - kl
    bucket = t5_bucket(jnp.maximum(steps, 0) * rate)
    bias = bias_table[bucket].transpose(2, 0, 1).astype(jnp.float32)
    band = (steps >= 0) & (steps <= n_steps)
    first = (jnp.arange(nb) == 0)[:, None, None]
    valid = band[None] & ~(first & (kl < Bk)[None])

    s = jnp.einsum('brnqhd,brnkhd->brnhqk', qb, kk,
                   preferred_element_type=jnp.float32) * (dh ** -0.5) + bias[None, None, None]
    s = jnp.where(valid[None, None, :, None], s, NEG_INF)
    m = jnp.max(s, axis=-1)
    p = jnp.exp(s - m[..., None])
    l = jnp.sum(p, axis=-1)
    o = jnp.einsum('brnhqk,brnkhd->brnqhd', p, vv.astype(jnp.float32))

    def from_blocks(t):
        t = t.reshape((B, rate, Lp) + t.shape[4:])[:, :, :L]
        return jnp.moveaxis(t, 1, 2).reshape((B, S) + t.shape[3:])

    return (from_blocks(o), from_blocks(jnp.swapaxes(m, 3, 4)),
            from_blocks(jnp.swapaxes(l, 3, 4)))


def shared_kv(h, kv_norm, w_kv, k_norm):
    B, S, _ = h.shape
    kv = (rmsnorm(h, kv_norm) @ w_kv).reshape(B, S, 2, N_GROUPS, DIL_HEADS, DIL_HEAD_DIM)
    k = head_rmsnorm(kv[:, :, 0], k_norm[:, None, :])
    return k, kv[:, :, 1]


def dilated_attention(xn, k, v, w_q, q_norm, w_o, rel_bias):
    B, S, _ = xn.shape
    H, dh = DIL_HEADS, DIL_HEAD_DIM
    q = head_rmsnorm((xn @ w_q).reshape(B, S, N_GROUPS, H, dh), q_norm[:, None, :])
    outs, maxs, dens = [], [], []
    for g in range(N_GROUPS):
        o_g, m_g, l_g = dilated_group(q[:, :, g], k[:, :, g], v[:, :, g],
                                      rel_bias[:, g * H:(g + 1) * H],
                                      DIL_RATES[g], DIL_WINDOWS[g] // DIL_RATES[g])
        outs.append(o_g); maxs.append(m_g); dens.append(l_g)
    ms = jnp.stack(maxs)
    w = jnp.exp(ms - jnp.max(ms, axis=0, keepdims=True))
    num = jnp.sum(w[..., None] * jnp.stack(outs), axis=0)
    den = jnp.sum(w * jnp.stack(dens), axis=0)
    out = (num / den[..., None]).reshape(B, S, H * dh).astype(xn.dtype)
    return out @ w_o


def hier_moe(xt, w_grp, b_grp, w_exp, b_exp, w_gate, w_up, w_down):
    T, D = xt.shape
    grp_logits = (xt @ w_grp).astype(jnp.float32) + b_grp.astype(jnp.float32)
    grp = jnp.argmax(grp_logits, axis=-1)
    p_grp = jnp.take_along_axis(jax.nn.softmax(grp_logits, axis=-1), grp[:, None], axis=1)[:, 0]
    exp_logits = ((xt @ w_exp).astype(jnp.float32) + b_exp.astype(jnp.float32)).reshape(
        T, MOE_GROUPS, EXPERTS_PER_GROUP)
    in_grp = jnp.take_along_axis(exp_logits, grp[:, None, None], axis=1)[:, 0]
    top_v, top_i = lax.top_k(in_grp, TOP_K_INNER)
    gate = jax.nn.softmax(top_v, axis=-1) * p_grp[:, None]

    A = T * TOP_K_INNER
    eid = (grp[:, None] * EXPERTS_PER_GROUP + top_i).reshape(-1).astype(jnp.int32)
    tok = jnp.repeat(jnp.arange(T, dtype=jnp.int32), TOP_K_INNER)
    gw = gate.reshape(-1)
    order = jnp.argsort(eid)
    se = eid[order]
    counts = jnp.bincount(eid, length=N_EXPERTS).astype(jnp.int32)
    starts = jnp.cumsum(counts) - counts
    padded = (counts + MOE_BLOCK - 1) // MOE_BLOCK * MOE_BLOCK
    pends = jnp.cumsum(padded)
    pstarts = pends - padded
    dest = pstarts[se] + jnp.arange(A, dtype=jnp.int32) - starts[se]
    nblk = -(-A // MOE_BLOCK) + N_EXPERTS
    P = nblk * MOE_BLOCK
    rows_tok = jnp.full((P,), T, jnp.int32).at[dest].set(tok[order])
    rows_gate = jnp.zeros((P,), jnp.float32).at[dest].set(gw[order])
    blk_exp = jnp.minimum(jnp.searchsorted(pends, jnp.arange(nblk, dtype=jnp.int32) * MOE_BLOCK,
                                           side='right'), N_EXPERTS - 1)
    x_pad = jnp.concatenate([xt, jnp.zeros((1, D), xt.dtype)], axis=0)
    xb = x_pad[rows_tok].reshape(nblk, MOE_BLOCK, D)

    def expert_block(args):
        xk, e = args
        hid = jax.nn.silu(xk @ w_gate[e]) * (xk @ w_up[e])
        return hid @ w_down[e]

    yb = lax.map(expert_block, (xb, blk_exp)).reshape(P, D)
    y = jax.ops.segment_sum(yb * rows_gate[:, None].astype(yb.dtype), rows_tok,
                            num_segments=T + 1)
    return y[:T]


def setup_inputs(seed: int = 0) -> dict:
    key = jax.random.key(seed)
    ks = jax.random.split(key, 24)
    D = D_MODEL
    f32 = jnp.float32

    def w(k, shape, fan_in):
        return jax.random.normal(k, shape, f32) * (fan_in ** -0.5)

    def gain(k, shape):
        return 1.0 + 0.02 * jax.random.normal(k, shape, f32)

    ret_in_cols = 2 * RET_HEADS * RET_QK_DIM + 2 * RET_HEADS * RET_V_DIM
    q_cols = N_GROUPS * DIL_HEADS * DIL_HEAD_DIM
    return {
        "x": jax.random.normal(ks[0], (BATCH, SEQ, D), f32),
        "ret_w_in": w(ks[1], (N_A_LAYERS, D, ret_in_cols), D),
        "ret_w_out": w(ks[2], (N_A_LAYERS, RET_HEADS * RET_V_DIM, D), RET_HEADS * RET_V_DIM),
        "kv_norm": gain(ks[3], (D,)),
        "w_kv": w(ks[4], (D, 2 * q_cols), D),
        "k_norm": gain(ks[5], (N_GROUPS, DIL_HEAD_DIM)),
        "dil_wq": w(ks[6], (N_B_LAYERS, D, q_cols), D),
        "q_norm": gain(ks[7], (N_B_LAYERS, N_GROUPS, DIL_HEAD_DIM)),
        "dil_wo": w(ks[8], (N_B_LAYERS, DIL_HEADS * DIL_HEAD_DIM, D), DIL_HEADS * DIL_HEAD_DIM),
        "rel_bias": 0.2 * jax.random.normal(ks[9], (NUM_BUCKETS, N_GROUPS * DIL_HEADS), f32),
        "mixer_norm": gain(ks[10], (DEPTH, D)),
        "ffn_norm": gain(ks[11], (DEPTH, D)),
        "router_grp": w(ks[12], (DEPTH, D, MOE_GROUPS), D),
        "router_grp_b": 0.01 * jax.random.normal(ks[13], (DEPTH, MOE_GROUPS), f32),
        "router_exp": w(ks[14], (DEPTH, D, N_EXPERTS), D),
        "router_exp_b": 0.01 * jax.random.normal(ks[15], (DEPTH, N_EXPERTS), f32),
        "exp_gate": w(ks[16], (DEPTH, N_EXPERTS, D, EXPERT_FF), D),
        "exp_up": w(ks[17], (DEPTH, N_EXPERTS, D, EXPERT_FF), D),
        "exp_down": w(ks[18], (DEPTH, N_EXPERTS, EXPERT_FF, D), EXPERT_FF),
    }


def reference(x, ret_w_in, ret_w_out, kv_norm, w_kv, k_norm, dil_wq, q_norm, dil_wo, rel_bias,
              mixer_norm, ffn_norm, router_grp, router_grp_b, router_exp, router_exp_b,
              exp_gate, exp_up, exp_down):
    B, S, D = x.shape
    h = x
    k_sh, v_sh = None, None
    for layer in range(DEPTH):
        xn = rmsnorm(h, mixer_norm[layer])
        if layer < N_A_LAYERS:
            mix = retention(xn, ret_w_in[layer], ret_w_out[layer])
        else:
            j = layer - N_A_LAYERS
            if j == 0:
                k_sh, v_sh = shared_kv(h, kv_norm, w_kv, k_norm)
            mix = dilated_attention(xn, k_sh, v_sh, dil_wq[j], q_norm[j], dil_wo[j], rel_bias)
        h = h + mix
        hn = rmsnorm(h, ffn_norm[layer]).reshape(B * S, D)
        h = h + hier_moe(hn, router_grp[layer], router_grp_b[layer], router_exp[layer],
                         router_exp_b[layer], exp_gate[layer], exp_up[layer],
                         exp_down[layer]).reshape(B, S, D)
    return h
```

```cpp
#include <hip/hip_runtime.h>
#include <cstdio>
#include <cstdint>

namespace nv {
constexpr int D = 1024, NB = 16, S = 2048, T = NB * S;
constexpr int CHB = 4, CT = CHB * S;
constexpr int NEXP = 32, FF = 512, MB = 256, NBLK = 2 * T / MB + NEXP, P = NBLK * MB;
constexpr size_t MiB = 1u << 20;

__device__ __forceinline__ float wave_sum(float v) {
#pragma unroll
    for (int o = 1; o < 64; o <<= 1) v += __shfl_xor(v, o);
    return v;
}
__device__ __forceinline__ float wave_max(float v) {
#pragma unroll
    for (int o = 1; o < 64; o <<= 1) v = fmaxf(v, __shfl_xor(v, o));
    return v;
}
__device__ __forceinline__ float silu(float x) { return x / (1.0f + __expf(-x)); }

__global__ void k_rmsnorm(const float* __restrict__ x, const float* __restrict__ g, float* __restrict__ out, int rows) {
    const int w = blockIdx.x * 4 + (threadIdx.x >> 6), lane = threadIdx.x & 63;
    if (w >= rows) return;
    const float4* xr = (const float4*)(x + (size_t)w * D);
    float4 v[4]; float s = 0.f;
#pragma unroll
    for (int j = 0; j < 4; ++j) { v[j] = xr[lane + 64 * j]; s += v[j].x * v[j].x + v[j].y * v[j].y + v[j].z * v[j].z + v[j].w * v[j].w; }
    const float rs = rsqrtf(wave_sum(s) * (1.0f / D) + 1e-6f);
    float4* o = (float4*)(out + (size_t)w * D);
#pragma unroll
    for (int j = 0; j < 4; ++j) { const float4 gg = ((const float4*)g)[lane + 64 * j]; float4 r; r.x = v[j].x * rs * gg.x; r.y = v[j].y * rs * gg.y; r.z = v[j].z * rs * gg.z; r.w = v[j].w * rs * gg.w; o[lane + 64 * j] = r; }
}

struct GemmP {
    const float* A; int lda; const int* arow;
    const float* B; int ldb; long long strideB; const int* blk_exp;
    float* C; int ldc;
    int M, N, K, mode;
    const float* R; int ldr;
    const float* rgate; float* Y;
};
__global__ void __launch_bounds__(256) k_gemm(GemmP p) {
    __shared__ float As[16][68], Bs[16][68];
    const int tid = threadIdx.x, tx = tid & 15, ty = tid >> 4;
    const int m0 = blockIdx.y * 64, n0 = blockIdx.x * 64;
    if (p.arow && p.mode != 3 && p.arow[m0] >= T) return;
    if (p.mode == 3 && p.arow[m0] >= T) return;
    const float* Bm = p.B + (p.blk_exp ? (long long)p.blk_exp[m0 / MB] * p.strideB : 0ll);
    const int ar = tid >> 2, ak = (tid & 3) * 4;
    const float* arowp;
    bool azero = false;
    if (p.arow && p.mode != 3) { const int idx = p.arow[m0 + ar]; azero = idx >= T; arowp = p.A + (size_t)(azero ? 0 : idx) * p.lda; }
    else arowp = p.A + (size_t)(m0 + ar) * p.lda;
    const int bk = tid >> 4, bn = (tid & 15) * 4;
    float acc[4][4];
#pragma unroll
    for (int i = 0; i < 4; ++i)
#pragma unroll
        for (int j = 0; j < 4; ++j) acc[i][j] = 0.f;
    for (int k0 = 0; k0 < p.K; k0 += 16) {
        float4 av = azero ? make_float4(0.f, 0.f, 0.f, 0.f) : *(const float4*)(arowp + k0 + ak);
        const float4 bv = *(const float4*)(Bm + (size_t)(k0 + bk) * p.ldb + n0 + bn);
        __syncthreads();
        As[ak + 0][ar] = av.x; As[ak + 1][ar] = av.y; As[ak + 2][ar] = av.z; As[ak + 3][ar] = av.w;
        *(float4*)&Bs[bk][bn] = bv;
        __syncthreads();
#pragma unroll
        for (int kk = 0; kk < 16; ++kk) {
            const float4 a = *(const float4*)&As[kk][ty * 4];
            const float4 b = *(const float4*)&Bs[kk][tx * 4];
            const float aa[4] = {a.x, a.y, a.z, a.w}, bb[4] = {b.x, b.y, b.z, b.w};
#pragma unroll
            for (int i = 0; i < 4; ++i)
#pragma unroll
                for (int j = 0; j < 4; ++j) acc[i][j] = fmaf(aa[i], bb[j], acc[i][j]);
        }
    }
#pragma unroll
    for (int i = 0; i < 4; ++i) {
        const int r = m0 + ty * 4 + i, c = n0 + tx * 4;
        if (p.mode == 0) { *(float4*)(p.C + (size_t)r * p.ldc + c) = make_float4(acc[i][0], acc[i][1], acc[i][2], acc[i][3]); }
        else if (p.mode == 1) { const float4 rr = *(const float4*)(p.R + (size_t)r * p.ldr + c);
            *(float4*)(p.C + (size_t)r * p.ldc + c) = make_float4(rr.x + acc[i][0], rr.y + acc[i][1], rr.z + acc[i][2], rr.w + acc[i][3]); }
        else if (p.mode == 2) { float4* cp = (float4*)(p.C + (size_t)r * p.ldc + c); const float4 g = *cp;
            *cp = make_float4(silu(g.x) * acc[i][0], silu(g.y) * acc[i][1], silu(g.z) * acc[i][2], silu(g.w) * acc[i][3]); }
        else { const int tok = p.arow[r]; if (tok < T) { const float gt = p.rgate[r]; float* y = p.Y + (size_t)tok * p.ldc + c;
#pragma unroll
                for (int j = 0; j < 4; ++j) atomicAdd(y + j, gt * acc[i][j]); } }
    }
}

__global__ void k_rotary(float* proj, int ntok) {
    const size_t i = (size_t)blockIdx.x * blockDim.x + threadIdx.x;
    if (i >= (size_t)ntok * 2 * 4 * 128) return;
    const int j = i & 127, h = (i >> 7) & 3, part = (i >> 9) & 1; const int tok = (int)(i >> 10);
    const int pos = tok % S;
    const float inv = 1.0f / exp2f((float)j * (13.287712379549449f / 127.0f));
    const float ang = (float)pos * inv;
    const double rev = (double)ang * 0.15915494309189535;
    const float fr = (float)(rev - floor(rev + 0.5)) * 6.283185307179586f;
    const float c = __cosf(fr), s = __sinf(fr);
    float* p1 = proj + (size_t)tok * 6144 + part * 1024 + h * 256 + j;
    const float t1 = p1[0], t2 = p1[128];
    const float sc = part ? 0.0625f : 1.0f;
    p1[0] = (t1 * c - t2 * s) * sc; p1[128] = (t1 * s + t2 * c) * sc;
}

__global__ void __launch_bounds__(256) k_retention(const float* __restrict__ proj, float* __restrict__ o) {
    __shared__ float Qs[32][260], Ks[32][260], Ss[32][33];
    const int qt = blockIdx.x, h = blockIdx.y, b = blockIdx.z, tid = threadIdx.x;
    const float l2g = log2f(1.0f - exp2f(-5.0f - (float)h));
    const float* base = proj + (size_t)b * S * 6144;
    for (int i = tid; i < 32 * 64; i += 256) { const int r = i >> 6, c4 = (i & 63) * 4;
        *(float4*)&Qs[r][c4] = *(const float4*)(base + (size_t)(qt * 32 + r) * 6144 + h * 256 + c4); }
    float acc[32][2];
#pragma unroll
    for (int r = 0; r < 32; ++r) { acc[r][0] = 0.f; acc[r][1] = 0.f; }
    for (int kt = 0; kt <= qt; ++kt) {
        __syncthreads();
        for (int i = tid; i < 32 * 64; i += 256) { const int r = i >> 6, c4 = (i & 63) * 4;
            *(float4*)&Ks[r][c4] = *(const float4*)(base + (size_t)(kt * 32 + r) * 6144 + 1024 + h * 256 + c4); }
        __syncthreads();
        { const int r = tid >> 3, s0 = (tid & 7) * 4; float d[4] = {0.f, 0.f, 0.f, 0.f};
            for (int k = 0; k < 256; k += 4) { const float4 q = *(const float4*)&Qs[r][k];
#pragma unroll
                for (int i = 0; i < 4; ++i) { const float4 kk = *(const float4*)&Ks[s0 + i][k]; d[i] += q.x * kk.x + q.y * kk.y + q.z * kk.z + q.w * kk.w; } }
#pragma unroll
            for (int i = 0; i < 4; ++i) { const int n = qt * 32 + r, m = kt * 32 + s0 + i; Ss[r][s0 + i] = (m <= n) ? d[i] * exp2f(l2g * (float)(n - m)) : 0.f; } }
        __syncthreads();
        for (int s = 0; s < 32; ++s) {
            const float* vp = base + (size_t)(kt * 32 + s) * 6144 + 2048 + h * 512;
            const float v0 = vp[tid], v1 = vp[tid + 256];
#pragma unroll
            for (int r = 0; r < 32; ++r) { const float w = Ss[r][s]; acc[r][0] = fmaf(w, v0, acc[r][0]); acc[r][1] = fmaf(w, v1, acc[r][1]); }
        }
    }
    float* ob = o + (size_t)(b * S + qt * 32) * 2048 + h * 512;
#pragma unroll
    for (int r = 0; r < 32; ++r) { ob[(size_t)r * 2048 + tid] = acc[r][0]; ob[(size_t)r * 2048 + tid + 256] = acc[r][1]; }
}

__global__ void k_gnorm_gate(float* o, const float* __restrict__ proj, int ntok) {
    const int w = blockIdx.x * 4 + (threadIdx.x >> 6), lane = threadIdx.x & 63;
    if (w >= ntok * 4) return;
    const int tok = w >> 2, h = w & 3;
    float4* op = (float4*)(o + (size_t)tok * 2048 + h * 512);
    const float4* gp = (const float4*)(proj + (size_t)tok * 6144 + 4096 + h * 512);
    float4 v[2]; float s = 0.f;
#pragma unroll
    for (int j = 0; j < 2; ++j) { v[j] = op[lane + 64 * j]; s += v[j].x * v[j].x + v[j].y * v[j].y + v[j].z * v[j].z + v[j].w * v[j].w; }
    const float rs = rsqrtf(wave_sum(s) * (1.0f / 512.0f) + 1e-6f);
#pragma unroll
    for (int j = 0; j < 2; ++j) { const float4 g = gp[lane + 64 * j]; float4 r; r.x = silu(g.x) * v[j].x * rs; r.y = silu(g.y) * v[j].y * rs; r.z = silu(g.z) * v[j].z * rs; r.w = silu(g.w) * v[j].w * rs; op[lane + 64 * j] = r; }
}

__global__ void k_headnorm(float* buf, int ld, const float* __restrict__ gn, int ntok) {
    const size_t i = (size_t)blockIdx.x * blockDim.x + threadIdx.x;
    if (i >= (size_t)ntok * 48) return;
    const int tok = (int)(i / 48), hh = (int)(i % 48), g = hh / 16;
    float4* p = (float4*)(buf + (size_t)tok * ld + hh * 64);
    float4 v[16]; float s = 0.f;
#pragma unroll
    for (int j = 0; j < 16; ++j) { v[j] = p[j]; s += v[j].x * v[j].x + v[j].y * v[j].y + v[j].z * v[j].z + v[j].w * v[j].w; }
    const float rs = rsqrtf(s * (1.0f / 64.0f) + 1e-6f);
#pragma unroll
    for (int j = 0; j < 16; ++j) { const float4 gg = ((const float4*)(gn + g * 64))[j]; float4 r; r.x = v[j].x * rs * gg.x; r.y = v[j].y * rs * gg.y; r.z = v[j].z * rs * gg.z; r.w = v[j].w * rs * gg.w; p[j] = r; }
}

__device__ __forceinline__ int t5_bucket(int n) {
    if (n < 16) return n;
    int l = 16 + (int)(log2f((float)n * 0.0625f) * (16.0f / 7.0f));
    return l > 31 ? 31 : l;
}
__global__ void __launch_bounds__(256) k_dilattn(const float* __restrict__ q, const float* __restrict__ kv, const float* __restrict__ rel_bias, float* __restrict__ out, int ntok) {
    const int gw = blockIdx.x * 4 + (threadIdx.x >> 6), lane = threadIdx.x & 63;
    if (gw >= ntok * 16) return;
    const int tok = gw >> 4, h = gw & 15, t = tok % S, bbase = tok - t;
    float sc[9];
#pragma unroll
    for (int g = 0; g < 3; ++g) {
        const int rate = g == 0 ? 1 : (g == 1 ? 4 : 16);
        const float4* qp = (const float4*)(q + (size_t)tok * 3072 + g * 1024 + h * 64);
#pragma unroll
        for (int jj = 0; jj < 3; ++jj) {
            const int j = jj * 64 + lane; const int tk = t - j * rate;
            float s = -1e30f;
            if (j <= 128 && tk >= 0) {
                const float4* kp = (const float4*)(kv + (size_t)(bbase + tk) * 6144 + g * 1024 + h * 64);
                float d = 0.f;
#pragma unroll
                for (int e = 0; e < 16; ++e) { const float4 a = qp[e], b = kp[e]; d += a.x * b.x + a.y * b.y + a.z * b.z + a.w * b.w; }
                s = d * 0.125f + rel_bias[t5_bucket(j * rate) * 48 + g * 16 + h];
            }
            sc[g * 3 + jj] = s;
        }
    }
    float m = sc[0];
#pragma unroll
    for (int i = 1; i < 9; ++i) m = fmaxf(m, sc[i]);
    m = wave_max(m);
    float den = 0.f;
#pragma unroll
    for (int i = 0; i < 9; ++i) { sc[i] = (sc[i] > -1e29f) ? __expf(sc[i] - m) : 0.f; den += sc[i]; }
    den = wave_sum(den);
    float od = 0.f;
#pragma unroll
    for (int g = 0; g < 3; ++g) {
        const int rate = g == 0 ? 1 : (g == 1 ? 4 : 16);
#pragma unroll
        for (int jj = 0; jj < 3; ++jj) {
            const float pv = sc[g * 3 + jj];
            for (int l = 0; l < 64; ++l) {
                const int j = jj * 64 + l; const int tk = t - j * rate;
                if (j > 128 || tk < 0) break;
                const float pj = __shfl(pv, l);
                od = fmaf(pj, kv[(size_t)(bbase + tk) * 6144 + 3072 + g * 1024 + h * 64 + lane], od);
            }
        }
    }
    out[(size_t)tok * 1024 + h * 64 + lane] = od / den;
}

__global__ void __launch_bounds__(256) k_router(const float* __restrict__ hn, const float* __restrict__ wg, const float* __restrict__ bg, const float* __restrict__ we, const float* __restrict__ be,
                                                int* __restrict__ eid, float* __restrict__ gwt, int* counts) {
    const int tok = blockIdx.x * 4 + (threadIdx.x >> 6), lane = threadIdx.x & 63;
    if (tok >= T) return;
    float a[36];
#pragma unroll
    for (int i = 0; i < 36; ++i) a[i] = 0.f;
    for (int i = lane; i < D; i += 64) {
        const float x = hn[(size_t)tok * D + i];
        const float4 g4 = *(const float4*)(wg + (size_t)i * 4);
        a[0] = fmaf(x, g4.x, a[0]); a[1] = fmaf(x, g4.y, a[1]); a[2] = fmaf(x, g4.z, a[2]); a[3] = fmaf(x, g4.w, a[3]);
#pragma unroll
        for (int e = 0; e < 8; ++e) { const float4 w4 = *(const float4*)(we + (size_t)i * 32 + e * 4);
            a[4 + e * 4 + 0] = fmaf(x, w4.x, a[4 + e * 4 + 0]); a[4 + e * 4 + 1] = fmaf(x, w4.y, a[4 + e * 4 + 1]); a[4 + e * 4 + 2] = fmaf(x, w4.z, a[4 + e * 4 + 2]); a[4 + e * 4 + 3] = fmaf(x, w4.w, a[4 + e * 4 + 3]); }
    }
#pragma unroll
    for (int i = 0; i < 36; ++i) a[i] = wave_sum(a[i]);
    if (lane == 0) {
        float gl[4];
#pragma unroll
        for (int g = 0; g < 4; ++g) gl[g] = a[g] + bg[g];
        int grp = 0; float gbest = gl[0];
#pragma unroll
        for (int g = 1; g < 4; ++g) if (gl[g] > gbest) { gbest = gl[g]; grp = g; }
        float den = 0.f;
#pragma unroll
        for (int g = 0; g < 4; ++g) den += __expf(gl[g] - gbest);
        const float pg = 1.0f / den;
        float el[8];
#pragma unroll
        for (int e = 0; e < 8; ++e) { float v = 0.f;
#pragma unroll
            for (int g = 0; g < 4; ++g) if (g == grp) v = a[4 + g * 8 + e] + be[g * 8 + e];
            el[e] = v; }
        int i0 = 0; float v0 = el[0];
#pragma unroll
        for (int e = 1; e < 8; ++e) if (el[e] > v0) { v0 = el[e]; i0 = e; }
        int i1 = -1; float v1 = -3.0e38f;
#pragma unroll
        for (int e = 0; e < 8; ++e) if (e != i0 && (i1 < 0 || el[e] > v1)) { v1 = el[e]; i1 = e; }
        const float e1 = __expf(v1 - v0); const float g0 = 1.0f / (1.0f + e1), g1 = e1 / (1.0f + e1);
        eid[2 * tok] = grp * 8 + i0; eid[2 * tok + 1] = grp * 8 + i1;
        gwt[2 * tok] = g0 * pg; gwt[2 * tok + 1] = g1 * pg;
        atomicAdd(&counts[grp * 8 + i0], 1); atomicAdd(&counts[grp * 8 + i1], 1);
    }
}
__global__ void k_plan(const int* counts, int* pstart, int* blk_exp) {
    __shared__ int pends[NEXP];
    if (threadIdx.x == 0) { int run = 0; for (int e = 0; e < NEXP; ++e) { const int padded = (counts[e] + MB - 1) / MB * MB; pstart[e] = run; run += padded; pends[e] = run; } }
    __syncthreads();
    for (int i = threadIdx.x; i < NBLK; i += blockDim.x) { int c = 0; for (int e = 0; e < NEXP; ++e) c += (pends[e] <= i * MB) ? 1 : 0; blk_exp[i] = c < NEXP - 1 ? c : NEXP - 1; }
}
__global__ void k_fill_rows(int* rows_tok, float* rows_gate) { const int i = blockIdx.x * blockDim.x + threadIdx.x; if (i < P) { rows_tok[i] = T; rows_gate[i] = 0.f; } }
__global__ void k_place(const int* __restrict__ eid, const float* __restrict__ gwt, const int* __restrict__ pstart, int* cursor, int* rows_tok, float* rows_gate) {
    const int a = blockIdx.x * blockDim.x + threadIdx.x; if (a >= 2 * T) return;
    const int e = eid[a]; const int pos = pstart[e] + atomicAdd(&cursor[e], 1);
    rows_tok[pos] = a >> 1; rows_gate[pos] = gwt[a];
}
__global__ void k_add(float* h, const float* __restrict__ y, size_t n4) { const size_t i = (size_t)blockIdx.x * blockDim.x + threadIdx.x; if (i < n4) { float4 a = ((float4*)h)[i]; const float4 b = ((const float4*)y)[i]; a.x += b.x; a.y += b.y; a.z += b.z; a.w += b.w; ((float4*)h)[i] = a; } }

static void gemm(hipStream_t st, const GemmP& p) { dim3 g(p.N / 64, p.M / 64); hipLaunchKernelGGL(k_gemm, g, dim3(256), 0, st, p); }
}

extern "C" void kernel_launch(void* const* d_in, const int* in_sizes, int n_in, void* d_out, int out_size, void* d_ws, size_t ws_size, hipStream_t stream) {
    using namespace nv;
    if (ws_size < 452 * MiB) return;
    const float* x = (const float*)d_in[0]; const float* ret_w_in = (const float*)d_in[1]; const float* ret_w_out = (const float*)d_in[2];
    const float* kv_norm = (const float*)d_in[3]; const float* w_kv = (const float*)d_in[4]; const float* k_norm = (const float*)d_in[5];
    const float* dil_wq = (const float*)d_in[6]; const float* q_norm = (const float*)d_in[7]; const float* dil_wo = (const float*)d_in[8];
    const float* rel_bias = (const float*)d_in[9]; const float* mixer_norm = (const float*)d_in[10]; const float* ffn_norm = (const float*)d_in[11];
    const float* router_grp = (const float*)d_in[12]; const float* router_grp_b = (const float*)d_in[13]; const float* router_exp = (const float*)d_in[14]; const float* router_exp_b = (const float*)d_in[15];
    const float* exp_gate = (const float*)d_in[16]; const float* exp_up = (const float*)d_in[17]; const float* exp_down = (const float*)d_in[18];
    float* h = (float*)d_out;
    char* ws = (char*)d_ws;
    int* counts = (int*)ws; int* cursor = counts + 64; int* pstart = counts + 128; int* blk_exp = counts + 256;
    int* eid = (int*)(ws + 1 * MiB); float* gwt = (float*)(ws + 1 * MiB + 512 * 1024);
    int* rows_tok = (int*)(ws + 2 * MiB); float* rows_gate = (float*)(ws + 3 * MiB);
    float* xn = (float*)(ws + 4 * MiB);
    float* R2 = (float*)(ws + 132 * MiB);
    float* projc = R2; float* oc = (float*)(ws + 324 * MiB);
    float* Gb = R2; float* Yb = (float*)(ws + 276 * MiB);
    float* xq = xn; float* xkv = (float*)(ws + 36 * MiB);
    float* qc = R2; float* kvc = (float*)(ws + 228 * MiB); float* ac = (float*)(ws + 420 * MiB);

    auto moe = [&](int layer) {
        hipLaunchKernelGGL(k_rmsnorm, dim3(T / 4), dim3(256), 0, stream, (const float*)h, ffn_norm + layer * D, xn, T);
        hipMemsetAsync(counts, 0, 128 * sizeof(int), stream);
        hipLaunchKernelGGL(k_router, dim3(T / 4), dim3(256), 0, stream, (const float*)xn, router_grp + (size_t)layer * D * 4, router_grp_b + layer * 4, router_exp + (size_t)layer * D * 32, router_exp_b + layer * 32, eid, gwt, counts);
        hipLaunchKernelGGL(k_plan, dim3(1), dim3(64), 0, stream, (const int*)counts, pstart, blk_exp);
        hipLaunchKernelGGL(k_fill_rows, dim3((P + 255) / 256), dim3(256), 0, stream, rows_tok, rows_gate);
        hipLaunchKernelGGL(k_place, dim3(2 * T / 256), dim3(256), 0, stream, (const int*)eid, (const float*)gwt, (const int*)pstart, cursor, rows_tok, rows_gate);
        GemmP g{}; g.A = xn; g.lda = D; g.arow = rows_tok; g.B = exp_gate + (size_t)layer * NEXP * D * FF; g.ldb = FF; g.strideB = (long long)D * FF; g.blk_exp = blk_exp;
        g.C = Gb; g.ldc = FF; g.M = P; g.N = FF; g.K = D; g.mode = 0; gemm(stream, g);
        g.B = exp_up + (size_t)layer * NEXP * D * FF; g.mode = 2; gemm(stream, g);
        hipMemsetAsync(Yb, 0, (size_t)T * D * 4, stream);
        GemmP d{}; d.A = Gb; d.lda = FF; d.arow = rows_tok; d.B = exp_down + (size_t)layer * NEXP * FF * D; d.ldb = D; d.strideB = (long long)FF * D; d.blk_exp = blk_exp;
        d.C = nullptr; d.ldc = D; d.M = P; d.N = D; d.K = FF; d.mode = 3; d.rgate = rows_gate; d.Y = Yb; gemm(stream, d);
        hipLaunchKernelGGL(k_add, dim3((unsigned)((size_t)T * D / 4 / 256)), dim3(256), 0, stream, h, (const float*)Yb, (size_t)T * D / 4);
    };

    hipLaunchKernelGGL(k_rmsnorm, dim3(T / 4), dim3(256), 0, stream, x, mixer_norm, xn, T);
    for (int c = 0; c < NB / CHB; ++c) {
        const size_t t0 = (size_t)c * CT;
        GemmP g{}; g.A = xn + t0 * D; g.lda = D; g.B = ret_w_in; g.ldb = 6144; g.C = projc; g.ldc = 6144; g.M = CT; g.N = 6144; g.K = D; g.mode = 0; gemm(stream, g);
        hipLaunchKernelGGL(k_rotary, dim3((unsigned)((size_t)CT * 1024 / 256)), dim3(256), 0, stream, projc, CT);
        hipLaunchKernelGGL(k_retention, dim3(64, 4, CHB), dim3(256), 0, stream, (const float*)projc, oc);
        hipLaunchKernelGGL(k_gnorm_gate, dim3(CT), dim3(256), 0, stream, oc, (const float*)projc, CT);
        GemmP o{}; o.A = oc; o.lda = 2048; o.B = ret_w_out; o.ldb = D; o.C = h + t0 * D; o.ldc = D; o.M = CT; o.N = D; o.K = 2048; o.mode = 1; o.R = x + t0 * D; o.ldr = D; gemm(stream, o);
    }
    moe(0);
    for (int c = 0; c < NB / CHB; ++c) {
        const size_t t0 = (size_t)c * CT;
        hipLaunchKernelGGL(k_rmsnorm, dim3(CT / 4), dim3(256), 0, stream, (const float*)(h + t0 * D), mixer_norm + D, xq, CT);
        hipLaunchKernelGGL(k_rmsnorm, dim3(CT / 4), dim3(256), 0, stream, (const float*)(h + t0 * D), kv_norm, xkv, CT);
        GemmP g{}; g.A = xq; g.lda = D; g.B = dil_wq; g.ldb = 3072; g.C = qc; g.ldc = 3072; g.M = CT; g.N = 3072; g.K = D; g.mode = 0; gemm(stream, g);
        GemmP k{}; k.A = xkv; k.lda = D; k.B = w_kv; k.ldb = 6144; k.C = kvc; k.ldc = 6144; k.M = CT; k.N = 6144; k.K = D; k.mode = 0; gemm(stream, k);
        hipLaunchKernelGGL(k_headnorm, dim3(CT * 48 / 256), dim3(256), 0, stream, qc, 3072, q_norm, CT);
        hipLaunchKernelGGL(k_headnorm, dim3(CT * 48 / 256), dim3(256), 0, stream, kvc, 6144, k_norm, CT);
        hipLaunchKernelGGL(k_dilattn, dim3(CT * 16 / 4), dim3(256), 0, stream, (const float*)qc, (const float*)kvc, rel_bias, ac, CT);
        GemmP o{}; o.A = ac; o.lda = D; o.B = dil_wo; o.ldb = D; o.C = h + t0 * D; o.ldc = D; o.M = CT; o.N = D; o.K = D; o.mode = 1; o.R = h + t0 * D; o.ldr = D; gemm(stream, o);
    }
    moe(1);
}
```

```cpp
#include <hip/hip_runtime.h>
#include <cstdio>
#include <cstdint>
#define MK_MASK 15
#define MK_SPLIT 1
namespace mk {
#define LAS __attribute__((address_space(3)))
#define GAS __attribute__((address_space(1)))
typedef unsigned short bf16;
typedef short bf16x8 __attribute__((ext_vector_type(8)));
typedef short s16x4 __attribute__((ext_vector_type(4)));
typedef float f32x4 __attribute__((ext_vector_type(4)));
typedef float f32x2 __attribute__((ext_vector_type(2)));
typedef unsigned u32x4 __attribute__((ext_vector_type(4)));
typedef unsigned u32x2 __attribute__((ext_vector_type(2)));
typedef GAS unsigned gu32;

constexpr int T = 32768, D = 1024, SEQ = 2048, NB = 16;
constexpr int NEXP = 32, FF = 512;
constexpr int TC = 16384;
constexpr size_t MiB = 1u << 20;
constexpr size_t WS_CTL = 0, CTL_BYTES = 1 * MiB;
constexpr size_t WS_COS = 1 * MiB, WS_SIN = 2 * MiB, WS_WR = 3 * MiB;
constexpr size_t WS_SSQ = 4 * MiB, WS_ML = 8 * MiB, WS_LIST = 16 * MiB, WS_GATEW = 24 * MiB;
constexpr size_t WS_WIN = 26 * MiB, WS_WOUT = 38 * MiB, WS_WQKV1 = 42 * MiB, WS_WO1 = 60 * MiB;
constexpr size_t WS_WGU1 = 62 * MiB, WS_WD1 = 126 * MiB;
constexpr size_t WS_XN = 158 * MiB;
constexpr size_t WS_WGU0 = 222 * MiB, WS_WD0 = 286 * MiB;
constexpr size_t WS_ACT = 318 * MiB;
constexpr size_t WS_Q0 = WS_ACT, WS_K0 = WS_ACT + 64 * MiB, WS_V0 = WS_ACT + 128 * MiB;
constexpr size_t WS_HID = WS_ACT;
constexpr size_t WS_Q1 = 222 * MiB, WS_K1 = 318 * MiB, WS_V1 = 414 * MiB;
constexpr size_t WS_END = 574 * MiB;
constexpr int CW_BAR = 4096;
constexpr int CW_CNT = 16384;
constexpr int LDS_MISC = 155648;
constexpr int LDS_BYTES = 159 * 1024;
constexpr int NWAVES = 8;

#define LDS_WAIT() asm volatile("s_waitcnt lgkmcnt(0)" ::: "memory")
#define VM_WAIT() asm volatile("s_waitcnt vmcnt(0)" ::: "memory")
__device__ __forceinline__ unsigned f2bf(float f) { unsigned u = __builtin_bit_cast(unsigned, f); return (u + 0x7fffu + ((u >> 16) & 1u)) >> 16; }
__device__ __forceinline__ unsigned pk2(float lo, float hi) { return f2bf(lo) | (f2bf(hi) << 16); }
typedef __bf16 bf16pair_t __attribute__((ext_vector_type(2)));
__device__ __forceinline__ unsigned cvt_pk_bf16(float lo, float hi) { bf16pair_t v; v.x = (__bf16)lo; v.y = (__bf16)hi; return __builtin_bit_cast(unsigned, v); }
__device__ __forceinline__ float bf_lo(unsigned u) { return __builtin_bit_cast(float, u << 16); }
__device__ __forceinline__ float bf_hi(unsigned u) { return __builtin_bit_cast(float, u & 0xffff0000u); }
__device__ __forceinline__ float wave_sum(float v) {
#pragma unroll
    for (int o = 1; o < 64; o <<= 1) v += __shfl_xor(v, o);
    return v;
}
__device__ __forceinline__ float silu_f(float x) { return x * __builtin_amdgcn_rcpf(1.0f + __builtin_amdgcn_exp2f(-1.4426950408889634f * x)); }

#define XB_TMO      128
#define XB_XCNT(j)  (256  + 64 * (j))
#define XB_XSUB(j)  (1280 + 64 * (j))
#define XB_XGEN(j)  (2304 + 64 * (j))
#define XB_TOP      3328
#define XB_TOPGEN   3392
#define XCD_BAR_WORDS 3456
#define XB_SPIN_CAP (1u << 22)
__device__ __forceinline__ unsigned xb_ld(unsigned* p)              { return __hip_atomic_load(p, __ATOMIC_RELAXED, __HIP_MEMORY_SCOPE_AGENT); }
__device__ __forceinline__ unsigned xb_add(unsigned* p, unsigned v) { return __hip_atomic_fetch_add(p, v, __ATOMIC_RELAXED, __HIP_MEMORY_SCOPE_AGENT); }
__device__ __forceinline__ unsigned xb_xcc_id() { return (unsigned)__builtin_amdgcn_s_getreg((3 << 11) | 20) & 0xFu; }
#define XB_SPIN(cond, bar) do { unsigned _sp = 0; while (cond) { __builtin_amdgcn_s_sleep(1); \
    if ((++_sp & 255u) == 0u) { if (xb_ld(&(bar)[XB_TMO])) break; if (_sp > XB_SPIN_CAP) { atomicAdd(&(bar)[XB_TMO], 1u); break; } } } } while (0)
struct XcdBarrier { unsigned* bar; unsigned x; volatile LAS unsigned* st; };
__device__ __forceinline__ int lane_id() { return (int)__builtin_amdgcn_mbcnt_hi(~0u, __builtin_amdgcn_mbcnt_lo(~0u, 0u)); }
__device__ __forceinline__ XcdBarrier xcd_barrier_post(unsigned* bar, volatile LAS unsigned* st, bool t0) {
    XcdBarrier b; b.bar = bar; b.x = xb_xcc_id(); b.st = st;
    if (t0) (void)xb_add(&bar[XB_XCNT(b.x)], 1u);
    return b;
}
__device__ __forceinline__ void xcd_barrier_complete(unsigned* bar, unsigned x, unsigned& nloc, unsigned& nx) {
    const unsigned G = gridDim.x * gridDim.y * gridDim.z;
    unsigned sum, cnt, mine, sp = 0u;
    for (;;) {
        sum = 0u; cnt = 0u; mine = 0u;
#pragma unroll
        for (unsigned j = 0; j < 16; ++j) { const unsigned c = xb_ld(&bar[XB_XCNT(j)]); sum += c; cnt += (c > 0u) ? 1u : 0u; mine = (j == x) ? c : mine; }
        if (sum == G) break;
        __builtin_amdgcn_s_sleep(1);
        if ((++sp & 255u) == 0u) { if (xb_ld(&bar[XB_TMO])) break; if (sp > XB_SPIN_CAP) { atomicAdd(&bar[XB_TMO], 1u); break; } }
    }
    nloc = mine > 0u ? mine : 1u; nx = cnt > 0u ? cnt : 1u;
}
__device__ __forceinline__ void xcd_barrier(const XcdBarrier& b, int wave_s) {
    asm volatile("s_waitcnt vmcnt(0)" ::: "memory");
    __syncthreads();
    if (wave_s == 0 && lane_id() == 0) {
        unsigned* bar = b.bar;
        __builtin_amdgcn_s_waitcnt(0);
        unsigned nloc = b.st[0], nx = b.st[1];
        if (nloc == 0u) { xcd_barrier_complete(bar, b.x, nloc, nx); b.st[0] = nloc; b.st[1] = nx; }
        const unsigned old = xb_add(&bar[XB_XSUB(b.x)], 1u);
        const unsigned gen = old / nloc;
        if (old + 1u == (gen + 1u) * nloc) {
            __builtin_amdgcn_fence(__ATOMIC_RELEASE, "agent");
            asm volatile("s_waitcnt vmcnt(0)" ::: "memory");
            const unsigned og = xb_add(&bar[XB_TOP], 1u);
            const unsigned tg = og / nx;
            if (og + 1u == (tg + 1u) * nx) xb_add(&bar[XB_TOPGEN], 1u);
            else XB_SPIN(xb_ld(&bar[XB_TOPGEN]) == tg, bar);
            __builtin_amdgcn_fence(__ATOMIC_ACQUIRE, "agent");
            xb_add(&bar[XB_XGEN(b.x)], 1u);
            asm volatile("s_waitcnt vmcnt(0)" ::: "memory");
        } else {
            XB_SPIN(xb_ld(&bar[XB_XGEN(b.x)]) == gen, bar);
            __builtin_amdgcn_fence(__ATOMIC_ACQUIRE, "agent");
            asm volatile("s_waitcnt vmcnt(0)" ::: "memory");
        }
    }
    __syncthreads();
}

constexpr int BM = 256, BK = 64, HALF = 128, HTB = HALF * BK * 2, NXCD = 8, WGM = 8;
__host__ __device__ __forceinline__ int lds_byte(int r, int c) { const int st = (r >> 4) * 2 + (c >> 5), rr = r & 15, cc = c & 31, ob = rr * 64 + cc * 2; return st * 1024 + (ob ^ (((ob >> 9) & 1) << 5)); }
__host__ __device__ __forceinline__ void stage_rc(int b, int& R, int& C) { const int st = b / 1024, sb = b % 1024, swz = sb ^ (((sb >> 9) & 1) << 5); R = (st >> 1) * 16 + swz / 64; C = (st & 1) * 32 + (swz % 64) / 2; }
__host__ __device__ __forceinline__ int perm32(int rho) { const int n = rho >> 4, i = rho & 15; return 8 * (i >> 2) + 4 * n + (i & 3); }
struct Unit { int pm, pn, a0, a1; };
struct StaticOrder {
    int nM, nN, nwg, G, c;
    __device__ __forceinline__ void init(int M, int N, int G_, int c_) { nM = M / BM; nN = N / BM; nwg = nM * nN; G = G_; c = c_; }
    __device__ __forceinline__ bool next(int i, Unit& u) const {
        const long L = (long)i * G + c; if (L >= nwg) return false;
        int wgid = (int)L; { const int q = nwg / NXCD, r = nwg % NXCD, xcd = wgid % NXCD, off = wgid / NXCD; wgid = (xcd < r ? xcd * (q + 1) : r * (q + 1) + (xcd - r) * q) + off; }
        const int nig = WGM * nN, gid = wgid / nig, fm = gid * WGM, gsz = (nM - fm) < WGM ? (nM - fm) : WGM;
        u.pm = fm + ((wgid % nig) % gsz); u.pn = (wgid % nig) / gsz; u.a0 = 0; u.a1 = 0; return true;
    }
};
template <class P>
__device__ __forceinline__ void gemm_phase(LAS unsigned char* lds, const P& S, const int tid) {
    const int wid = __builtin_amdgcn_readfirstlane(tid >> 6), lane = tid & 63, wr = wid >> 2, wc = wid & 3, fr = lane & 15, fq = lane >> 4;
    const int K = S.K, nt = K / BK;
    unsigned voffB[2]; unsigned vA[2][2], vN[2][2];
#pragma unroll
    for (int i = 0; i < 2; ++i) { int R, C; stage_rc(tid * 16 + i * 8192, R, C); const int Rb = P::PERM ? ((R & ~31) + perm32(R & 31)) : R;
        voffB[i] = (unsigned)Rb * S.ldb + (unsigned)C * 2u;
#pragma unroll
        for (int h = 0; h < 2; ++h) { vA[h][i] = (unsigned)(h * HALF + R) * S.lda + (unsigned)C * 2u; vN[h][i] = vA[h][i]; } }
    const size_t kstep = (size_t)(BK * 2);
    const size_t hstepB = (size_t)HALF * S.ldb;
    const unsigned ldsw = (unsigned)wid * 1024u;
    const int aoff = lds_byte(wr * 64 + fr, fq * 8), boff = lds_byte(wc * 32 + fr, fq * 8);
#define PG8_SA(b, h) (((b) * 2 + (h)) * HTB)
#define PG8_SB(b, h) ((4 + (b) * 2 + (h)) * HTB)
#define PG8_STAGE(bufoff, gbase, voff) do { _Pragma("unroll") for (int _i = 0; _i < 2; ++_i) \
        __builtin_amdgcn_global_load_lds((const unsigned*)((const char*)(gbase) + (voff)[_i]), (LAS unsigned*)(lds + (bufoff) + ldsw + _i * 8192), 16, 0, 0); } while (0)
#define PG8_LDA(dst, b, h) do { _Pragma("unroll") for (int m = 0; m < 4; ++m) _Pragma("unroll") for (int k = 0; k < 2; ++k) dst[m][k] = *(const LAS bf16x8*)(lds + PG8_SA(b, h) + aoff + m * 2048 + k * 1024); } while (0)
#define PG8_LDB(dst, b, h) do { _Pragma("unroll") for (int n = 0; n < 2; ++n) _Pragma("unroll") for (int k = 0; k < 2; ++k) dst[n][k] = *(const LAS bf16x8*)(lds + PG8_SB(b, h) + boff + n * 2048 + k * 1024); } while (0)
#define PG8_MMA(ai, bj, At, Bt) do { __builtin_amdgcn_s_setprio(1); _Pragma("unroll") for (int m = 0; m < 4; ++m) _Pragma("unroll") for (int n = 0; n < 2; ++n) _Pragma("unroll") for (int k = 0; k < 2; ++k) \
        acc[ai][bj][m][n] = __builtin_amdgcn_mfma_f32_16x16x32_bf16(Bt[n][k], At[m][k], acc[ai][bj][m][n], 0, 0, 0); __builtin_amdgcn_s_setprio(0); } while (0)
#define PG8_WAIT_V(n) asm volatile("s_waitcnt vmcnt(" #n ")" ::: "memory")
#define PG8_WAIT_L(n) asm volatile("s_waitcnt lgkmcnt(" #n ")" ::: "memory")
#define PG8_BAR __builtin_amdgcn_s_barrier()
#define PG8_SCHED __builtin_amdgcn_sched_barrier(0)
    Unit cur, nxt; int ui = 0;
    if (!S.next(0, cur)) return;
    f32x4 acc[2][2][4][2];
#pragma unroll
    for (int a = 0; a < 2; ++a)
#pragma unroll
        for (int b = 0; b < 2; ++b)
#pragma unroll
            for (int m = 0; m < 4; ++m)
#pragma unroll
                for (int n = 0; n < 2; ++n) acc[a][b][m][n] = (f32x4){0.f, 0.f, 0.f, 0.f};
    bf16x8 At[4][2], B0[2][2], B1[2][2];
    const char* cA = S.a_base(cur); const char* cB = S.b_base(cur);
    if constexpr (P::GATHER) { S.a_rows(cur, tid, vA); }
    PG8_STAGE(PG8_SB(0, 0), cB, voffB); PG8_STAGE(PG8_SB(0, 1), cB + hstepB, voffB); PG8_STAGE(PG8_SA(0, 0), cA, vA[0]); PG8_STAGE(PG8_SA(0, 1), cA, vA[1]);
    if (wr == 1) PG8_BAR;
    PG8_WAIT_V(2); PG8_BAR;
    PG8_STAGE(PG8_SB(1, 0), cB + kstep, voffB); PG8_STAGE(PG8_SA(1, 0), cA + kstep, vA[0]); PG8_STAGE(PG8_SB(1, 1), cB + hstepB + kstep, voffB);
    PG8_WAIT_V(6); PG8_BAR;
    for (;;) {
        const bool has_next = S.next(ui + 1, nxt);
        const char* nA = has_next ? S.a_base(nxt) : cA; const char* nB = has_next ? S.b_base(nxt) : cB;
        for (int t = 0; t < nt; t += 2) {
            const bool last = (t == nt - 2);
            if constexpr (P::GATHER) { if (t == nt - 4 && has_next) S.a_rows(nxt, tid, vN); }
            const char* a1 = cA + (size_t)(t + 1) * kstep;
            const char* a2 = last ? nA : cA + (size_t)(t + 2) * kstep; const char* b2 = last ? nB : cB + (size_t)(t + 2) * kstep;
            const char* a3 = a2 + kstep; const char* b3 = b2 + kstep;
            unsigned v2[2][2];
#pragma unroll
            for (int h = 0; h < 2; ++h)
#pragma unroll
                for (int i = 0; i < 2; ++i) v2[h][i] = (P::GATHER && last) ? vN[h][i] : vA[h][i];
            PG8_LDB(B0, 0, 0); PG8_LDB(B1, 0, 1); PG8_SCHED; PG8_LDA(At, 0, 0); PG8_STAGE(PG8_SA(1, 1), a1, vA[1]);
            PG8_WAIT_V(8); PG8_WAIT_L(0); PG8_BAR; PG8_MMA(0, 0, At, B0); PG8_MMA(0, 1, At, B1); PG8_BAR; PG8_SCHED;
            PG8_LDA(At, 0, 1); PG8_STAGE(PG8_SB(0, 0), b2, voffB); PG8_STAGE(PG8_SB(0, 1), b2 + hstepB, voffB); PG8_STAGE(PG8_SA(0, 0), a2, v2[0]);
            PG8_WAIT_V(8); PG8_WAIT_L(0); PG8_BAR; PG8_MMA(1, 0, At, B0); PG8_MMA(1, 1, At, B1); PG8_BAR; PG8_SCHED;
            PG8_LDB(B0, 1, 0); PG8_LDB(B1, 1, 1); PG8_SCHED; PG8_LDA(At, 1, 0); PG8_STAGE(PG8_SA(0, 1), a2, v2[1]);
            PG8_WAIT_V(8); PG8_WAIT_L(0); PG8_BAR; PG8_MMA(0, 0, At, B0); PG8_MMA(0, 1, At, B1); PG8_BAR; PG8_SCHED;
            PG8_LDA(At, 1, 1); PG8_STAGE(PG8_SB(1, 0), b3, voffB); PG8_STAGE(PG8_SB(1, 1), b3 + hstepB, voffB); PG8_STAGE(PG8_SA(1, 0), a3, v2[0]);
            PG8_WAIT_V(8); PG8_WAIT_L(0); PG8_BAR; PG8_MMA(1, 0, At, B0); PG8_MMA(1, 1, At, B1); PG8_BAR; PG8_SCHED;
        }
        if (wr == 0) PG8_BAR;
        S.epi(acc, cur, wr, wc, fr, fq);
        if (!has_next) break;
#pragma unroll
        for (int a = 0; a < 2; ++a)
#pragma unroll
            for (int b = 0; b < 2; ++b)
#pragma unroll
                for (int m = 0; m < 4; ++m)
#pragma unroll
                    for (int n = 0; n < 2; ++n) acc[a][b][m][n] = (f32x4){0.f, 0.f, 0.f, 0.f};
        cur = nxt; cA = nA; cB = nB; ++ui;
        if constexpr (P::GATHER) {
#pragma unroll
            for (int h = 0; h < 2; ++h)
#pragma unroll
                for (int i = 0; i < 2; ++i) vA[h][i] = vN[h][i]; }
        if (wr == 1) PG8_BAR;
    }
    PG8_WAIT_V(0);
    PG8_BAR;
#undef PG8_SA
#undef PG8_SB
#undef PG8_STAGE
#undef PG8_LDA
#undef PG8_LDB
#undef PG8_MMA
#undef PG8_WAIT_V
#undef PG8_WAIT_L
#undef PG8_BAR
#undef PG8_SCHED
}
struct PlainBase {
    const char* A; const char* Bt; unsigned lda, ldb; int K; StaticOrder so;
    __device__ __forceinline__ bool next(int i, Unit& u) const { return so.next(i, u); }
    __device__ __forceinline__ const char* a_base(const Unit& u) const { return A + (size_t)u.pm * BM * lda; }
    __device__ __forceinline__ const char* b_base(const Unit& u) const { return Bt + (size_t)u.pn * BM * ldb; }
    __device__ __forceinline__ void a_rows(const Unit&, int, unsigned (&)[2][2]) const {}
};
__device__ __forceinline__ float head_l2g(int h) { return __builtin_log2f(1.0f - __builtin_amdgcn_exp2f(-5.0f - (float)h)); }

struct P_QKV0 : PlainBase {
    static constexpr bool PERM = true, GATHER = false;
    bf16* qk; bf16* v; const float* cs; const float* sn;
    __device__ __forceinline__ void epi(const f32x4 (&acc)[2][2][4][2], const Unit& u, int wr, int wc, int fr, int fq) const {
        const int row0 = u.pm * BM + wr * 64 + fr, pn = u.pn;
        if (pn < 8) {
            const int hh = pn & 3; const bool isk = pn >= 4; bf16* dst = qk + (size_t)(pn >> 2) * ((size_t)T * 1024);
            const float l2g = isk ? -head_l2g(hh) : head_l2g(hh);
#pragma unroll
            for (int ai = 0; ai < 2; ++ai)
#pragma unroll
                for (int m = 0; m < 4; ++m) { const int row = row0 + ai * HALF + m * 16, pos = row & (SEQ - 1);
                    const float sc = __builtin_amdgcn_exp2f(l2g * (float)(pos & 63));
#pragma unroll
                    for (int bj = 0; bj < 2; ++bj) { const int c0 = bj * HALF + wc * 32 + 8 * fq, i0 = c0 >> 1;
                        const f32x4 cv = *(const f32x4*)(cs + pos * 128 + i0), sv = *(const f32x4*)(sn + pos * 128 + i0);
                        const f32x4 v0 = acc[ai][bj][m][0], v1 = acc[ai][bj][m][1];
                        u32x4 w;
                        w.x = cvt_pk_bf16((v0[0] * cv[0] - v0[1] * sv[0]) * sc, (v0[0] * sv[0] + v0[1] * cv[0]) * sc);
                        w.y = cvt_pk_bf16((v0[2] * cv[1] - v0[3] * sv[1]) * sc, (v0[2] * sv[1] + v0[3] * cv[1]) * sc);
                        w.z = cvt_pk_bf16((v1[0] * cv[2] - v1[1] * sv[2]) * sc, (v1[0] * sv[2] + v1[1] * cv[2]) * sc);
                        w.w = cvt_pk_bf16((v1[2] * cv[3] - v1[3] * sv[3]) * sc, (v1[2] * sv[3] + v1[3] * cv[3]) * sc);
                        *(u32x4*)(dst + (size_t)row * 1024 + hh * 256 + c0) = w; } }
        } else {
#pragma unroll
            for (int ai = 0; ai < 2; ++ai)
#pragma unroll
                for (int m = 0; m < 4; ++m) { const int row = row0 + ai * HALF + m * 16;
#pragma unroll
                    for (int bj = 0; bj < 2; ++bj) { const int c0 = bj * HALF + wc * 32 + 8 * fq;
                        const f32x4 v0 = acc[ai][bj][m][0], v1 = acc[ai][bj][m][1];
                        u32x4 w; w.x = cvt_pk_bf16(v0[0], v0[1]); w.y = cvt_pk_bf16(v0[2], v0[3]); w.z = cvt_pk_bf16(v1[0], v1[1]); w.w = cvt_pk_bf16(v1[2], v1[3]);
                        *(u32x4*)(v + (size_t)row * 2048 + (pn - 8) * 256 + c0) = w; } }
        }
    }
};
struct P_GATE : PlainBase {
    static constexpr bool PERM = true, GATHER = false;
    bf16* ov; const float* ssq;
    __device__ __forceinline__ void epi(const f32x4 (&acc)[2][2][4][2], const Unit& u, int wr, int wc, int fr, int fq) const {
        const int row0 = u.pm * BM + wr * 64 + fr, head = u.pn >> 1;
#pragma unroll
        for (int ai = 0; ai < 2; ++ai)
#pragma unroll
            for (int m = 0; m < 4; ++m) { const int row = row0 + ai * HALF + m * 16;
                const f32x4 s0 = *(const f32x4*)(ssq + ((size_t)row * 4 + head) * 8), s1 = *(const f32x4*)(ssq + ((size_t)row * 4 + head) * 8 + 4);
                const float rs = __builtin_amdgcn_rsqf((((s0[0] + s0[1]) + (s0[2] + s0[3])) + ((s1[0] + s1[1]) + (s1[2] + s1[3]))) * (1.0f / 512.0f) + 1e-6f);
#pragma unroll
                for (int bj = 0; bj < 2; ++bj) { const int c0 = u.pn * BM + bj * HALF + wc * 32 + 8 * fq;
                    u32x4* p = (u32x4*)(ov + (size_t)row * 2048 + c0); const u32x4 o = *p;
                    const f32x4 v0 = acc[ai][bj][m][0], v1 = acc[ai][bj][m][1];
                    u32x4 w;
                    w.x = cvt_pk_bf16(silu_f(v0[0]) * bf_lo(o.x) * rs, silu_f(v0[1]) * bf_hi(o.x) * rs);
                    w.y = cvt_pk_bf16(silu_f(v0[2]) * bf_lo(o.y) * rs, silu_f(v0[3]) * bf_hi(o.y) * rs);
                    w.z = cvt_pk_bf16(silu_f(v1[0]) * bf_lo(o.z) * rs, silu_f(v1[1]) * bf_hi(o.z) * rs);
                    w.w = cvt_pk_bf16(silu_f(v1[2]) * bf_lo(o.w) * rs, silu_f(v1[3]) * bf_hi(o.w) * rs);
                    *p = w; } }
    }
};
struct P_RES : PlainBase {
    static constexpr bool PERM = false, GATHER = false;
    const float* res; float* out; int row_off;
    __device__ __forceinline__ void epi(const f32x4 (&acc)[2][2][4][2], const Unit& u, int wr, int wc, int fr, int fq) const {
        const int row0 = row_off + u.pm * BM + wr * 64 + fr, col0 = u.pn * BM + wc * 32 + 4 * fq;
#pragma unroll
        for (int ai = 0; ai < 2; ++ai)
#pragma unroll
            for (int m = 0; m < 4; ++m) { const size_t off = (size_t)(row0 + ai * HALF + m * 16) * D + col0;
#pragma unroll
                for (int bj = 0; bj < 2; ++bj)
#pragma unroll
                    for (int n = 0; n < 2; ++n) { const f32x4 r = *(const f32x4*)(res + off + bj * HALF + n * 16); *(f32x4*)(out + off + bj * HALF + n * 16) = r + acc[ai][bj][m][n]; } }
    }
};
struct P_QKV1 : PlainBase {
    static constexpr bool PERM = true, GATHER = false;
    bf16* qkv; const float* gains;
    __device__ __forceinline__ void epi(const f32x4 (&acc)[2][2][4][2], const Unit& u, int wr, int wc, int fr, int fq) const {
        const int row0 = u.pm * BM + wr * 64 + fr, part = u.pn / 12, pp = u.pn % 12, g = pp >> 2, head = (pp & 3) * 4 + wc;
        bf16* dst = qkv + (size_t)part * ((size_t)TC * 3072) + g * 1024 + head * 64 + 8 * fq;
        const float* gp = gains + (part & 1) * 192 + g * 64 + 8 * fq;
        const float qs = part == 0 ? 0.125f * 1.4426950408889634f : 1.0f;
#pragma unroll
        for (int ai = 0; ai < 2; ++ai)
#pragma unroll
            for (int m = 0; m < 4; ++m) { const int row = row0 + ai * HALF + m * 16;
                float rs = 1.0f;
                if (part < 2) {
                    float ss = 0.f;
#pragma unroll
                    for (int bj = 0; bj < 2; ++bj)
#pragma unroll
                        for (int n = 0; n < 2; ++n) { const f32x4 t = acc[ai][bj][m][n]; ss += (t[0] * t[0] + t[1] * t[1]) + (t[2] * t[2] + t[3] * t[3]); }
                    ss += __shfl_xor(ss, 16); ss += __shfl_xor(ss, 32);
                    rs = __builtin_amdgcn_rsqf(ss * (1.0f / 64.0f) + 1e-6f) * qs;
                }
#pragma unroll
                for (int bj = 0; bj < 2; ++bj) { f32x4 v0 = acc[ai][bj][m][0], v1 = acc[ai][bj][m][1];
                    if (part < 2) { v0 = v0 * *(const f32x4*)(gp + 32 * bj) * rs; v1 = v1 * *(const f32x4*)(gp + 32 * bj + 4) * rs; }
                    u32x4 w; w.x = cvt_pk_bf16(v0[0], v0[1]); w.y = cvt_pk_bf16(v0[2], v0[3]); w.z = cvt_pk_bf16(v1[0], v1[1]); w.w = cvt_pk_bf16(v1[2], v1[3]);
                    *(u32x4*)(dst + (size_t)row * 3072 + 32 * bj) = w; }
                asm volatile("" ::: "memory"); }
    }
};
__device__ __forceinline__ void moe_build_tab(LAS int* tab, const unsigned* cnt_g, const int tid) {
    if (tid == 0) { int run = 0; for (int b = 0; b < 64; ++b) { const int c = (int)__hip_atomic_load(cnt_g + b, __ATOMIC_RELAXED, __HIP_MEMORY_SCOPE_AGENT); tab[b] = c; tab[64 + b] = run; run += (c + 255) >> 8; } tab[128] = run; }
    __syncthreads();
}
__device__ __forceinline__ int moe_find_bin(const LAS int* tab, int tl, int blo, int bhi) {
    int b = blo;
    for (int j = blo; j < bhi; ++j) if (tab[64 + j + 1] <= tl) b = j + 1;
    return __builtin_amdgcn_readfirstlane(b);
}
struct P_GU {
    static constexpr bool PERM = true, GATHER = true;
    const char* xn; const char* W; const int* list; bf16* hid; const LAS int* tab; int G, vcu; int K; unsigned lda, ldb;
    __device__ __forceinline__ bool next(int i, Unit& u) const {
        const int L = i * G + vcu; if (L >= tab[128] * 4) return false;
        const int tl = L >> 2, b = moe_find_bin(tab, tl, 0, 64);
        u.pm = tl - tab[64 + b]; u.pn = L & 3; u.a0 = b; u.a1 = tl; return true;
    }
    __device__ __forceinline__ const char* a_base(const Unit&) const { return xn; }
    __device__ __forceinline__ const char* b_base(const Unit& u) const { return W + ((size_t)(u.a0 & 31) * 1024 + (size_t)u.pn * BM) * 2048; }
    __device__ __forceinline__ void a_rows(const Unit& u, int tid, unsigned (&off)[2][2]) const {
        const int n = tab[u.a0]; const int* lp = list + (size_t)u.a0 * T + u.pm * BM;
#pragma unroll
        for (int i = 0; i < 2; ++i) { int R, C; stage_rc(tid * 16 + i * 8192, R, C);
#pragma unroll
            for (int h = 0; h < 2; ++h) { const int r = h * HALF + R; const int tok = (u.pm * BM + r < n) ? lp[r] : 0; off[h][i] = (unsigned)tok * 2048u + (unsigned)C * 2u; } }
    }
    __device__ __forceinline__ void epi(const f32x4 (&acc)[2][2][4][2], const Unit& u, int wr, int wc, int fr, int fq) const {
        const size_t hrow0 = (size_t)u.a1 * BM + wr * 64 + fr;
#pragma unroll
        for (int ai = 0; ai < 2; ++ai)
#pragma unroll
            for (int m = 0; m < 4; ++m)
#pragma unroll
                for (int bj = 0; bj < 2; ++bj) { const int f0 = (u.pn * BM + bj * HALF + wc * 32 + 8 * fq) >> 1;
                    const f32x4 gv = acc[ai][bj][m][0], uv = acc[ai][bj][m][1];
                    u32x2 w; w.x = cvt_pk_bf16(silu_f(gv[0]) * uv[0], silu_f(gv[1]) * uv[1]); w.y = cvt_pk_bf16(silu_f(gv[2]) * uv[2], silu_f(gv[3]) * uv[3]);
                    *(u32x2*)(hid + (hrow0 + ai * HALF + m * 16) * FF + f0) = w; }
    }
};
struct P_DN {
    static constexpr bool PERM = false, GATHER = false;
    const char* hid; const char* W; const int* list; const float* gatew; float* h; const LAS int* tab; int G, vcu, slot; int K; unsigned lda, ldb;
    __device__ __forceinline__ bool next(int i, Unit& u) const {
        const int L = i * G + vcu, t0 = tab[64 + slot * 32], t1 = tab[64 + slot * 32 + 32]; if (L >= (t1 - t0) * 4) return false;
        const int tl = t0 + (L >> 2), b = moe_find_bin(tab, tl, slot * 32, slot * 32 + 32);
        u.pm = tl - tab[64 + b]; u.pn = L & 3; u.a0 = b; u.a1 = tl; return true;
    }
    __device__ __forceinline__ const char* a_base(const Unit& u) const { return hid + (size_t)u.a1 * BM * 1024; }
    __device__ __forceinline__ const char* b_base(const Unit& u) const { return W + ((size_t)(u.a0 & 31) * 1024 + (size_t)u.pn * BM) * 1024; }
    __device__ __forceinline__ void a_rows(const Unit&, int, unsigned (&)[2][2]) const {}
    __device__ __forceinline__ void epi(const f32x4 (&acc)[2][2][4][2], const Unit& u, int wr, int wc, int fr, int fq) const {
        const int n = tab[u.a0], col0 = u.pn * BM + wc * 32 + 4 * fq; const int* lp = list + (size_t)u.a0 * T + u.pm * BM;
#pragma unroll
        for (int ai = 0; ai < 2; ++ai)
#pragma unroll
            for (int m = 0; m < 4; ++m) { const int r = ai * HALF + wr * 64 + m * 16 + fr;
                if (u.pm * BM + r < n) { const int tok = lp[r]; const float gt = gatew[tok * 2 + slot]; float* hp = h + (size_t)tok * D + col0;
#pragma unroll
                    for (int bj = 0; bj < 2; ++bj)
#pragma unroll
                        for (int nn = 0; nn < 2; ++nn) { f32x4* p = (f32x4*)(hp + bj * HALF + nn * 16); *p = *p + acc[ai][bj][m][nn] * gt; } } }
    }
};

struct MapId { int off; __device__ __forceinline__ int row(int n) const { return n + off; } __device__ __forceinline__ float scale(int) const { return 1.0f; } };
struct MapWin { __device__ __forceinline__ int row(int n) const { if (n >= 2048) return n; const int d = n & 255; return (n & ~255) + ((d < 128) ? 2 * d : 2 * (d - 128) + 1); }
                __device__ __forceinline__ float scale(int n) const { return (n >= 1024 && n < 2048) ? 0.0625f : 1.0f; } };
struct MapQkv1 { int base; __device__ __forceinline__ int row(int n) const { const int two = n / 3072, n1 = n % 3072, g = n1 >> 10, h = (n1 >> 6) & 15, d = n1 & 63;
                     return base + two * 3072 + (g * 4 + (h >> 2)) * 256 + 32 * (h & 3) + (d & 31) + 128 * (d >> 5); }
                 __device__ __forceinline__ float scale(int) const { return 1.0f; } };
struct MapGu { int up; __device__ __forceinline__ int row(int f) const { return (f >> 2) * 8 + (f & 3) + 4 * up; } __device__ __forceinline__ float scale(int) const { return 1.0f; } };
template <class Map>
__device__ __forceinline__ void transpose_item(const float* W, int N, bf16* WT, int ldt, LAS float* scr, int item, int lane, const float* gain, const Map mp) {
    const int nblk = N / 32, kb = item / nblk, nb = item % nblk, k0 = 64 * kb, n0 = 32 * nb;
#pragma unroll 8
    for (int i = 0; i < 32; ++i) { const int kk = 2 * i + (lane >> 5); const float gg = gain ? gain[k0 + kk] : 1.0f; scr[kk * 33 + (lane & 31)] = W[(size_t)(k0 + kk) * N + n0 + (lane & 31)] * gg; }
    LDS_WAIT(); asm volatile("" ::: "memory");
    const int c = lane & 7;
#pragma unroll
    for (int j = 0; j < 4; ++j) { const int n = (lane >> 3) + 8 * j; const LAS float* s = scr + (8 * c) * 33 + n; const float sc = mp.scale(n0 + n);
        u32x4 o; o.x = pk2(s[0 * 33] * sc, s[1 * 33] * sc); o.y = pk2(s[2 * 33] * sc, s[3 * 33] * sc); o.z = pk2(s[4 * 33] * sc, s[5 * 33] * sc); o.w = pk2(s[6 * 33] * sc, s[7 * 33] * sc);
        *(GAS u32x4*)(WT + (size_t)mp.row(n0 + n) * ldt + k0 + 8 * c) = o; }
    LDS_WAIT(); asm volatile("" ::: "memory");
}
template <class Map>
__device__ __forceinline__ void transpose_matrix(const float* W, int K, int N, bf16* WT, LAS float* scr, int gw, int ngw, int lane, const float* gain, const Map mp) {
    const int nitems = (K / 64) * (N / 32);
    for (int it = gw; it < nitems; it += ngw) transpose_item(W, N, WT, K, scr, it, lane, gain, mp);
}
__device__ __forceinline__ void rms_row_to_bf16(const float* xrow, bf16* orow, int lane) {
    const GAS f32x4* xr = (const GAS f32x4*)xrow + lane;
    f32x4 v[4]; float s = 0.f;
#pragma unroll
    for (int j = 0; j < 4; ++j) { v[j] = xr[64 * j]; s += (v[j].x * v[j].x + v[j].y * v[j].y) + (v[j].z * v[j].z + v[j].w * v[j].w); }
    const float rs = __builtin_amdgcn_rsqf(wave_sum(s) * (1.f / D) + 1e-6f);
    GAS unsigned long long* o8 = (GAS unsigned long long*)orow + lane;
#pragma unroll
    for (int j = 0; j < 4; ++j) o8[64 * j] = (unsigned long long)pk2(v[j].x * rs, v[j].y * rs) | ((unsigned long long)pk2(v[j].z * rs, v[j].w * rs) << 32);
}
__device__ __forceinline__ unsigned swz(int row, int bytecol, int stride) { return (unsigned)(row * stride + ((((bytecol >> 4) ^ (row & 7)) << 4) | (bytecol & 15))); }
__device__ __forceinline__ bf16x8 frag_row(const LAS unsigned char* img, int row0, int bytecol0, int stride, int fr, int fq) {
    return *(const LAS bf16x8*)(img + swz(row0 + fr, bytecol0 + 16 * fq, stride));
}
__device__ __forceinline__ bf16x8 frag_tr2(const LAS unsigned char* img, int rowa, int rowb, int c0, int stride, int lane) {
    const int fq = lane >> 4, q = (lane & 15) >> 2, p = lane & 3;
    const s16x4 lo = __builtin_amdgcn_ds_read_tr16_b64_v4i16((LAS s16x4*)(img + swz(rowa + 4 * fq + q, (c0 + 4 * p) * 2, stride)));
    const s16x4 hi = __builtin_amdgcn_ds_read_tr16_b64_v4i16((LAS s16x4*)(img + swz(rowb + 4 * fq + q, (c0 + 4 * p) * 2, stride)));
    return (bf16x8){lo[0], lo[1], lo[2], lo[3], hi[0], hi[1], hi[2], hi[3]};
}
__device__ __forceinline__ bf16x8 frag_tr(const LAS unsigned char* img, int k0, int c0, int stride, int lane) {
    const int fq = lane >> 4; return frag_tr2(img, k0 + 4 * fq, k0 + 4 * fq + 4, c0, stride, lane);
}
#define MFMA16(a, b, c) __builtin_amdgcn_mfma_f32_16x16x32_bf16((a), (b), (c), 0, 0, 0)

__device__ __forceinline__ void retention_phase(LAS unsigned char* lds, const bf16* qg, const bf16* kg, bf16* vg, float* ssq, int G, int bx, const int tid) {
    const int lane0 = tid & 63, w = __builtin_amdgcn_readfirstlane(tid >> 6);
    const int tq = w & 3, hv = w >> 2;
    LAS unsigned char* QI = lds; LAS unsigned char* KI = lds + 32768; LAS unsigned char* VI = lds + 65536; LAS unsigned char* PI = lds + 81920; LAS unsigned char* ZI = lds + 90112;
    for (int u = bx; u < 256; u += G) {
        const int b = u >> 4, h = (u >> 2) & 3, vs = u & 3;
        const float g64 = __builtin_amdgcn_exp2f(64.0f * head_l2g(h));
        f32x4 Z[16];
#pragma unroll
        for (int i = 0; i < 16; ++i) Z[i] = (f32x4){0.f, 0.f, 0.f, 0.f};
        u32x4 pq[4], pk[4], pv[2];
        const bf16* qh = qg + (size_t)b * SEQ * 1024 + h * 256; const bf16* kh = kg + (size_t)b * SEQ * 1024 + h * 256;
        bf16* vh = vg + (size_t)b * SEQ * 2048 + h * 512 + vs * 128;
#define RET_LOAD(sc) do { _Pragma("unroll") for (int i = 0; i < 4; ++i) { const int pid = tid + 512 * i, r = pid >> 5, c = pid & 31; \
            pq[i] = *(const u32x4*)(qh + (size_t)((sc) * 64 + r) * 1024 + c * 8); pk[i] = *(const u32x4*)(kh + (size_t)((sc) * 64 + r) * 1024 + c * 8); } \
        _Pragma("unroll") for (int i = 0; i < 2; ++i) { const int pid = tid + 512 * i, r = pid >> 4, c = pid & 15; pv[i] = *(const u32x4*)(vh + (size_t)((sc) * 64 + r) * 2048 + c * 8); } } while (0)
        RET_LOAD(0);
        for (int sc = 0; sc < 32; ++sc) {
            int lane = lane0, fr = lane0 & 15, fq = lane0 >> 4;
            asm volatile("" : "+v"(lane), "+v"(fr), "+v"(fq));
            __syncthreads();
#pragma unroll
            for (int i = 0; i < 4; ++i) { const int pid = tid + 512 * i, r = pid >> 5, c = pid & 31; *(LAS u32x4*)(QI + swz(r, c * 16, 512)) = pq[i]; *(LAS u32x4*)(KI + swz(r, c * 16, 512)) = pk[i]; }
#pragma unroll
            for (int i = 0; i < 2; ++i) { const int pid = tid + 512 * i, r = pid >> 4, c = pid & 15; *(LAS u32x4*)(VI + swz(r, c * 16, 256)) = pv[i]; }
#pragma unroll
            for (int dt = 0; dt < 16; ++dt) { u32x2 zz; zz.x = cvt_pk_bf16(Z[dt][0], Z[dt][1]); zz.y = cvt_pk_bf16(Z[dt][2], Z[dt][3]); *(LAS u32x2*)(ZI + swz(16 * dt + fr, (16 * w + 4 * fq) * 2, 256)) = zz; }
            if (sc + 1 < 32) RET_LOAD(sc + 1);
            __syncthreads();
#pragma unroll
            for (int mi = 0; mi < 2; ++mi) { const int mt = 2 * hv + mi; f32x4 s = (f32x4){0.f, 0.f, 0.f, 0.f};
                if (mt <= tq) {
#pragma unroll
                    for (int ks = 0; ks < 8; ++ks) s = MFMA16(frag_row(KI, 16 * mt, ks * 64, 512, fr, fq), frag_row(QI, 16 * tq, ks * 64, 512, fr, fq), s);
                    if (mt == tq) {
#pragma unroll
                        for (int r = 0; r < 4; ++r) if (4 * fq + r > fr) s[r] = 0.f; }
                }
                u32x2 pp; pp.x = cvt_pk_bf16(s[0], s[1]); pp.y = cvt_pk_bf16(s[2], s[3]); *(LAS u32x2*)(PI + swz(16 * tq + fr, (16 * mt + 4 * fq) * 2, 128)) = pp; }
            bf16x8 va[2];
#pragma unroll
            for (int k2 = 0; k2 < 2; ++k2) va[k2] = frag_tr(VI, 32 * k2, 16 * w, 256, lane);
#pragma unroll
            for (int dt = 0; dt < 16; ++dt) { Z[dt] = Z[dt] * g64;
#pragma unroll
                for (int k2 = 0; k2 < 2; ++k2) Z[dt] = MFMA16(va[k2], frag_tr(KI, 32 * k2, 16 * dt, 512, lane), Z[dt]);
                if (dt & 1) asm volatile("" ::: "memory"); }
            asm volatile("" ::: "memory");
            f32x4 o[4];
#pragma unroll
            for (int vt = 0; vt < 4; ++vt) o[vt] = (f32x4){0.f, 0.f, 0.f, 0.f};
            asm volatile("" ::: "memory");
#pragma unroll
            for (int ks = 0; ks < 8; ++ks) { const bf16x8 qf = frag_row(QI, 16 * tq, ks * 64, 512, fr, fq);
#pragma unroll
                for (int vt = 0; vt < 4; ++vt) o[vt] = MFMA16(frag_tr(ZI, 32 * ks, 16 * (4 * hv + vt), 256, lane), qf, o[vt]);
                asm volatile("" ::: "memory"); }
            __syncthreads();
#pragma unroll
            for (int vt = 0; vt < 4; ++vt) o[vt] = o[vt] * g64;
#pragma unroll
            for (int k2 = 0; k2 < 2; ++k2) if (32 * k2 <= 16 * tq + 15) { const bf16x8 pb = frag_row(PI, 16 * tq, k2 * 64, 128, fr, fq);
#pragma unroll
                for (int vt = 0; vt < 4; ++vt) o[vt] = MFMA16(frag_tr(VI, 32 * k2, 16 * (4 * hv + vt), 256, lane), pb, o[vt]); }
            const int tokl = sc * 64 + 16 * tq + fr; float ss = 0.f;
#pragma unroll
            for (int vt = 0; vt < 4; ++vt) { ss += (o[vt][0] * o[vt][0] + o[vt][1] * o[vt][1]) + (o[vt][2] * o[vt][2] + o[vt][3] * o[vt][3]);
                u32x2 ww; ww.x = cvt_pk_bf16(o[vt][0], o[vt][1]); ww.y = cvt_pk_bf16(o[vt][2], o[vt][3]); *(u32x2*)(vh + (size_t)tokl * 2048 + 16 * (4 * hv + vt) + 4 * fq) = ww; }
            ss += __shfl_xor(ss, 16); ss += __shfl_xor(ss, 32);
            if (fq == 0) ssq[(((size_t)(b * SEQ + tokl) * 4 + h) * 4 + vs) * 2 + hv] = ss;
        }
#undef RET_LOAD
        __syncthreads();
    }
}

__device__ __forceinline__ int t5_bucket(int n) { if (n < 16) return n; const int l = 16 + (int)(__builtin_log2f((float)n * 0.0625f) * (16.0f / 7.0f)); return l > 31 ? 31 : l; }
__device__ __forceinline__ void attn_phase(LAS unsigned char* lds, bf16* qb, const bf16* kb, const bf16* vb, f32x2* ml, const float* rel_bias, int G, int bx, const int tid) {
    const int lane = tid & 63, w = __builtin_amdgcn_readfirstlane(tid >> 6), fr = lane & 15, fq = lane >> 4;
    LAS unsigned char* KI = lds; LAS unsigned char* VI = lds + 32768; LAS float* BT = (LAS float*)(lds + 65536);
    for (int unit = bx; unit < 1536; unit += G) {
        const int u4 = unit & 3, g = (unit >> 2) % 3, rest = unit / 12, h = rest & 15, bl = rest >> 4;
        const int R = g == 0 ? 1 : (g == 1 ? 4 : 16);
        __syncthreads();
        if (tid < 160) { const int steps = tid - 16; BT[tid] = (steps >= 0 && steps <= 128) ? rel_bias[t5_bucket(steps * R) * 48 + g * 16 + h] * 1.4426950408889634f : -1e30f; }
        const int s_first = (g == 0 && u4 > 0) ? -1 : 0;
        const bf16* kbase = kb + (size_t)bl * SEQ * 3072 + g * 1024 + h * 64; const bf16* vbase = vb + (size_t)bl * SEQ * 3072 + g * 1024 + h * 64;
        u32x4 pk[2], pv[2];
#define ATT_SEG(s, r, n) do { if (g == 0) { r = 0; n = 4 * u4 + (s); } else if (g == 1) { r = u4; n = (s); } else { r = 4 * u4 + (s); n = 0; } } while (0)
#define ATT_LOAD(s) do { int r_, n_; ATT_SEG(s, r_, n_); _Pragma("unroll") for (int i = 0; i < 2; ++i) { const int pid = tid + 512 * i, row = pid >> 3, c = pid & 7; \
            const size_t off = (size_t)((128 * n_ + row) * R + r_) * 3072 + c * 8; pk[i] = *(const u32x4*)(kbase + off); pv[i] = *(const u32x4*)(vbase + off); } } while (0)
        ATT_LOAD(s_first);
        int cnt = 0;
        for (int s = s_first; s < 4; ++s, ++cnt) {
            __syncthreads();
            const int cs = cnt & 1, ps = cs ^ 1;
#pragma unroll
            for (int i = 0; i < 2; ++i) { const int pid = tid + 512 * i, row = pid >> 3, c = pid & 7; *(LAS u32x4*)(KI + swz(cs * 128 + row, c * 16, 128)) = pk[i]; *(LAS u32x4*)(VI + swz(cs * 128 + row, c * 16, 128)) = pv[i]; }
            if (s < 3) ATT_LOAD(s + 1);
            __syncthreads();
            if (s < 0) continue;
            int r, n; ATT_SEG(s, r, n);
            const bool has_prev = n > 0;
            const size_t grow = (size_t)bl * SEQ + (size_t)(128 * n + 16 * w + fr) * R + r;
            bf16* qptr = qb + grow * 3072 + g * 1024 + h * 64;
            bf16x8 qf[2];
#pragma unroll
            for (int ks = 0; ks < 2; ++ks) qf[ks] = *(const bf16x8*)(qptr + ks * 32 + fq * 8);
            f32x4 sc[9]; float mx = -1e30f;
#pragma unroll
            for (int j = 0; j < 9; ++j) { const int kt = w + j; const bool valid = has_prev || kt >= 8;
                const int rb = (kt < 8) ? ps * 128 + 16 * kt : cs * 128 + 16 * (kt - 8);
                if (valid) { f32x4 a = (f32x4){0.f, 0.f, 0.f, 0.f};
#pragma unroll
                    for (int ks = 0; ks < 2; ++ks) a = MFMA16(frag_row(KI, rb, ks * 64, 128, fr, fq), qf[ks], a);
                    const int idx0 = fr + 144 - 16 * j - 4 * fq;
#pragma unroll
                    for (int rr = 0; rr < 4; ++rr) { a[rr] += BT[idx0 - rr]; mx = fmaxf(mx, a[rr]); }
                    sc[j] = a;
                } else sc[j] = (f32x4){-1e30f, -1e30f, -1e30f, -1e30f};
            }
            mx = fmaxf(mx, __shfl_xor(mx, 16)); mx = fmaxf(mx, __shfl_xor(mx, 32));
            float lsum = 0.f;
#pragma unroll
            for (int j = 0; j < 9; ++j)
#pragma unroll
                for (int rr = 0; rr < 4; ++rr) { const float p = __builtin_amdgcn_exp2f(sc[j][rr] - mx); sc[j][rr] = p; lsum += p; }
            lsum += __shfl_xor(lsum, 16); lsum += __shfl_xor(lsum, 32);
            f32x4 o[4];
#pragma unroll
            for (int dt = 0; dt < 4; ++dt) o[dt] = (f32x4){0.f, 0.f, 0.f, 0.f};
#pragma unroll
            for (int jj = 0; jj < 5; ++jj) { const int t0 = 2 * jj, t1 = 2 * jj + 1;
                union { bf16x8 v; unsigned u[4]; } pb;
                pb.u[0] = cvt_pk_bf16(sc[t0][0], sc[t0][1]); pb.u[1] = cvt_pk_bf16(sc[t0][2], sc[t0][3]);
                if (t1 < 9) { pb.u[2] = cvt_pk_bf16(sc[t1 < 9 ? t1 : 8][0], sc[t1 < 9 ? t1 : 8][1]); pb.u[3] = cvt_pk_bf16(sc[t1 < 9 ? t1 : 8][2], sc[t1 < 9 ? t1 : 8][3]); } else { pb.u[2] = 0u; pb.u[3] = 0u; }
                int kt0 = w + t0, kt1 = w + t1; if (kt1 > 15) kt1 = 15;
                const bool v0 = has_prev || kt0 >= 8, v1 = has_prev || kt1 >= 8;
                const int rb0 = (kt0 < 8) ? (v0 ? ps * 128 + 16 * kt0 : cs * 128 + 16 * kt0) : cs * 128 + 16 * (kt0 - 8);
                const int rb1 = (kt1 < 8) ? (v1 ? ps * 128 + 16 * kt1 : cs * 128 + 16 * kt1) : cs * 128 + 16 * (kt1 - 8);
#pragma unroll
                for (int dt = 0; dt < 4; ++dt) o[dt] = MFMA16(frag_tr2(VI, rb0, rb1, 16 * dt, 128, lane), pb.v, o[dt]); }
            const float il = 1.0f / lsum;
#pragma unroll
            for (int dt = 0; dt < 4; ++dt) { u32x2 ww; ww.x = cvt_pk_bf16(o[dt][0] * il, o[dt][1] * il); ww.y = cvt_pk_bf16(o[dt][2] * il, o[dt][3] * il); *(u32x2*)(qptr + 16 * dt + 4 * fq) = ww; }
            if (fq == 0) ml[(grow * 3 + g) * 16 + h] = (f32x2){mx, lsum};
        }
#undef ATT_SEG
#undef ATT_LOAD
    }
    __syncthreads();
}
__device__ __forceinline__ void merge_phase(bf16* qb, const f32x2* ml, int G, int bx, const int tid) {
    const size_t nitems = (size_t)TC * 16 * 8;
    for (size_t it = (size_t)bx * 512 + tid; it < nitems; it += (size_t)G * 512) {
        const int pc = (int)(it & 7), h = (int)((it >> 3) & 15); const size_t tok = it >> 7;
        f32x2 a[3]; float M = -3e38f;
#pragma unroll
        for (int g = 0; g < 3; ++g) { a[g] = ml[(tok * 3 + g) * 16 + h]; M = fmaxf(M, a[g].x); }
        float wg[3], W = 0.f;
#pragma unroll
        for (int g = 0; g < 3; ++g) { wg[g] = __builtin_amdgcn_exp2f(a[g].x - M) * a[g].y; W += wg[g]; }
        const float iw = 1.0f / W; float acc[8];
#pragma unroll
        for (int e = 0; e < 8; ++e) acc[e] = 0.f;
        bf16* p0 = qb + tok * 3072 + h * 64 + pc * 8;
#pragma unroll
        for (int g = 0; g < 3; ++g) { const u32x4 o = *(const u32x4*)(p0 + g * 1024); const float ww = wg[g] * iw;
            acc[0] += ww * bf_lo(o.x); acc[1] += ww * bf_hi(o.x); acc[2] += ww * bf_lo(o.y); acc[3] += ww * bf_hi(o.y); acc[4] += ww * bf_lo(o.z); acc[5] += ww * bf_hi(o.z); acc[6] += ww * bf_lo(o.w); acc[7] += ww * bf_hi(o.w); }
        u32x4 r; r.x = cvt_pk_bf16(acc[0], acc[1]); r.y = cvt_pk_bf16(acc[2], acc[3]); r.z = cvt_pk_bf16(acc[4], acc[5]); r.w = cvt_pk_bf16(acc[6], acc[7]);
        *(u32x4*)p0 = r;
    }
}
__device__ __forceinline__ void router_phase(LAS unsigned char* lds, const float* hbuf, const float* wr  , const float* bg, const float* be, bf16* xn, int* list, float* gatew, unsigned* cnt, int G, int vcu, const int tid) {
    const int lane = tid & 63, w = __builtin_amdgcn_readfirstlane(tid >> 6);
    for (int i = tid; i < 9216; i += 512) *(LAS u32x4*)(lds + i * 16) = *(const u32x4*)((const char*)wr + i * 16);
    __syncthreads();
    const LAS float* WL = (const LAS float*)lds;
    for (int tk = vcu * NWAVES + w; tk < T; tk += G * NWAVES) {
        const GAS f32x4* xr = (const GAS f32x4*)(hbuf + (size_t)tk * D) + lane;
        f32x4 v[4]; float s = 0.f;
#pragma unroll
        for (int j = 0; j < 4; ++j) { v[j] = xr[64 * j]; s += (v[j].x * v[j].x + v[j].y * v[j].y) + (v[j].z * v[j].z + v[j].w * v[j].w); }
        const float rs = __builtin_amdgcn_rsqf(wave_sum(s) * (1.f / D) + 1e-6f);
        GAS unsigned long long* o8 = (GAS unsigned long long*)(xn + (size_t)tk * D) + lane;
        float a[36];
#pragma unroll
        for (int j = 0; j < 36; ++j) a[j] = 0.f;
#pragma unroll
        for (int j = 0; j < 4; ++j) { v[j] = v[j] * rs; o8[64 * j] = (unsigned long long)pk2(v[j].x, v[j].y) | ((unsigned long long)pk2(v[j].z, v[j].w) << 32);
#pragma unroll
            for (int e = 0; e < 4; ++e) { const float x = v[j][e]; const LAS f32x4* wp = (const LAS f32x4*)(WL + (e * 256 + 64 * j + lane) * 36);
#pragma unroll
                for (int q = 0; q < 9; ++q) { const f32x4 ww = wp[q]; a[4 * q] = fmaf(x, ww[0], a[4 * q]); a[4 * q + 1] = fmaf(x, ww[1], a[4 * q + 1]); a[4 * q + 2] = fmaf(x, ww[2], a[4 * q + 2]); a[4 * q + 3] = fmaf(x, ww[3], a[4 * q + 3]); }
                asm volatile("" ::: "memory"); } }
#pragma unroll
        for (int j = 0; j < 36; ++j) a[j] = wave_sum(a[j]);
        if (lane == 0) {
            float gl[4];
#pragma unroll
            for (int g = 0; g < 4; ++g) gl[g] = a[g] + bg[g];
            int grp = 0; float gbest = gl[0];
#pragma unroll
            for (int g = 1; g < 4; ++g) if (gl[g] > gbest) { gbest = gl[g]; grp = g; }
            float den = 0.f;
#pragma unroll
            for (int g = 0; g < 4; ++g) den += __expf(gl[g] - gbest);
            const float pg = 1.0f / den;
            float el[8];
#pragma unroll
            for (int e = 0; e < 8; ++e) { float vv = 0.f;
#pragma unroll
                for (int g = 0; g < 4; ++g) if (g == grp) vv = a[4 + g * 8 + e] + be[g * 8 + e];
                el[e] = vv; }
            int i0 = 0; float v0 = el[0];
#pragma unroll
            for (int e = 1; e < 8; ++e) if (el[e] > v0) { v0 = el[e]; i0 = e; }
            int i1 = -1; float v1 = -3.0e38f;
#pragma unroll
            for (int e = 0; e < 8; ++e) if (e != i0 && (i1 < 0 || el[e] > v1)) { v1 = el[e]; i1 = e; }
            const float e1 = __expf(v1 - v0); const float g0 = 1.0f / (1.0f + e1), g1 = e1 / (1.0f + e1);
            const int b0 = grp * 8 + i0, b1 = 32 + grp * 8 + i1;
            const unsigned p0 = __hip_atomic_fetch_add(cnt + b0, 1u, __ATOMIC_RELAXED, __HIP_MEMORY_SCOPE_AGENT);
            const unsigned p1 = __hip_atomic_fetch_add(cnt + b1, 1u, __ATOMIC_RELAXED, __HIP_MEMORY_SCOPE_AGENT);
            list[(size_t)b0 * T + p0] = tk; list[(size_t)b1 * T + p1] = tk;
            gatew[tk * 2] = g0 * pg; gatew[tk * 2 + 1] = g1 * pg;
        }
    }
    __syncthreads();
}
struct Args { const float* in[19]; float* out; unsigned char* ws; int ph_lo, ph_hi, flags, pad; };
enum { IN_X = 0, IN_RET_WIN, IN_RET_WOUT, IN_KV_NORM, IN_W_KV, IN_K_NORM, IN_DIL_WQ, IN_Q_NORM, IN_DIL_WO, IN_REL_BIAS, IN_MIXER_NORM, IN_FFN_NORM, IN_RGRP, IN_RGRP_B, IN_REXP, IN_REXP_B, IN_EGATE, IN_EUP, IN_EDOWN };
constexpr int NPHASE = 24;
#ifndef MK_PHMASK
#define MK_PHMASK 0xffffffu
#endif
struct PhaseCtx { int tid, lane, wave, G, bx, vcu, gw, NGW; unsigned char* ws; float* hout; };
__device__ __forceinline__ PhaseCtx phase_ctx(const Args& args, int wave_s) {
    PhaseCtx c; int tid = (wave_s << 6) | lane_id(), bx = blockIdx.x, G = gridDim.x; unsigned char* ws = args.ws; float* hout = args.out;
    asm volatile("" : "+v"(tid), "+s"(bx), "+s"(G), "+s"(ws), "+s"(hout));
    c.tid = tid; c.lane = tid & 63; c.wave = __builtin_amdgcn_readfirstlane(tid >> 6); c.G = G; c.bx = bx; c.vcu = (G % 8 == 0) ? (bx % 8) * (G / 8) + bx / 8 : bx;
    c.gw = c.vcu * NWAVES + c.wave; c.NGW = G * NWAVES; c.ws = ws; c.hout = hout; return c;
}
__device__ __forceinline__ void pro_s1(const Args& args, const PhaseCtx& c, LAS unsigned char* lds) {
    unsigned char* ws = c.ws; LAS float* scr = (LAS float*)(lds + c.wave * 16384); const int gw = c.gw, NGW = c.NGW, lane = c.lane;
    float* cosT = (float*)(ws + WS_COS); float* sinT = (float*)(ws + WS_SIN); bf16* xn = (bf16*)(ws + WS_XN); const float* x = args.in[IN_X];
    transpose_matrix(args.in[IN_RET_WIN], 1024, 6144, (bf16*)(ws + WS_WIN), scr, gw, NGW, lane, args.in[IN_MIXER_NORM], MapWin{});
    transpose_matrix(args.in[IN_RET_WOUT], 2048, 1024, (bf16*)(ws + WS_WOUT), scr, gw, NGW, lane, nullptr, MapId{0});
    for (int i = gw * 64 + lane; i < SEQ * 128; i += NGW * 64) { const int pos = i >> 7, j = i & 127;
        const float inv = 1.0f / __builtin_amdgcn_exp2f((float)j * (13.287712379549449f / 127.0f));
        const float ang = (float)pos * inv; const double rev = (double)ang * 0.15915494309189535;
        const float frc = (float)(rev - floor(rev + 0.5)) * 6.283185307179586f;
        cosT[i] = __cosf(frc); sinT[i] = __sinf(frc); }
    for (int m = gw; m < T; m += NGW) rms_row_to_bf16(x + (size_t)m * D, xn + (size_t)m * D, lane);
}
__device__ __forceinline__ void pro_moe(const Args& args, const PhaseCtx& c, LAS unsigned char* lds, int L) {
    unsigned char* ws = c.ws; LAS float* scr = (LAS float*)(lds + c.wave * 16384); const int gw = c.gw, NGW = c.NGW, lane = c.lane;
    bf16* wgu = (bf16*)(ws + (L ? WS_WGU1 : WS_WGU0)); bf16* wd = (bf16*)(ws + (L ? WS_WD1 : WS_WD0));
    const float* gain = args.in[IN_FFN_NORM] + L * D;
    for (int it = gw; it < NEXP * 768; it += NGW) { const int e = it / 768, r = it % 768, which = r >> 8, item = r & 255; const size_t eo = (size_t)(L * NEXP + e);
        if (which == 0) transpose_item(args.in[IN_EGATE] + eo * D * FF, FF, wgu + (size_t)e * 1024 * 1024, 1024, scr, item, lane, gain, MapGu{0});
        else if (which == 1) transpose_item(args.in[IN_EUP] + eo * D * FF, FF, wgu + (size_t)e * 1024 * 1024, 1024, scr, item, lane, gain, MapGu{1});
        else transpose_item(args.in[IN_EDOWN] + eo * FF * D, D, wd + (size_t)e * 1024 * 512, 512, scr, item, lane, nullptr, MapId{0}); }
    float* wr = (float*)(ws + WS_WR) + (size_t)L * 1024 * 36;
    for (int i = gw * 64 + lane; i < 1024 * 36; i += NGW * 64) { const int p = i / 36, j = i % 36, k = ((p & 255) << 2) | (p >> 8);
        wr[i] = gain[k] * (j < 4 ? args.in[IN_RGRP][((size_t)L * D + k) * 4 + j] : args.in[IN_REXP][((size_t)L * D + k) * 32 + (j - 4)]); }
}
__device__ __forceinline__ void pro_s3(const Args& args, const PhaseCtx& c, LAS unsigned char* lds) {
    unsigned char* ws = c.ws; LAS float* scr = (LAS float*)(lds + c.wave * 16384); const int gw = c.gw, NGW = c.NGW, lane = c.lane;
    transpose_matrix(args.in[IN_DIL_WQ], 1024, 3072, (bf16*)(ws + WS_WQKV1), scr, gw, NGW, lane, args.in[IN_MIXER_NORM] + D, MapQkv1{0});
    transpose_matrix(args.in[IN_W_KV], 1024, 6144, (bf16*)(ws + WS_WQKV1), scr, gw, NGW, lane, args.in[IN_KV_NORM], MapQkv1{3072});
    transpose_matrix(args.in[IN_DIL_WO], 1024, 1024, (bf16*)(ws + WS_WO1), scr, gw, NGW, lane, nullptr, MapId{0});
    if (gw == 0) { float* gt = (float*)(ws + WS_WR + 512 * 1024); for (int i = lane; i < 192; i += 64) { gt[i] = args.in[IN_Q_NORM][i]; gt[192 + i] = args.in[IN_K_NORM][i]; } }
}

__global__ void __launch_bounds__(NWAVES * 64, 2) mk_fwd(Args args) {
    extern __shared__ __attribute__((aligned(16))) unsigned char lds_raw[];
    LAS unsigned char* lds = (LAS unsigned char*)lds_raw;
    volatile LAS unsigned* MISC = (volatile LAS unsigned*)(lds + LDS_MISC);
    LAS int* TAB = (LAS int*)(lds + LDS_MISC + 64);
    const int wave_s = __builtin_amdgcn_readfirstlane(threadIdx.x >> 6);
    if (threadIdx.x < 4) MISC[threadIdx.x] = 0u;
    __syncthreads();
    XcdBarrier bar = xcd_barrier_post((unsigned*)(args.ws + WS_CTL) + CW_BAR, MISC, threadIdx.x == 0);
    int lo = args.ph_lo, hi = args.ph_hi, flg = args.flags;
#define RELAUNDER() asm volatile("" : "+s"(lo), "+s"(hi), "+s"(flg))
#define fullpro ((flg & 1) != 0)
#define IN(k) ((((MK_PHMASK) >> (k)) & 1u) && lo <= (k) && (k) < hi)
#define SEAM(k) do { asm volatile("; SEAM_MARK %0" :: "n"(k)); if (IN(k) && IN((k) + 1)) xcd_barrier(bar, wave_s); } while (0)

    if (IN(0)) { const PhaseCtx c = phase_ctx(args, wave_s); pro_s1(args, c, lds); if (fullpro) { pro_moe(args, c, lds, 0); pro_s3(args, c, lds); pro_moe(args, c, lds, 1); } }
    SEAM(0);
    if (IN(1)) { const PhaseCtx c = phase_ctx(args, wave_s); unsigned char* ws = c.ws;
        P_QKV0 p; p.A = (const char*)(ws + WS_XN); p.Bt = (const char*)(ws + WS_WIN); p.lda = 2048; p.ldb = 2048; p.K = 1024; p.so.init(T, 4096, c.G, c.bx);
        p.qk = (bf16*)(ws + WS_Q0); p.v = (bf16*)(ws + WS_V0); p.cs = (const float*)(ws + WS_COS); p.sn = (const float*)(ws + WS_SIN);
        gemm_phase(lds, p, c.tid); }
    SEAM(1);
    if (IN(2)) { const PhaseCtx c = phase_ctx(args, wave_s); unsigned char* ws = c.ws;
        retention_phase(lds, (const bf16*)(ws + WS_Q0), (const bf16*)(ws + WS_K0), (bf16*)(ws + WS_V0), (float*)(ws + WS_SSQ), c.G, c.bx, c.tid); }
    SEAM(2);
    if (IN(3)) { const PhaseCtx c = phase_ctx(args, wave_s); unsigned char* ws = c.ws;
        P_GATE p; p.A = (const char*)(ws + WS_XN); p.Bt = (const char*)(ws + WS_WIN) + (size_t)4096 * 2048; p.lda = 2048; p.ldb = 2048; p.K = 1024; p.so.init(T, 2048, c.G, c.bx);
        p.ov = (bf16*)(ws + WS_V0); p.ssq = (const float*)(ws + WS_SSQ);
        gemm_phase(lds, p, c.tid); }
    SEAM(3);
    if (IN(4)) { const PhaseCtx c = phase_ctx(args, wave_s); unsigned char* ws = c.ws;
        P_RES p; p.A = (const char*)(ws + WS_V0); p.Bt = (const char*)(ws + WS_WOUT); p.lda = 4096; p.ldb = 4096; p.K = 2048; p.so.init(T, 1024, c.G, c.bx);
        p.res = args.in[IN_X]; p.out = c.hout; p.row_off = 0;
        gemm_phase(lds, p, c.tid); }
    SEAM(4);
#pragma unroll 1
    for (int L = 0; L < 2; ++L) {
        RELAUNDER();
        const int P0 = L ? 19 : 5;
#define INL(k0, k1) (L ? IN(k1) : IN(k0))
#define SEAML(k0, k1) do { if (L) SEAM(k1); else SEAM(k0); } while (0)
        if (L == 1) {
            if (IN(10)) { const PhaseCtx c = phase_ctx(args, wave_s); if (!fullpro) pro_s3(args, c, lds); bf16* xn = (bf16*)(c.ws + WS_XN);
                const int nrows = (flg & 2) ? TC : T; for (int m = c.gw; m < nrows; m += c.NGW) rms_row_to_bf16(c.hout + (size_t)m * D, xn + (size_t)m * D, c.lane); }
            SEAM(10);
#pragma unroll 1
            for (int ch = 0; ch < 2; ++ch) {
                RELAUNDER();
#define INC(k) (ch ? IN((k) + 4) : IN(k))
#define SEAMC(k) do { if (ch) SEAM((k) + 4); else SEAM(k); } while (0)
                if (INC(11)) { const PhaseCtx c = phase_ctx(args, wave_s); unsigned char* ws = c.ws;
                    P_QKV1 p; p.A = (const char*)(ws + WS_XN) + (size_t)ch * TC * D * 2; p.Bt = (const char*)(ws + WS_WQKV1); p.lda = 2048; p.ldb = 2048; p.K = 1024; p.so.init(TC, 9216, c.G, c.bx);
                    p.qkv = (bf16*)(ws + WS_Q1); p.gains = (const float*)(ws + WS_WR + 512 * 1024);
                    gemm_phase(lds, p, c.tid); }
                SEAMC(11);
                if (INC(12)) { const PhaseCtx c = phase_ctx(args, wave_s); unsigned char* ws = c.ws;
                    attn_phase(lds, (bf16*)(ws + WS_Q1), (const bf16*)(ws + WS_K1), (const bf16*)(ws + WS_V1), (f32x2*)(ws + WS_ML), args.in[IN_REL_BIAS], c.G, c.bx, c.tid); }
                SEAMC(12);
                if (INC(13)) { const PhaseCtx c = phase_ctx(args, wave_s); merge_phase((bf16*)(c.ws + WS_Q1), (const f32x2*)(c.ws + WS_ML), c.G, c.bx, c.tid); }
                SEAMC(13);
                if (INC(14)) { const PhaseCtx c = phase_ctx(args, wave_s); unsigned char* ws = c.ws;
                    P_RES p; p.A = (const char*)(ws + WS_Q1); p.Bt = (const char*)(ws + WS_WO1); p.lda = 6144; p.ldb = 2048; p.K = 1024; p.so.init(TC, 1024, c.G, c.bx);
                    p.res = c.hout; p.out = c.hout; p.row_off = ch * TC;
                    gemm_phase(lds, p, c.tid); }
                SEAMC(14);
#undef INC
#undef SEAMC
            }
        }
        if (INL(5, 19)) { const PhaseCtx c = phase_ctx(args, wave_s); if (!fullpro) pro_moe(args, c, lds, L); }
        SEAML(5, 19);
        if (INL(6, 20)) { const PhaseCtx c = phase_ctx(args, wave_s); unsigned char* ws = c.ws;
            router_phase(lds, c.hout, (const float*)(ws + WS_WR) + (size_t)L * 1024 * 36, args.in[IN_RGRP_B] + L * 4, args.in[IN_REXP_B] + L * 32, (bf16*)(ws + WS_XN), (int*)(ws + WS_LIST), (float*)(ws + WS_GATEW),
                         (unsigned*)(ws + WS_CTL) + CW_CNT + L * 64, c.G, c.vcu, c.tid); }
        SEAML(6, 20);
        if (INL(7, 21) || INL(8, 22) || INL(9, 23)) { const PhaseCtx c = phase_ctx(args, wave_s); moe_build_tab(TAB, (const unsigned*)(c.ws + WS_CTL) + CW_CNT + L * 64, c.tid); }
        if (INL(7, 21)) { const PhaseCtx c = phase_ctx(args, wave_s); unsigned char* ws = c.ws;
            P_GU p; p.xn = (const char*)(ws + WS_XN); p.W = (const char*)(ws + (L ? WS_WGU1 : WS_WGU0)); p.list = (const int*)(ws + WS_LIST); p.hid = (bf16*)(ws + WS_HID); p.tab = TAB; p.G = c.G; p.vcu = c.vcu; p.K = 1024; p.lda = 2048; p.ldb = 2048;
            gemm_phase(lds, p, c.tid); }
        SEAML(7, 21);
#pragma unroll 1
        for (int slot = 0; slot < 2; ++slot) {
            RELAUNDER();
            if (slot ? INL(9, 23) : INL(8, 22)) { const PhaseCtx c = phase_ctx(args, wave_s); unsigned char* ws = c.ws;
                P_DN p; p.hid = (const char*)(ws + WS_HID); p.W = (const char*)(ws + (L ? WS_WD1 : WS_WD0)); p.list = (const int*)(ws + WS_LIST); p.gatew = (const float*)(ws + WS_GATEW); p.h = c.hout; p.tab = TAB; p.G = c.G; p.vcu = c.vcu; p.slot = slot; p.K = 512; p.lda = 1024; p.ldb = 1024;
                gemm_phase(lds, p, c.tid); }
            if (slot) SEAML(9, 23); else SEAML(8, 22);
        }
#undef INL
#undef SEAML
        (void)P0;
    }
#undef IN
#undef SEAM
#undef RELAUNDER
#undef fullpro
}
}
#ifndef MK_MASK
#define MK_MASK 15
#endif
#ifndef MK_SPLIT
#define MK_SPLIT 0
#endif

#ifdef MK_DEBUG
namespace dbg {
__global__ void k_cmp(const float* a, const float* b, size_t n, unsigned long long* acc) {
    double num = 0.0, den = 0.0; unsigned long long bad = 0;
    for (size_t i = (size_t)blockIdx.x * blockDim.x + threadIdx.x; i < n; i += (size_t)gridDim.x * blockDim.x) { const float x = a[i], y = b[i]; const float d = x - y; if (!(d - d == 0.0f)) { ++bad; continue; } num += (double)d * d; den += (double)x * x; }
    for (int o = 32; o >= 1; o >>= 1) { num += __shfl_xor(num, o); den += __shfl_xor(den, o); bad += __shfl_xor(bad, o); }
    if ((threadIdx.x & 63) == 0) { atomicAdd(acc, (unsigned long long)(num * 1048576.0)); atomicAdd(acc + 1, (unsigned long long)(den * 1048576.0)); atomicAdd(acc + 2, bad); }
}
__global__ void k_code(const unsigned long long* acc, float* scale) {
    const double num = (double)acc[0], den = (double)acc[1]; const double e = sqrt(num / (den + 1.0));
    int code = e < 0.01 ? 0 : (e < 0.03 ? 1 : (e < 0.1 ? 2 : (e < 0.3 ? 3 : (e < 1.0 ? 4 : 5)))); if (acc[2]) code = 7;
    scale[0] = 1.0f + 0.1f * (float)code;
}
__global__ void k_cmp_bf(const unsigned short* nw, const float* ref, int ldr, int offr, int mode, unsigned long long* acc, int tlo = 0, int thi = 2048) {
    double num = 0.0, den = 0.0; unsigned long long bad = 0;
    const size_t n = mode < 2 ? (size_t)2048 * 1024 : (size_t)2048 * 2048;
    for (size_t i = (size_t)blockIdx.x * blockDim.x + threadIdx.x; i < n; i += (size_t)gridDim.x * blockDim.x) {
        float x, y;
        if (mode < 2) { const int t = (int)(i >> 10), col = (int)(i & 1023), hh = col >> 8, d = col & 255, c = d < 128 ? 2 * d : 2 * (d - 128) + 1;
            const float l2g = log2f(1.0f - exp2f(-5.0f - (float)hh)); const float sc = exp2f((mode == 0 ? -l2g : l2g) * (float)(t & 63));
            y = __uint_as_float(((unsigned)nw[(size_t)t * 1024 + hh * 256 + c]) << 16) * sc; x = ref[(size_t)t * ldr + offr + col]; }
        else { const int t = (int)(i >> 11), col = (int)(i & 2047); if (t < tlo || t >= thi) continue; y = __uint_as_float(((unsigned)nw[(size_t)t * 2048 + col]) << 16); x = ref[(size_t)t * ldr + offr + col]; }
        const float dd = x - y; if (!(dd - dd == 0.0f)) { ++bad; continue; } num += (double)dd * dd; den += (double)x * x; }
    for (int o = 32; o >= 1; o >>= 1) { num += __shfl_xor(num, o); den += __shfl_xor(den, o); bad += __shfl_xor(bad, o); }
    if ((threadIdx.x & 63) == 0) { atomicAdd(acc, (unsigned long long)(num * 1048576.0)); atomicAdd(acc + 1, (unsigned long long)(den * 1048576.0)); atomicAdd(acc + 2, bad); }
}
__device__ inline int code_of(const unsigned long long* acc) { const double e = sqrt((double)acc[0] / ((double)acc[1] + 1.0)); int code = e < 0.01 ? 0 : (e < 0.03 ? 1 : (e < 0.1 ? 2 : (e < 0.3 ? 3 : (e < 1.0 ? 4 : 5)))); if (acc[2]) code = 7; return code; }
__global__ void k_code3(const unsigned long long* acc, float* scale) { scale[0] = 1.0f + 0.1f * (float)code_of(acc); scale[1] = 100.0f * (float)(code_of(acc + 4) + 1) + 10.0f * (float)code_of(acc + 8); }
__global__ void k_spike(float* out, const float* scale) { out[0] += scale[1]; }
__global__ void k_scale(float* out, const float* scale, size_t n) { const float s = scale[0]; for (size_t i = (size_t)blockIdx.x * blockDim.x + threadIdx.x; i < n; i += (size_t)gridDim.x * blockDim.x) out[i] *= s; }
}
#endif
extern "C" void kernel_launch(void* const* d_in, const int* in_sizes, int n_in, void* d_out, int out_size, void* d_ws, size_t ws_size, hipStream_t stream) {
    (void)in_sizes; (void)n_in; (void)out_size;
    if (ws_size < mk::WS_END) return;
    static int configured = 0;
    if (!configured) { if (hipFuncSetAttribute((const void*)mk::mk_fwd, hipFuncAttributeMaxDynamicSharedMemorySize, mk::LDS_BYTES) != hipSuccess) return; configured = 1; }
    mk::Args a{};
    for (int i = 0; i < 19; ++i) a.in[i] = (const float*)d_in[i];
    a.out = (float*)d_out; a.ws = (unsigned char*)d_ws; a.pad = 0;
    const int mask = MK_MASK;
    auto run_new = [&](int lo, int hi, int flags) {
        (void)hipMemsetAsync((char*)d_ws + mk::WS_CTL, 0, mk::CTL_BYTES, stream);
        if (MK_SPLIT) { for (int p = lo; p < hi; ++p) { a.ph_lo = p; a.ph_hi = p + 1; a.flags = flags; hipLaunchKernelGGL(mk::mk_fwd, dim3(256), dim3(512), mk::LDS_BYTES, stream, a); } }
        else { a.ph_lo = lo; a.ph_hi = hi; a.flags = flags; hipLaunchKernelGGL(mk::mk_fwd, dim3(256), dim3(512), mk::LDS_BYTES, stream, a); }
    };
#ifdef MK_DEBUG
    {
        const size_t MiB = mk::MiB; const size_t nall = (size_t)mk::T * mk::D;
        if (ws_size < 580 * MiB) return;
        nv::Ctx c; nv::ctx_init(c, d_in, d_out, d_ws, stream);
        unsigned long long* acc = (unsigned long long*)((char*)d_ws + 575 * MiB); float* scl = (float*)((char*)d_ws + 575 * MiB + 256);
        float* dout = (float*)d_out; float* alt = nullptr; size_t ncmp = nall;
        if (MK_DEBUG == 1) { nv::stage_mixer0(c); alt = (float*)((char*)d_ws + mk::WS_Q0); a.out = alt; run_new(0, 5, 0); }
        else if (MK_DEBUG == 11) {
            nv::stage_mixer0(c);
            float* xn_n = (float*)((char*)d_ws + 62 * MiB); float* pj_n = (float*)((char*)d_ws + 70 * MiB); float* oc_n = (float*)((char*)d_ws + 118 * MiB);
            (void)hipMemsetAsync(acc, 0, 512, stream);
            run_new(0, 2, 0);
            hipLaunchKernelGGL(nv::k_rmsnorm, dim3(2048 / 4), dim3(256), 0, stream, c.x, c.mixer_norm, xn_n, 2048);
            { nv::GemmP g{}; g.A = xn_n; g.lda = 1024; g.B = c.ret_w_in; g.ldb = 6144; g.C = pj_n; g.ldc = 6144; g.M = 2048; g.N = 6144; g.K = 1024; g.mode = 0; nv::gemm(stream, g); }
            hipLaunchKernelGGL(nv::k_rotary, dim3(2048 * 1024 / 256), dim3(256), 0, stream, pj_n, 2048);
            hipLaunchKernelGGL(dbg::k_cmp_bf, dim3(512), dim3(256), 0, stream, (const unsigned short*)((char*)d_ws + mk::WS_Q0), (const float*)pj_n, 6144, 0, 0, acc);
            hipLaunchKernelGGL(dbg::k_cmp_bf, dim3(512), dim3(256), 0, stream, (const unsigned short*)((char*)d_ws + mk::WS_K0), (const float*)pj_n, 6144, 1024, 1, acc);
            hipLaunchKernelGGL(dbg::k_cmp_bf, dim3(512), dim3(256), 0, stream, (const unsigned short*)((char*)d_ws + mk::WS_V0), (const float*)pj_n, 6144, 2048, 2, acc);
            run_new(2, 3, 0);
            hipLaunchKernelGGL(nv::k_retention, dim3(64, 4, 1), dim3(256), 0, stream, (const float*)pj_n, oc_n);
            hipLaunchKernelGGL(dbg::k_cmp_bf, dim3(512), dim3(256), 0, stream, (const unsigned short*)((char*)d_ws + mk::WS_V0), (const float*)oc_n, 2048, 0, 2, acc + 4);
            run_new(3, 4, 0);
            hipLaunchKernelGGL(nv::k_gnorm_gate, dim3(2048), dim3(256), 0, stream, oc_n, (const float*)pj_n, 2048);
            hipLaunchKernelGGL(dbg::k_cmp_bf, dim3(512), dim3(256), 0, stream, (const unsigned short*)((char*)d_ws + mk::WS_V0), (const float*)oc_n, 2048, 0, 2, acc + 8);
            hipLaunchKernelGGL(dbg::k_code3, dim3(1), dim3(1), 0, stream, (const unsigned long long*)acc, scl);
            nv::stage_moe(c, 0); nv::stage_mixer1(c); nv::stage_moe(c, 1);
            hipLaunchKernelGGL(dbg::k_scale, dim3(1024), dim3(256), 0, stream, dout, (const float*)scl, nall);
            hipLaunchKernelGGL(dbg::k_spike, dim3(1), dim3(1), 0, stream, dout, (const float*)scl);
            return;
        }
        else if (MK_DEBUG == 12) {
            nv::stage_mixer0(c);
            float* xn_n = (float*)((char*)d_ws + 62 * MiB); float* pj_n = (float*)((char*)d_ws + 70 * MiB); float* oc_n = (float*)((char*)d_ws + 118 * MiB);
            (void)hipMemsetAsync(acc, 0, 512, stream);
            run_new(0, 3, 0);
            hipLaunchKernelGGL(nv::k_rmsnorm, dim3(2048 / 4), dim3(256), 0, stream, c.x, c.mixer_norm, xn_n, 2048);
            { nv::GemmP g{}; g.A = xn_n; g.lda = 1024; g.B = c.ret_w_in; g.ldb = 6144; g.C = pj_n; g.ldc = 6144; g.M = 2048; g.N = 6144; g.K = 1024; g.mode = 0; nv::gemm(stream, g); }
            hipLaunchKernelGGL(nv::k_rotary, dim3(2048 * 1024 / 256), dim3(256), 0, stream, pj_n, 2048);
            hipLaunchKernelGGL(nv::k_retention, dim3(64, 4, 1), dim3(256), 0, stream, (const float*)pj_n, oc_n);
            hipLaunchKernelGGL(dbg::k_cmp_bf, dim3(512), dim3(256), 0, stream, (const unsigned short*)((char*)d_ws + mk::WS_V0), (const float*)oc_n, 2048, 0, 2, acc, 0, 64);
            hipLaunchKernelGGL(dbg::k_cmp_bf, dim3(512), dim3(256), 0, stream, (const unsigned short*)((char*)d_ws + mk::WS_V0), (const float*)oc_n, 2048, 0, 2, acc + 4, 64, 128);
            hipLaunchKernelGGL(dbg::k_cmp_bf, dim3(512), dim3(256), 0, stream, (const unsigned short*)((char*)d_ws + mk::WS_V0), (const float*)oc_n, 2048, 0, 2, acc + 8, 128, 2048);
            hipLaunchKernelGGL(dbg::k_code3, dim3(1), dim3(1), 0, stream, (const unsigned long long*)acc, scl);
            nv::stage_moe(c, 0); nv::stage_mixer1(c); nv::stage_moe(c, 1);
            hipLaunchKernelGGL(dbg::k_scale, dim3(1024), dim3(256), 0, stream, dout, (const float*)scl, nall);
            hipLaunchKernelGGL(dbg::k_spike, dim3(1), dim3(1), 0, stream, dout, (const float*)scl);
            return;
        }
        else nv::stage_mixer0(c);
        if (MK_DEBUG == 2) { alt = (float*)((char*)d_ws + 446 * MiB); (void)hipMemcpyAsync(alt, dout, nall * 4, hipMemcpyDeviceToDevice, stream); nv::stage_moe(c, 0); a.out = alt; run_new(5, 10, 0); }
        else if (MK_DEBUG > 2) nv::stage_moe(c, 0);
        if (MK_DEBUG == 3) { alt = (float*)((char*)d_ws + 510 * MiB); ncmp = (size_t)mk::TC * mk::D; (void)hipMemcpyAsync(alt, dout, ncmp * 4, hipMemcpyDeviceToDevice, stream); nv::stage_mixer1(c); a.out = alt; run_new(10, 15, 2); }
        else if (MK_DEBUG > 3) nv::stage_mixer1(c);
        if (MK_DEBUG == 4) { alt = (float*)((char*)d_ws + 446 * MiB); (void)hipMemcpyAsync(alt, dout, nall * 4, hipMemcpyDeviceToDevice, stream); nv::stage_moe(c, 1); a.out = alt; run_new(19, 24, 0); }
        (void)hipMemsetAsync(acc, 0, 512, stream);
        hipLaunchKernelGGL(dbg::k_cmp, dim3(1024), dim3(256), 0, stream, (const float*)dout, (const float*)alt, ncmp, acc);
        hipLaunchKernelGGL(dbg::k_code, dim3(1), dim3(1), 0, stream, (const unsigned long long*)acc, scl);
        if (MK_DEBUG < 2) nv::stage_moe(c, 0);
        if (MK_DEBUG < 3) nv::stage_mixer1(c);
        if (MK_DEBUG < 4) nv::stage_moe(c, 1);
        hipLaunchKernelGGL(dbg::k_scale, dim3(1024), dim3(256), 0, stream, dout, (const float*)scl, nall);
        return;
    }
#endif
    if (mask == 15) { run_new(0, mk::NPHASE, MK_SPLIT ? 0 : 1); return; }
#ifdef MK_WITH_NAIVE
    nv::Ctx c; nv::ctx_init(c, d_in, d_out, d_ws, stream);
    if (mask & 1) run_new(0, 5, 0); else nv::stage_mixer0(c);
    if (mask & 2) run_new(5, 10, 0); else nv::stage_moe(c, 0);
    if (mask & 4) run_new(10, 19, 0); else nv::stage_mixer1(c);
    if (mask & 8) run_new(19, 24, 0); else nv::stage_moe(c, 1);
#endif
}
```

```cpp
#include <hip/hip_runtime.h>
#include <cstdio>
#include <cstdint>
#define MK_MASK 15
#define MK_SPLIT 0
namespace mk {
#define LAS __attribute__((address_space(3)))
#define GAS __attribute__((address_space(1)))
typedef unsigned short bf16;
typedef short bf16x8 __attribute__((ext_vector_type(8)));
typedef short s16x4 __attribute__((ext_vector_type(4)));
typedef float f32x4 __attribute__((ext_vector_type(4)));
typedef float f32x2 __attribute__((ext_vector_type(2)));
typedef unsigned u32x4 __attribute__((ext_vector_type(4)));
typedef unsigned u32x2 __attribute__((ext_vector_type(2)));
typedef GAS unsigned gu32;

constexpr int T = 32768, D = 1024, SEQ = 2048, NB = 16;
constexpr int NEXP = 32, FF = 512;
constexpr int TC = 16384;
constexpr size_t MiB = 1u << 20;
constexpr size_t WS_CTL = 0, CTL_BYTES = 1 * MiB;
constexpr size_t WS_COS = 1 * MiB, WS_SIN = 2 * MiB, WS_WR = 3 * MiB;
constexpr size_t WS_SSQ = 4 * MiB, WS_ML = 8 * MiB, WS_LIST = 16 * MiB, WS_GATEW = 24 * MiB;
constexpr size_t WS_WIN = 26 * MiB, WS_WOUT = 38 * MiB, WS_WQKV1 = 42 * MiB, WS_WO1 = 60 * MiB;
constexpr size_t WS_WGU1 = 62 * MiB, WS_WD1 = 126 * MiB;
constexpr size_t WS_XN = 158 * MiB;
constexpr size_t WS_WGU0 = 222 * MiB, WS_WD0 = 286 * MiB;
constexpr size_t WS_ACT = 318 * MiB;
constexpr size_t WS_Q0 = WS_ACT, WS_K0 = WS_ACT + 64 * MiB, WS_V0 = WS_ACT + 128 * MiB;
constexpr size_t WS_HID = WS_ACT;
constexpr size_t WS_Q1 = 222 * MiB, WS_K1 = 318 * MiB, WS_V1 = 414 * MiB;
constexpr size_t WS_END = 574 * MiB;
constexpr int CW_BAR = 4096;
constexpr int CW_CNT = 16384;
constexpr int LDS_MISC = 155648;
constexpr int LDS_BYTES = 159 * 1024;
constexpr int NWAVES = 8;

#define LDS_WAIT() asm volatile("s_waitcnt lgkmcnt(0)" ::: "memory")
#define VM_WAIT() asm volatile("s_waitcnt vmcnt(0)" ::: "memory")
__device__ __forceinline__ unsigned f2bf(float f) { unsigned u = __builtin_bit_cast(unsigned, f); return (u + 0x7fffu + ((u >> 16) & 1u)) >> 16; }
__device__ __forceinline__ unsigned pk2(float lo, float hi) { return f2bf(lo) | (f2bf(hi) << 16); }
typedef __bf16 bf16pair_t __attribute__((ext_vector_type(2)));
__device__ __forceinline__ unsigned cvt_pk_bf16(float lo, float hi) { bf16pair_t v; v.x = (__bf16)lo; v.y = (__bf16)hi; return __builtin_bit_cast(unsigned, v); }
__device__ __forceinline__ float bf_lo(unsigned u) { return __builtin_bit_cast(float, u << 16); }
__device__ __forceinline__ float bf_hi(unsigned u) { return __builtin_bit_cast(float, u & 0xffff0000u); }
__device__ __forceinline__ float wave_sum(float v) {
#pragma unroll
    for (int o = 1; o < 64; o <<= 1) v += __shfl_xor(v, o);
    return v;
}
__device__ __forceinline__ float silu_f(float x) { return x * __builtin_amdgcn_rcpf(1.0f + __builtin_amdgcn_exp2f(-1.4426950408889634f * x)); }

#define XB_TMO      128
#define XB_XCNT(j)  (256  + 64 * (j))
#define XB_XSUB(j)  (1280 + 64 * (j))
#define XB_XGEN(j)  (2304 + 64 * (j))
#define XB_TOP      3328
#define XB_TOPGEN   3392
#define XCD_BAR_WORDS 3456
#define XB_SPIN_CAP (1u << 22)
__device__ __forceinline__ unsigned xb_ld(unsigned* p)              { return __hip_atomic_load(p, __ATOMIC_RELAXED, __HIP_MEMORY_SCOPE_AGENT); }
__device__ __forceinline__ unsigned xb_add(unsigned* p, unsigned v) { return __hip_atomic_fetch_add(p, v, __ATOMIC_RELAXED, __HIP_MEMORY_SCOPE_AGENT); }
__device__ __forceinline__ unsigned xb_xcc_id() { return (unsigned)__builtin_amdgcn_s_getreg((3 << 11) | 20) & 0xFu; }
#define XB_SPIN(cond, bar) do { unsigned _sp = 0; while (cond) { __builtin_amdgcn_s_sleep(1); \
    if ((++_sp & 255u) == 0u) { if (xb_ld(&(bar)[XB_TMO])) break; if (_sp > XB_SPIN_CAP) { atomicAdd(&(bar)[XB_TMO], 1u); break; } } } } while (0)
struct XcdBarrier { unsigned* bar; unsigned x; volatile LAS unsigned* st; };
__device__ __forceinline__ int lane_id() { return (int)__builtin_amdgcn_mbcnt_hi(~0u, __builtin_amdgcn_mbcnt_lo(~0u, 0u)); }
__device__ __forceinline__ XcdBarrier xcd_barrier_post(unsigned* bar, volatile LAS unsigned* st, bool t0) {
    XcdBarrier b; b.bar = bar; b.x = xb_xcc_id(); b.st = st;
    if (t0) (void)xb_add(&bar[XB_XCNT(b.x)], 1u);
    return b;
}
__device__ __forceinline__ void xcd_barrier_complete(unsigned* bar, unsigned x, unsigned& nloc, unsigned& nx) {
    const unsigned G = gridDim.x * gridDim.y * gridDim.z;
    unsigned sum, cnt, mine, sp = 0u;
    for (;;) {
        sum = 0u; cnt = 0u; mine = 0u;
#pragma unroll
        for (unsigned j = 0; j < 16; ++j) { const unsigned c = xb_ld(&bar[XB_XCNT(j)]); sum += c; cnt += (c > 0u) ? 1u : 0u; mine = (j == x) ? c : mine; }
        if (sum == G) break;
        __builtin_amdgcn_s_sleep(1);
        if ((++sp & 255u) == 0u) { if (xb_ld(&bar[XB_TMO])) break; if (sp > XB_SPIN_CAP) { atomicAdd(&bar[XB_TMO], 1u); break; } }
    }
    nloc = mine > 0u ? mine : 1u; nx = cnt > 0u ? cnt : 1u;
}
__device__ __forceinline__ void xcd_barrier(const XcdBarrier& b, int wave_s) {
    asm volatile("s_waitcnt vmcnt(0)" ::: "memory");
    __syncthreads();
    if (wave_s == 0 && lane_id() == 0) {
        unsigned* bar = b.bar;
        __builtin_amdgcn_s_waitcnt(0);
        unsigned nloc = b.st[0], nx = b.st[1];
        if (nloc == 0u) { xcd_barrier_complete(bar, b.x, nloc, nx); b.st[0] = nloc; b.st[1] = nx; }
        const unsigned old = xb_add(&bar[XB_XSUB(b.x)], 1u);
        const unsigned gen = old / nloc;
        if (old + 1u == (gen + 1u) * nloc) {
            __builtin_amdgcn_fence(__ATOMIC_RELEASE, "agent");
            asm volatile("s_waitcnt vmcnt(0)" ::: "memory");
            const unsigned og = xb_add(&bar[XB_TOP], 1u);
            const unsigned tg = og / nx;
            if (og + 1u == (tg + 1u) * nx) xb_add(&bar[XB_TOPGEN], 1u);
            else XB_SPIN(xb_ld(&bar[XB_TOPGEN]) == tg, bar);
            __builtin_amdgcn_fence(__ATOMIC_ACQUIRE, "agent");
            xb_add(&bar[XB_XGEN(b.x)], 1u);
            asm volatile("s_waitcnt vmcnt(0)" ::: "memory");
        } else {
            XB_SPIN(xb_ld(&bar[XB_XGEN(b.x)]) == gen, bar);
            __builtin_amdgcn_fence(__ATOMIC_ACQUIRE, "agent");
            asm volatile("s_waitcnt vmcnt(0)" ::: "memory");
        }
    }
    __syncthreads();
}

constexpr int BM = 256, BK = 64, HALF = 128, HTB = HALF * BK * 2, NXCD = 8, WGM = 8;
__host__ __device__ __forceinline__ int lds_byte(int r, int c) { const int st = (r >> 4) * 2 + (c >> 5), rr = r & 15, cc = c & 31, ob = rr * 64 + cc * 2; return st * 1024 + (ob ^ (((ob >> 9) & 1) << 5)); }
__host__ __device__ __forceinline__ void stage_rc(int b, int& R, int& C) { const int st = b / 1024, sb = b % 1024, swz = sb ^ (((sb >> 9) & 1) << 5); R = (st >> 1) * 16 + swz / 64; C = (st & 1) * 32 + (swz % 64) / 2; }
__host__ __device__ __forceinline__ int perm32(int rho) { const int n = rho >> 4, i = rho & 15; return 8 * (i >> 2) + 4 * n + (i & 3); }
struct Unit { int pm, pn, a0, a1; };
struct StaticOrder {
    int nM, nN, nwg, G, c;
    __device__ __forceinline__ void init(int M, int N, int G_, int c_) { nM = M / BM; nN = N / BM; nwg = nM * nN; G = G_; c = c_; }
    __device__ __forceinline__ bool next(int i, Unit& u) const {
        const long L = (long)i * G + c; if (L >= nwg) return false;
        int wgid = (int)L; { const int q = nwg / NXCD, r = nwg % NXCD, xcd = wgid % NXCD, off = wgid / NXCD; wgid = (xcd < r ? xcd * (q + 1) : r * (q + 1) + (xcd - r) * q) + off; }
        const int nig = WGM * nN, gid = wgid / nig, fm = gid * WGM, gsz = (nM - fm) < WGM ? (nM - fm) : WGM;
        u.pm = fm + ((wgid % nig) % gsz); u.pn = (wgid % nig) / gsz; u.a0 = 0; u.a1 = 0; return true;
    }
};
template <class P>
__device__ __forceinline__ void gemm_phase(LAS unsigned char* lds, const P& S, const int tid) {
    const int wid = __builtin_amdgcn_readfirstlane(tid >> 6), lane = tid & 63, wr = wid >> 2, wc = wid & 3, fr = lane & 15, fq = lane >> 4;
    const int K = S.K, nt = K / BK;
    unsigned voffB[2]; unsigned vA[2][2], vN[2][2];
#pragma unroll
    for (int i = 0; i < 2; ++i) { int R, C; stage_rc(tid * 16 + i * 8192, R, C); const int Rb = P::PERM ? ((R & ~31) + perm32(R & 31)) : R;
        voffB[i] = (unsigned)Rb * S.ldb + (unsigned)C * 2u;
#pragma unroll
        for (int h = 0; h < 2; ++h) { vA[h][i] = (unsigned)(h * HALF + R) * S.lda + (unsigned)C * 2u; vN[h][i] = vA[h][i]; } }
    const size_t kstep = (size_t)(BK * 2);
    const size_t hstepB = (size_t)HALF * S.ldb;
    const unsigned ldsw = (unsigned)wid * 1024u;
    const int aoff = lds_byte(wr * 64 + fr, fq * 8), boff = lds_byte(wc * 32 + fr, fq * 8);
#define PG8_SA(b, h) (((b) * 2 + (h)) * HTB)
#define PG8_SB(b, h) ((4 + (b) * 2 + (h)) * HTB)
#define PG8_STAGE(bufoff, gbase, voff) do { _Pragma("unroll") for (int _i = 0; _i < 2; ++_i) \
        __builtin_amdgcn_global_load_lds((const unsigned*)((const char*)(gbase) + (voff)[_i]), (LAS unsigned*)(lds + (bufoff) + ldsw + _i * 8192), 16, 0, 0); } while (0)
#define PG8_LDA(dst, b, h) do { _Pragma("unroll") for (int m = 0; m < 4; ++m) _Pragma("unroll") for (int k = 0; k < 2; ++k) dst[m][k] = *(const LAS bf16x8*)(lds + PG8_SA(b, h) + aoff + m * 2048 + k * 1024); } while (0)
#define PG8_LDB(dst, b, h) do { _Pragma("unroll") for (int n = 0; n < 2; ++n) _Pragma("unroll") for (int k = 0; k < 2; ++k) dst[n][k] = *(const LAS bf16x8*)(lds + PG8_SB(b, h) + boff + n * 2048 + k * 1024); } while (0)
#define PG8_MMA(ai, bj, At, Bt) do { __builtin_amdgcn_s_setprio(1); _Pragma("unroll") for (int m = 0; m < 4; ++m) _Pragma("unroll") for (int n = 0; n < 2; ++n) _Pragma("unroll") for (int k = 0; k < 2; ++k) \
        acc[ai][bj][m][n] = __builtin_amdgcn_mfma_f32_16x16x32_bf16(Bt[n][k], At[m][k], acc[ai][bj][m][n], 0, 0, 0); __builtin_amdgcn_s_setprio(0); } while (0)
#define PG8_WAIT_V(n) asm volatile("s_waitcnt vmcnt(" #n ")" ::: "memory")
#define PG8_WAIT_L(n) asm volatile("s_waitcnt lgkmcnt(" #n ")" ::: "memory")
#define PG8_BAR __builtin_amdgcn_s_barrier()
#define PG8_SCHED __builtin_amdgcn_sched_barrier(0)
    Unit cur, nxt; int ui = 0;
    if (!S.next(0, cur)) return;
    f32x4 acc[2][2][4][2];
#pragma unroll
    for (int a = 0; a < 2; ++a)
#pragma unroll
        for (int b = 0; b < 2; ++b)
#pragma unroll
            for (int m = 0; m < 4; ++m)
#pragma unroll
                for (int n = 0; n < 2; ++n) acc[a][b][m][n] = (f32x4){0.f, 0.f, 0.f, 0.f};
    bf16x8 At[4][2], B0[2][2], B1[2][2];
    const char* cA = S.a_base(cur); const char* cB = S.b_base(cur);
    if constexpr (P::GATHER) { S.a_rows(cur, tid, vA); }
    PG8_STAGE(PG8_SB(0, 0), cB, voffB); PG8_STAGE(PG8_SB(0, 1), cB + hstepB, voffB); PG8_STAGE(PG8_SA(0, 0), cA, vA[0]); PG8_STAGE(PG8_SA(0, 1), cA, vA[1]);
    if (wr == 1) PG8_BAR;
    PG8_WAIT_V(2); PG8_BAR;
    PG8_STAGE(PG8_SB(1, 0), cB + kstep, voffB); PG8_STAGE(PG8_SA(1, 0), cA + kstep, vA[0]); PG8_STAGE(PG8_SB(1, 1), cB + hstepB + kstep, voffB);
    PG8_WAIT_V(6); PG8_BAR;
    for (;;) {
        const bool has_next = S.next(ui + 1, nxt);
        const char* nA = has_next ? S.a_base(nxt) : cA; const char* nB = has_next ? S.b_base(nxt) : cB;
        for (int t = 0; t < nt; t += 2) {
            const bool last = (t == nt - 2);
            if constexpr (P::GATHER) { if (t == nt - 4 && has_next) S.a_rows(nxt, tid, vN); }
            const char* a1 = cA + (size_t)(t + 1) * kstep;
            const char* a2 = last ? nA : cA + (size_t)(t + 2) * kstep; const char* b2 = last ? nB : cB + (size_t)(t + 2) * kstep;
            const char* a3 = a2 + kstep; const char* b3 = b2 + kstep;
            unsigned v2[2][2];
#pragma unroll
            for (int h = 0; h < 2; ++h)
#pragma unroll
                for (int i = 0; i < 2; ++i) v2[h][i] = (P::GATHER && last) ? vN[h][i] : vA[h][i];
            PG8_LDB(B0, 0, 0); PG8_LDB(B1, 0, 1); PG8_SCHED; PG8_LDA(At, 0, 0); PG8_STAGE(PG8_SA(1, 1), a1, vA[1]);
            PG8_WAIT_V(8); PG8_WAIT_L(0); PG8_BAR; PG8_MMA(0, 0, At, B0); PG8_MMA(0, 1, At, B1); PG8_BAR; PG8_SCHED;
            PG8_LDA(At, 0, 1); PG8_STAGE(PG8_SB(0, 0), b2, voffB); PG8_STAGE(PG8_SB(0, 1), b2 + hstepB, voffB); PG8_STAGE(PG8_SA(0, 0), a2, v2[0]);
            PG8_WAIT_V(8); PG8_WAIT_L(0); PG8_BAR; PG8_MMA(1, 0, At, B0); PG8_MMA(1, 1, At, B1); PG8_BAR; PG8_SCHED;
            PG8_LDB(B0, 1, 0); PG8_LDB(B1, 1, 1); PG8_SCHED; PG8_LDA(At, 1, 0); PG8_STAGE(PG8_SA(0, 1), a2, v2[1]);
            PG8_WAIT_V(8); PG8_WAIT_L(0); PG8_BAR; PG8_MMA(0, 0, At, B0); PG8_MMA(0, 1, At, B1); PG8_BAR; PG8_SCHED;
            PG8_LDA(At, 1, 1); PG8_STAGE(PG8_SB(1, 0), b3, voffB); PG8_STAGE(PG8_SB(1, 1), b3 + hstepB, voffB); PG8_STAGE(PG8_SA(1, 0), a3, v2[0]);
            PG8_WAIT_V(8); PG8_WAIT_L(0); PG8_BAR; PG8_MMA(1, 0, At, B0); PG8_MMA(1, 1, At, B1); PG8_BAR; PG8_SCHED;
        }
        if (wr == 0) PG8_BAR;
        S.epi(acc, cur, wr, wc, fr, fq);
        if (!has_next) break;
#pragma unroll
        for (int a = 0; a < 2; ++a)
#pragma unroll
            for (int b = 0; b < 2; ++b)
#pragma unroll
                for (int m = 0; m < 4; ++m)
#pragma unroll
                    for (int n = 0; n < 2; ++n) acc[a][b][m][n] = (f32x4){0.f, 0.f, 0.f, 0.f};
        cur = nxt; cA = nA; cB = nB; ++ui;
        if constexpr (P::GATHER) {
#pragma unroll
            for (int h = 0; h < 2; ++h)
#pragma unroll
                for (int i = 0; i < 2; ++i) vA[h][i] = vN[h][i]; }
        if (wr == 1) PG8_BAR;
    }
    PG8_WAIT_V(0);
    PG8_BAR;
#undef PG8_SA
#undef PG8_SB
#undef PG8_STAGE
#undef PG8_LDA
#undef PG8_LDB
#undef PG8_MMA
#undef PG8_WAIT_V
#undef PG8_WAIT_L
#undef PG8_BAR
#undef PG8_SCHED
}
struct PlainBase {
    const char* A; const char* Bt; unsigned lda, ldb; int K; StaticOrder so;
    __device__ __forceinline__ bool next(int i, Unit& u) const { return so.next(i, u); }
    __device__ __forceinline__ const char* a_base(const Unit& u) const { return A + (size_t)u.pm * BM * lda; }
    __device__ __forceinline__ const char* b_base(const Unit& u) const { return Bt + (size_t)u.pn * BM * ldb; }
    __device__ __forceinline__ void a_rows(const Unit&, int, unsigned (&)[2][2]) const {}
};
__device__ __forceinline__ float head_l2g(int h) { return __builtin_log2f(1.0f - __builtin_amdgcn_exp2f(-5.0f - (float)h)); }

struct P_QKV0 : PlainBase {
    static constexpr bool PERM = true, GATHER = false;
    bf16* qk; bf16* v; const float* cs; const float* sn;
    __device__ __forceinline__ void epi(const f32x4 (&acc)[2][2][4][2], const Unit& u, int wr, int wc, int fr, int fq) const {
        const int row0 = u.pm * BM + wr * 64 + fr, pn = u.pn;
        if (pn < 8) {
            const int hh = pn & 3; const bool isk = pn >= 4; bf16* dst = qk + (size_t)(pn >> 2) * ((size_t)T * 1024);
            const float l2g = isk ? -head_l2g(hh) : head_l2g(hh);
#pragma unroll
            for (int ai = 0; ai < 2; ++ai)
#pragma unroll
                for (int m = 0; m < 4; ++m) { const int row = row0 + ai * HALF + m * 16, pos = row & (SEQ - 1);
                    const float sc = __builtin_amdgcn_exp2f(l2g * (float)(pos & 63));
#pragma unroll
                    for (int bj = 0; bj < 2; ++bj) { const int c0 = bj * HALF + wc * 32 + 8 * fq, i0 = c0 >> 1;
                        const f32x4 cv = *(const f32x4*)(cs + pos * 128 + i0), sv = *(const f32x4*)(sn + pos * 128 + i0);
                        const f32x4 v0 = acc[ai][bj][m][0], v1 = acc[ai][bj][m][1];
                        u32x4 w;
                        w.x = cvt_pk_bf16((v0[0] * cv[0] - v0[1] * sv[0]) * sc, (v0[0] * sv[0] + v0[1] * cv[0]) * sc);
                        w.y = cvt_pk_bf16((v0[2] * cv[1] - v0[3] * sv[1]) * sc, (v0[2] * sv[1] + v0[3] * cv[1]) * sc);
                        w.z = cvt_pk_bf16((v1[0] * cv[2] - v1[1] * sv[2]) * sc, (v1[0] * sv[2] + v1[1] * cv[2]) * sc);
                        w.w = cvt_pk_bf16((v1[2] * cv[3] - v1[3] * sv[3]) * sc, (v1[2] * sv[3] + v1[3] * cv[3]) * sc);
                        *(u32x4*)(dst + (size_t)row * 1024 + hh * 256 + c0) = w; } }
        } else {
#pragma unroll
            for (int ai = 0; ai < 2; ++ai)
#pragma unroll
                for (int m = 0; m < 4; ++m) { const int row = row0 + ai * HALF + m * 16;
#pragma unroll
                    for (int bj = 0; bj < 2; ++bj) { const int c0 = bj * HALF + wc * 32 + 8 * fq;
                        const f32x4 v0 = acc[ai][bj][m][0], v1 = acc[ai][bj][m][1];
                        u32x4 w; w.x = cvt_pk_bf16(v0[0], v0[1]); w.y = cvt_pk_bf16(v0[2], v0[3]); w.z = cvt_pk_bf16(v1[0], v1[1]); w.w = cvt_pk_bf16(v1[2], v1[3]);
                        *(u32x4*)(v + (size_t)row * 2048 + (pn - 8) * 256 + c0) = w; } }
        }
    }
};
struct P_GATE : PlainBase {
    static constexpr bool PERM = true, GATHER = false;
    bf16* ov; const float* ssq;
    __device__ __forceinline__ void epi(const f32x4 (&acc)[2][2][4][2], const Unit& u, int wr, int wc, int fr, int fq) const {
        const int row0 = u.pm * BM + wr * 64 + fr, head = u.pn >> 1;
#pragma unroll
        for (int ai = 0; ai < 2; ++ai)
#pragma unroll
            for (int m = 0; m < 4; ++m) { const int row = row0 + ai * HALF + m * 16;
                const f32x4 s0 = *(const f32x4*)(ssq + ((size_t)row * 4 + head) * 8), s1 = *(const f32x4*)(ssq + ((size_t)row * 4 + head) * 8 + 4);
                const float rs = __builtin_amdgcn_rsqf((((s0[0] + s0[1]) + (s0[2] + s0[3])) + ((s1[0] + s1[1]) + (s1[2] + s1[3]))) * (1.0f / 512.0f) + 1e-6f);
#pragma unroll
                for (int bj = 0; bj < 2; ++bj) { const int c0 = u.pn * BM + bj * HALF + wc * 32 + 8 * fq;
                    u32x4* p = (u32x4*)(ov + (size_t)row * 2048 + c0); const u32x4 o = *p;
                    const f32x4 v0 = acc[ai][bj][m][0], v1 = acc[ai][bj][m][1];
                    u32x4 w;
                    w.x = cvt_pk_bf16(silu_f(v0[0]) * bf_lo(o.x) * rs, silu_f(v0[1]) * bf_hi(o.x) * rs);
                    w.y = cvt_pk_bf16(silu_f(v0[2]) * bf_lo(o.y) * rs, silu_f(v0[3]) * bf_hi(o.y) * rs);
                    w.z = cvt_pk_bf16(silu_f(v1[0]) * bf_lo(o.z) * rs, silu_f(v1[1]) * bf_hi(o.z) * rs);
                    w.w = cvt_pk_bf16(silu_f(v1[2]) * bf_lo(o.w) * rs, silu_f(v1[3]) * bf_hi(o.w) * rs);
                    *p = w; } }
    }
};
struct P_RES : PlainBase {
    static constexpr bool PERM = false, GATHER = false;
    const float* res; float* out; int row_off;
    __device__ __forceinline__ void epi(const f32x4 (&acc)[2][2][4][2], const Unit& u, int wr, int wc, int fr, int fq) const {
        const int row0 = row_off + u.pm * BM + wr * 64 + fr, col0 = u.pn * BM + wc * 32 + 4 * fq;
#pragma unroll
        for (int ai = 0; ai < 2; ++ai)
#pragma unroll
            for (int m = 0; m < 4; ++m) { const size_t off = (size_t)(row0 + ai * HALF + m * 16) * D + col0;
#pragma unroll
                for (int bj = 0; bj < 2; ++bj)
#pragma unroll
                    for (int n = 0; n < 2; ++n) { const f32x4 r = *(const f32x4*)(res + off + bj * HALF + n * 16); *(f32x4*)(out + off + bj * HALF + n * 16) = r + acc[ai][bj][m][n]; } }
    }
};
struct P_QKV1 : PlainBase {
    static constexpr bool PERM = true, GATHER = false;
    bf16* qkv; const float* gains;
    __device__ __forceinline__ void epi(const f32x4 (&acc)[2][2][4][2], const Unit& u, int wr, int wc, int fr, int fq) const {
        const int row0 = u.pm * BM + wr * 64 + fr, part = u.pn / 12, pp = u.pn % 12, g = pp >> 2, head = (pp & 3) * 4 + wc;
        bf16* dst = qkv + (size_t)part * ((size_t)TC * 3072) + g * 1024 + head * 64 + 8 * fq;
        const float* gp = gains + (part & 1) * 192 + g * 64 + 8 * fq;
        const float qs = part == 0 ? 0.125f * 1.4426950408889634f : 1.0f;
#pragma unroll
        for (int ai = 0; ai < 2; ++ai)
#pragma unroll
            for (int m = 0; m < 4; ++m) { const int row = row0 + ai * HALF + m * 16;
                float rs = 1.0f;
                if (part < 2) {
                    float ss = 0.f;
#pragma unroll
                    for (int bj = 0; bj < 2; ++bj)
#pragma unroll
                        for (int n = 0; n < 2; ++n) { const f32x4 t = acc[ai][bj][m][n]; ss += (t[0] * t[0] + t[1] * t[1]) + (t[2] * t[2] + t[3] * t[3]); }
                    ss += __shfl_xor(ss, 16); ss += __shfl_xor(ss, 32);
                    rs = __builtin_amdgcn_rsqf(ss * (1.0f / 64.0f) + 1e-6f) * qs;
                }
#pragma unroll
                for (int bj = 0; bj < 2; ++bj) { f32x4 v0 = acc[ai][bj][m][0], v1 = acc[ai][bj][m][1];
                    if (part < 2) { v0 = v0 * *(const f32x4*)(gp + 32 * bj) * rs; v1 = v1 * *(const f32x4*)(gp + 32 * bj + 4) * rs; }
                    u32x4 w; w.x = cvt_pk_bf16(v0[0], v0[1]); w.y = cvt_pk_bf16(v0[2], v0[3]); w.z = cvt_pk_bf16(v1[0], v1[1]); w.w = cvt_pk_bf16(v1[2], v1[3]);
                    *(u32x4*)(dst + (size_t)row * 3072 + 32 * bj) = w; }
                asm volatile("" ::: "memory"); }
    }
};
__device__ __forceinline__ void moe_build_tab(LAS int* tab, const unsigned* cnt_g, const int tid) {
    if (tid == 0) { int run = 0; for (int b = 0; b < 64; ++b) { const int c = (int)__hip_atomic_load(cnt_g + b, __ATOMIC_RELAXED, __HIP_MEMORY_SCOPE_AGENT); tab[b] = c; tab[64 + b] = run; run += (c + 255) >> 8; } tab[128] = run; }
    __syncthreads();
}
__device__ __forceinline__ int moe_find_bin(const LAS int* tab, int tl, int blo, int bhi) {
    int b = blo;
    for (int j = blo; j < bhi; ++j) if (tab[64 + j + 1] <= tl) b = j + 1;
    return __builtin_amdgcn_readfirstlane(b);
}
struct P_GU {
    static constexpr bool PERM = true, GATHER = true;
    const char* xn; const char* W; const int* list; bf16* hid; const LAS int* tab; int G, vcu; int K; unsigned lda, ldb;
    __device__ __forceinline__ bool next(int i, Unit& u) const {
        const int L = i * G + vcu; if (L >= tab[128] * 4) return false;
        const int tl = L >> 2, b = moe_find_bin(tab, tl, 0, 64);
        u.pm = tl - tab[64 + b]; u.pn = L & 3; u.a0 = b; u.a1 = tl; return true;
    }
    __device__ __forceinline__ const char* a_base(const Unit&) const { return xn; }
    __device__ __forceinline__ const char* b_base(const Unit& u) const { return W + ((size_t)(u.a0 & 31) * 1024 + (size_t)u.pn * BM) * 2048; }
    __device__ __forceinline__ void a_rows(const Unit& u, int tid, unsigned (&off)[2][2]) const {
        const int n = tab[u.a0]; const int* lp = list + (size_t)u.a0 * T + u.pm * BM;
#pragma unroll
        for (int i = 0; i < 2; ++i) { int R, C; stage_rc(tid * 16 + i * 8192, R, C);
#pragma unroll
            for (int h = 0; h < 2; ++h) { const int r = h * HALF + R; const int tok = (u.pm * BM + r < n) ? lp[r] : 0; off[h][i] = (unsigned)tok * 2048u + (unsigned)C * 2u; } }
    }
    __device__ __forceinline__ void epi(const f32x4 (&acc)[2][2][4][2], const Unit& u, int wr, int wc, int fr, int fq) const {
        const size_t hrow0 = (size_t)u.a1 * BM + wr * 64 + fr;
#pragma unroll
        for (int ai = 0; ai < 2; ++ai)
#pragma unroll
            for (int m = 0; m < 4; ++m)
#pragma unroll
                for (int bj = 0; bj < 2; ++bj) { const int f0 = (u.pn * BM + bj * HALF + wc * 32 + 8 * fq) >> 1;
                    const f32x4 gv = acc[ai][bj][m][0], uv = acc[ai][bj][m][1];
                    u32x2 w; w.x = cvt_pk_bf16(silu_f(gv[0]) * uv[0], silu_f(gv[1]) * uv[1]); w.y = cvt_pk_bf16(silu_f(gv[2]) * uv[2], silu_f(gv[3]) * uv[3]);
                    *(u32x2*)(hid + (hrow0 + ai * HALF + m * 16) * FF + f0) = w; }
    }
};
struct P_DN {
    static constexpr bool PERM = false, GATHER = false;
    const char* hid; const char* W; const int* list; const float* gatew; float* h; const LAS int* tab; int G, vcu, slot; int K; unsigned lda, ldb;
    __device__ __forceinline__ bool next(int i, Unit& u) const {
        const int L = i * G + vcu, t0 = tab[64 + slot * 32], t1 = tab[64 + slot * 32 + 32]; if (L >= (t1 - t0) * 4) return false;
        const int tl = t0 + (L >> 2), b = moe_find_bin(tab, tl, slot * 32, slot * 32 + 32);
        u.pm = tl - tab[64 + b]; u.pn = L & 3; u.a0 = b; u.a1 = tl; return true;
    }
    __device__ __forceinline__ const char* a_base(const Unit& u) const { return hid + (size_t)u.a1 * BM * 1024; }
    __device__ __forceinline__ const char* b_base(const Unit& u) const { return W + ((size_t)(u.a0 & 31) * 1024 + (size_t)u.pn * BM) * 1024; }
    __device__ __forceinline__ void a_rows(const Unit&, int, unsigned (&)[2][2]) const {}
    __device__ __forceinline__ void epi(const f32x4 (&acc)[2][2][4][2], const Unit& u, int wr, int wc, int fr, int fq) const {
        const int n = tab[u.a0], col0 = u.pn * BM + wc * 32 + 4 * fq; const int* lp = list + (size_t)u.a0 * T + u.pm * BM;
#pragma unroll
        for (int ai = 0; ai < 2; ++ai)
#pragma unroll
            for (int m = 0; m < 4; ++m) { const int r = ai * HALF + wr * 64 + m * 16 + fr;
                if (u.pm * BM + r < n) { const int tok = lp[r]; const float gt = gatew[tok * 2 + slot]; float* hp = h + (size_t)tok * D + col0;
#pragma unroll
                    for (int bj = 0; bj < 2; ++bj)
#pragma unroll
                        for (int nn = 0; nn < 2; ++nn) { f32x4* p = (f32x4*)(hp + bj * HALF + nn * 16); *p = *p + acc[ai][bj][m][nn] * gt; } } }
    }
};

struct MapId { int off; __device__ __forceinline__ int row(int n) const { return n + off; } __device__ __forceinline__ float scale(int) const { return 1.0f; } };
struct MapWin { __device__ __forceinline__ int row(int n) const { if (n >= 2048) return n; const int d = n & 255; return (n & ~255) + ((d < 128) ? 2 * d : 2 * (d - 128) + 1); }
                __device__ __forceinline__ float scale(int n) const { return (n >= 1024 && n < 2048) ? 0.0625f : 1.0f; } };
struct MapQkv1 { int base; __device__ __forceinline__ int row(int n) const { const int two = n / 3072, n1 = n % 3072, g = n1 >> 10, h = (n1 >> 6) & 15, d = n1 & 63;
                     return base + two * 3072 + (g * 4 + (h >> 2)) * 256 + 32 * (h & 3) + (d & 31) + 128 * (d >> 5); }
                 __device__ __forceinline__ float scale(int) const { return 1.0f; } };
struct MapGu { int up; __device__ __forceinline__ int row(int f) const { return (f >> 2) * 8 + (f & 3) + 4 * up; } __device__ __forceinline__ float scale(int) const { return 1.0f; } };
template <class Map>
__device__ __forceinline__ void transpose_item(const float* W, int N, bf16* WT, int ldt, LAS float* scr, int item, int lane, const float* gain, const Map mp) {
    const int nblk = N / 32, kb = item / nblk, nb = item % nblk, k0 = 64 * kb, n0 = 32 * nb;
#pragma unroll 8
    for (int i = 0; i < 32; ++i) { const int kk = 2 * i + (lane >> 5); const float gg = gain ? gain[k0 + kk] : 1.0f; scr[kk * 33 + (lane & 31)] = W[(size_t)(k0 + kk) * N + n0 + (lane & 31)] * gg; }
    LDS_WAIT(); asm volatile("" ::: "memory");
    const int c = lane & 7;
#pragma unroll
    for (int j = 0; j < 4; ++j) { const int n = (lane >> 3) + 8 * j; const LAS float* s = scr + (8 * c) * 33 + n; const float sc = mp.scale(n0 + n);
        u32x4 o; o.x = pk2(s[0 * 33] * sc, s[1 * 33] * sc); o.y = pk2(s[2 * 33] * sc, s[3 * 33] * sc); o.z = pk2(s[4 * 33] * sc, s[5 * 33] * sc); o.w = pk2(s[6 * 33] * sc, s[7 * 33] * sc);
        *(GAS u32x4*)(WT + (size_t)mp.row(n0 + n) * ldt + k0 + 8 * c) = o; }
    LDS_WAIT(); asm volatile("" ::: "memory");
}
template <class Map>
__device__ __forceinline__ void transpose_matrix(const float* W, int K, int N, bf16* WT, LAS float* scr, int gw, int ngw, int lane, const float* gain, const Map mp) {
    const int nitems = (K / 64) * (N / 32);
    for (int it = gw; it < nitems; it += ngw) transpose_item(W, N, WT, K, scr, it, lane, gain, mp);
}
__device__ __forceinline__ void rms_row_to_bf16(const float* xrow, bf16* orow, int lane) {
    const GAS f32x4* xr = (const GAS f32x4*)xrow + lane;
    f32x4 v[4]; float s = 0.f;
#pragma unroll
    for (int j = 0; j < 4; ++j) { v[j] = xr[64 * j]; s += (v[j].x * v[j].x + v[j].y * v[j].y) + (v[j].z * v[j].z + v[j].w * v[j].w); }
    const float rs = __builtin_amdgcn_rsqf(wave_sum(s) * (1.f / D) + 1e-6f);
    GAS unsigned long long* o8 = (GAS unsigned long long*)orow + lane;
#pragma unroll
    for (int j = 0; j < 4; ++j) o8[64 * j] = (unsigned long long)pk2(v[j].x * rs, v[j].y * rs) | ((unsigned long long)pk2(v[j].z * rs, v[j].w * rs) << 32);
}
__device__ __forceinline__ unsigned swz(int row, int bytecol, int stride) { return (unsigned)(row * stride + ((((bytecol >> 4) ^ (row & 7)) << 4) | (bytecol & 15))); }
__device__ __forceinline__ bf16x8 frag_row(const LAS unsigned char* img, int row0, int bytecol0, int stride, int fr, int fq) {
    return *(const LAS bf16x8*)(img + swz(row0 + fr, bytecol0 + 16 * fq, stride));
}
__device__ __forceinline__ bf16x8 frag_tr2(const LAS unsigned char* img, int rowa, int rowb, int c0, int stride, int lane) {
    const int fq = lane >> 4, q = (lane & 15) >> 2, p = lane & 3;
    const s16x4 lo = __builtin_amdgcn_ds_read_tr16_b64_v4i16((LAS s16x4*)(img + swz(rowa + 4 * fq + q, (c0 + 4 * p) * 2, stride)));
    const s16x4 hi = __builtin_amdgcn_ds_read_tr16_b64_v4i16((LAS s16x4*)(img + swz(rowb + 4 * fq + q, (c0 + 4 * p) * 2, stride)));
    return (bf16x8){lo[0], lo[1], lo[2], lo[3], hi[0], hi[1], hi[2], hi[3]};
}
__device__ __forceinline__ bf16x8 frag_tr(const LAS unsigned char* img, int k0, int c0, int stride, int lane) {
    const int fq = lane >> 4; return frag_tr2(img, k0 + 4 * fq, k0 + 4 * fq + 4, c0, stride, lane);
}
#define MFMA16(a, b, c) __builtin_amdgcn_mfma_f32_16x16x32_bf16((a), (b), (c), 0, 0, 0)

__device__ __forceinline__ void retention_phase(LAS unsigned char* lds, const bf16* qg, const bf16* kg, bf16* vg, float* ssq, int G, int bx, const int tid) {
    const int lane0 = tid & 63, w = __builtin_amdgcn_readfirstlane(tid >> 6);
    const int tq = w & 3, hv = w >> 2;
    LAS unsigned char* QI = lds; LAS unsigned char* KI = lds + 32768; LAS unsigned char* VI = lds + 65536; LAS unsigned char* PI = lds + 81920; LAS unsigned char* ZI = lds + 90112;
    for (int u = bx; u < 256; u += G) {
        const int b = u >> 4, h = (u >> 2) & 3, vs = u & 3;
        const float g64 = __builtin_amdgcn_exp2f(64.0f * head_l2g(h));
        f32x4 Z[16];
#pragma unroll
        for (int i = 0; i < 16; ++i) Z[i] = (f32x4){0.f, 0.f, 0.f, 0.f};
        u32x4 pq[4], pk[4], pv[2];
        const bf16* qh = qg + (size_t)b * SEQ * 1024 + h * 256; const bf16* kh = kg + (size_t)b * SEQ * 1024 + h * 256;
        bf16* vh = vg + (size_t)b * SEQ * 2048 + h * 512 + vs * 128;
#define RET_LOAD(sc) do { _Pragma("unroll") for (int i = 0; i < 4; ++i) { const int pid = tid + 512 * i, r = pid >> 5, c = pid & 31; \
            pq[i] = *(const u32x4*)(qh + (size_t)((sc) * 64 + r) * 1024 + c * 8); pk[i] = *(const u32x4*)(kh + (size_t)((sc) * 64 + r) * 1024 + c * 8); } \
        _Pragma("unroll") for (int i = 0; i < 2; ++i) { const int pid = tid + 512 * i, r = pid >> 4, c = pid & 15; pv[i] = *(const u32x4*)(vh + (size_t)((sc) * 64 + r) * 2048 + c * 8); } } while (0)
        RET_LOAD(0);
        for (int sc = 0; sc < 32; ++sc) {
            int lane = lane0, fr = lane0 & 15, fq = lane0 >> 4;
            asm volatile("" : "+v"(lane), "+v"(fr), "+v"(fq));
            __syncthreads();
#pragma unroll
            for (int i = 0; i < 4; ++i) { const int pid = tid + 512 * i, r = pid >> 5, c = pid & 31; *(LAS u32x4*)(QI + swz(r, c * 16, 512)) = pq[i]; *(LAS u32x4*)(KI + swz(r, c * 16, 512)) = pk[i]; }
#pragma unroll
            for (int i = 0; i < 2; ++i) { const int pid = tid + 512 * i, r = pid >> 4, c = pid & 15; *(LAS u32x4*)(VI + swz(r, c * 16, 256)) = pv[i]; }
#pragma unroll
            for (int dt = 0; dt < 16; ++dt) { u32x2 zz; zz.x = cvt_pk_bf16(Z[dt][0], Z[dt][1]); zz.y = cvt_pk_bf16(Z[dt][2], Z[dt][3]); *(LAS u32x2*)(ZI + swz(16 * dt + fr, (16 * w + 4 * fq) * 2, 256)) = zz; }
            if (sc + 1 < 32) RET_LOAD(sc + 1);
            __syncthreads();
#pragma unroll
            for (int mi = 0; mi < 2; ++mi) { const int mt = 2 * hv + mi; f32x4 s = (f32x4){0.f, 0.f, 0.f, 0.f};
                if (mt <= tq) {
#pragma unroll
                    for (int ks = 0; ks < 8; ++ks) s = MFMA16(frag_row(KI, 16 * mt, ks * 64, 512, fr, fq), frag_row(QI, 16 * tq, ks * 64, 512, fr, fq), s);
                    if (mt == tq) {
#pragma unroll
                        for (int r = 0; r < 4; ++r) if (4 * fq + r > fr) s[r] = 0.f; }
                }
                u32x2 pp; pp.x = cvt_pk_bf16(s[0], s[1]); pp.y = cvt_pk_bf16(s[2], s[3]); *(LAS u32x2*)(PI + swz(16 * tq + fr, (16 * mt + 4 * fq) * 2, 128)) = pp; }
            bf16x8 va[2];
#pragma unroll
            for (int k2 = 0; k2 < 2; ++k2) va[k2] = frag_tr(VI, 32 * k2, 16 * w, 256, lane);
#pragma unroll
            for (int dt = 0; dt < 16; ++dt) { Z[dt] = Z[dt] * g64;
#pragma unroll
                for (int k2 = 0; k2 < 2; ++k2) Z[dt] = MFMA16(va[k2], frag_tr(KI, 32 * k2, 16 * dt, 512, lane), Z[dt]);
                if (dt & 1) asm volatile("" ::: "memory"); }
            asm volatile("" ::: "memory");
            f32x4 o[4];
#pragma unroll
            for (int vt = 0; vt < 4; ++vt) o[vt] = (f32x4){0.f, 0.f, 0.f, 0.f};
            asm volatile("" ::: "memory");
#pragma unroll
            for (int ks = 0; ks < 8; ++ks) { const bf16x8 qf = frag_row(QI, 16 * tq, ks * 64, 512, fr, fq);
#pragma unroll
                for (int vt = 0; vt < 4; ++vt) o[vt] = MFMA16(frag_tr(ZI, 32 * ks, 16 * (4 * hv + vt), 256, lane), qf, o[vt]);
                asm volatile("" ::: "memory"); }
            __syncthreads();
#pragma unroll
            for (int vt = 0; vt < 4; ++vt) o[vt] = o[vt] * g64;
#pragma unroll
            for (int k2 = 0; k2 < 2; ++k2) if (32 * k2 <= 16 * tq + 15) { const bf16x8 pb = frag_row(PI, 16 * tq, k2 * 64, 128, fr, fq);
#pragma unroll
                for (int vt = 0; vt < 4; ++vt) o[vt] = MFMA16(frag_tr(VI, 32 * k2, 16 * (4 * hv + vt), 256, lane), pb, o[vt]); }
            const int tokl = sc * 64 + 16 * tq + fr; float ss = 0.f;
#pragma unroll
            for (int vt = 0; vt < 4; ++vt) { ss += (o[vt][0] * o[vt][0] + o[vt][1] * o[vt][1]) + (o[vt][2] * o[vt][2] + o[vt][3] * o[vt][3]);
                u32x2 ww; ww.x = cvt_pk_bf16(o[vt][0], o[vt][1]); ww.y = cvt_pk_bf16(o[vt][2], o[vt][3]); *(u32x2*)(vh + (size_t)tokl * 2048 + 16 * (4 * hv + vt) + 4 * fq) = ww; }
            ss += __shfl_xor(ss, 16); ss += __shfl_xor(ss, 32);
            if (fq == 0) ssq[(((size_t)(b * SEQ + tokl) * 4 + h) * 4 + vs) * 2 + hv] = ss;
        }
#undef RET_LOAD
        __syncthreads();
    }
}

__device__ __forceinline__ int t5_bucket(int n) { if (n < 16) return n; const int l = 16 + (int)(__builtin_log2f((float)n * 0.0625f) * (16.0f / 7.0f)); return l > 31 ? 31 : l; }
__device__ __forceinline__ void attn_phase(LAS unsigned char* lds, bf16* qb, const bf16* kb, const bf16* vb, f32x2* ml, const float* rel_bias, int G, int bx, const int tid) {
    const int lane = tid & 63, w = __builtin_amdgcn_readfirstlane(tid >> 6), fr = lane & 15, fq = lane >> 4;
    LAS unsigned char* KI = lds; LAS unsigned char* VI = lds + 32768; LAS float* BT = (LAS float*)(lds + 65536);
    for (int unit = bx; unit < 1536; unit += G) {
        const int u4 = unit & 3, g = (unit >> 2) % 3, rest = unit / 12, h = rest & 15, bl = rest >> 4;
        const int R = g == 0 ? 1 : (g == 1 ? 4 : 16);
        __syncthreads();
        if (tid < 160) { const int steps = tid - 16; BT[tid] = (steps >= 0 && steps <= 128) ? rel_bias[t5_bucket(steps * R) * 48 + g * 16 + h] * 1.4426950408889634f : -1e30f; }
        const int s_first = (g == 0 && u4 > 0) ? -1 : 0;
        const bf16* kbase = kb + (size_t)bl * SEQ * 3072 + g * 1024 + h * 64; const bf16* vbase = vb + (size_t)bl * SEQ * 3072 + g * 1024 + h * 64;
        u32x4 pk[2], pv[2];
#define ATT_SEG(s, r, n) do { if (g == 0) { r = 0; n = 4 * u4 + (s); } else if (g == 1) { r = u4; n = (s); } else { r = 4 * u4 + (s); n = 0; } } while (0)
#define ATT_LOAD(s) do { int r_, n_; ATT_SEG(s, r_, n_); _Pragma("unroll") for (int i = 0; i < 2; ++i) { const int pid = tid + 512 * i, row = pid >> 3, c = pid & 7; \
            const size_t off = (size_t)((128 * n_ + row) * R + r_) * 3072 + c * 8; pk[i] = *(const u32x4*)(kbase + off); pv[i] = *(const u32x4*)(vbase + off); } } while (0)
        ATT_LOAD(s_first);
        int cnt = 0;
        for (int s = s_first; s < 4; ++s, ++cnt) {
            __syncthreads();
            const int cs = cnt & 1, ps = cs ^ 1;
#pragma unroll
            for (int i = 0; i < 2; ++i) { const int pid = tid + 512 * i, row = pid >> 3, c = pid & 7; *(LAS u32x4*)(KI + swz(cs * 128 + row, c * 16, 128)) = pk[i]; *(LAS u32x4*)(VI + swz(cs * 128 + row, c * 16, 128)) = pv[i]; }
            if (s < 3) ATT_LOAD(s + 1);
            __syncthreads();
            if (s < 0) continue;
            int r, n; ATT_SEG(s, r, n);
            const bool has_prev = n > 0;
            const size_t grow = (size_t)bl * SEQ + (size_t)(128 * n + 16 * w + fr) * R + r;
            bf16* qptr = qb + grow * 3072 + g * 1024 + h * 64;
            bf16x8 qf[2];
#pragma unroll
            for (int ks = 0; ks < 2; ++ks) qf[ks] = *(const bf16x8*)(qptr + ks * 32 + fq * 8);
            f32x4 sc[9]; float mx = -1e30f;
#pragma unroll
            for (int j = 0; j < 9; ++j) { const int kt = w + j; const bool valid = has_prev || kt >= 8;
                const int rb = (kt < 8) ? ps * 128 + 16 * kt : cs * 128 + 16 * (kt - 8);
                if (valid) { f32x4 a = (f32x4){0.f, 0.f, 0.f, 0.f};
#pragma unroll
                    for (int ks = 0; ks < 2; ++ks) a = MFMA16(frag_row(KI, rb, ks * 64, 128, fr, fq), qf[ks], a);
                    const int idx0 = fr + 144 - 16 * j - 4 * fq;
#pragma unroll
                    for (int rr = 0; rr < 4; ++rr) { a[rr] += BT[idx0 - rr]; mx = fmaxf(mx, a[rr]); }
                    sc[j] = a;
                } else sc[j] = (f32x4){-1e30f, -1e30f, -1e30f, -1e30f};
            }
            mx = fmaxf(mx, __shfl_xor(mx, 16)); mx = fmaxf(mx, __shfl_xor(mx, 32));
            float lsum = 0.f;
#pragma unroll
            for (int j = 0; j < 9; ++j)
#pragma unroll
                for (int rr = 0; rr < 4; ++rr) { const float p = __builtin_amdgcn_exp2f(sc[j][rr] - mx); sc[j][rr] = p; lsum += p; }
            lsum += __shfl_xor(lsum, 16); lsum += __shfl_xor(lsum, 32);
            f32x4 o[4];
#pragma unroll
            for (int dt = 0; dt < 4; ++dt) o[dt] = (f32x4){0.f, 0.f, 0.f, 0.f};
#pragma unroll
            for (int jj = 0; jj < 5; ++jj) { const int t0 = 2 * jj, t1 = 2 * jj + 1;
                union { bf16x8 v; unsigned u[4]; } pb;
                pb.u[0] = cvt_pk_bf16(sc[t0][0], sc[t0][1]); pb.u[1] = cvt_pk_bf16(sc[t0][2], sc[t0][3]);
                if (t1 < 9) { pb.u[2] = cvt_pk_bf16(sc[t1 < 9 ? t1 : 8][0], sc[t1 < 9 ? t1 : 8][1]); pb.u[3] = cvt_pk_bf16(sc[t1 < 9 ? t1 : 8][2], sc[t1 < 9 ? t1 : 8][3]); } else { pb.u[2] = 0u; pb.u[3] = 0u; }
                int kt0 = w + t0, kt1 = w + t1; if (kt1 > 15) kt1 = 15;
                const bool v0 = has_prev || kt0 >= 8, v1 = has_prev || kt1 >= 8;
                const int rb0 = (kt0 < 8) ? (v0 ? ps * 128 + 16 * kt0 : cs * 128 + 16 * kt0) : cs * 128 + 16 * (kt0 - 8);
                const int rb1 = (kt1 < 8) ? (v1 ? ps * 128 + 16 * kt1 : cs * 128 + 16 * kt1) : cs * 128 + 16 * (kt1 - 8);
#pragma unroll
                for (int dt = 0; dt < 4; ++dt) o[dt] = MFMA16(frag_tr2(VI, rb0, rb1, 16 * dt, 128, lane), pb.v, o[dt]); }
            const float il = 1.0f / lsum;
#pragma unroll
            for (int dt = 0; dt < 4; ++dt) { u32x2 ww; ww.x = cvt_pk_bf16(o[dt][0] * il, o[dt][1] * il); ww.y = cvt_pk_bf16(o[dt][2] * il, o[dt][3] * il); *(u32x2*)(qptr + 16 * dt + 4 * fq) = ww; }
            if (fq == 0) ml[(grow * 3 + g) * 16 + h] = (f32x2){mx, lsum};
        }
#undef ATT_SEG
#undef ATT_LOAD
    }
    __syncthreads();
}
__device__ __forceinline__ void merge_phase(bf16* qb, const f32x2* ml, int G, int bx, const int tid) {
    const size_t nitems = (size_t)TC * 16 * 8;
    for (size_t it = (size_t)bx * 512 + tid; it < nitems; it += (size_t)G * 512) {
        const int pc = (int)(it & 7), h = (int)((it >> 3) & 15); const size_t tok = it >> 7;
        f32x2 a[3]; float M = -3e38f;
#pragma unroll
        for (int g = 0; g < 3; ++g) { a[g] = ml[(tok * 3 + g) * 16 + h]; M = fmaxf(M, a[g].x); }
        float wg[3], W = 0.f;
#pragma unroll
        for (int g = 0; g < 3; ++g) { wg[g] = __builtin_amdgcn_exp2f(a[g].x - M) * a[g].y; W += wg[g]; }
        const float iw = 1.0f / W; float acc[8];
#pragma unroll
        for (int e = 0; e < 8; ++e) acc[e] = 0.f;
        bf16* p0 = qb + tok * 3072 + h * 64 + pc * 8;
#pragma unroll
        for (int g = 0; g < 3; ++g) { const u32x4 o = *(const u32x4*)(p0 + g * 1024); const float ww = wg[g] * iw;
            acc[0] += ww * bf_lo(o.x); acc[1] += ww * bf_hi(o.x); acc[2] += ww * bf_lo(o.y); acc[3] += ww * bf_hi(o.y); acc[4] += ww * bf_lo(o.z); acc[5] += ww * bf_hi(o.z); acc[6] += ww * bf_lo(o.w); acc[7] += ww * bf_hi(o.w); }
        u32x4 r; r.x = cvt_pk_bf16(acc[0], acc[1]); r.y = cvt_pk_bf16(acc[2], acc[3]); r.z = cvt_pk_bf16(acc[4], acc[5]); r.w = cvt_pk_bf16(acc[6], acc[7]);
        *(u32x4*)p0 = r;
    }
}
__device__ __forceinline__ void router_phase(LAS unsigned char* lds, const float* hbuf, const float* wr  , const float* bg, const float* be, bf16* xn, int* list, float* gatew, unsigned* cnt, int G, int vcu, const int tid) {
    const int lane = tid & 63, w = __builtin_amdgcn_readfirstlane(tid >> 6);
    for (int i = tid; i < 9216; i += 512) *(LAS u32x4*)(lds + i * 16) = *(const u32x4*)((const char*)wr + i * 16);
    __syncthreads();
    const LAS float* WL = (const LAS float*)lds;
    for (int tk = vcu * NWAVES + w; tk < T; tk += G * NWAVES) {
        const GAS f32x4* xr = (const GAS f32x4*)(hbuf + (size_t)tk * D) + lane;
        f32x4 v[4]; float s = 0.f;
#pragma unroll
        for (int j = 0; j < 4; ++j) { v[j] = xr[64 * j]; s += (v[j].x * v[j].x + v[j].y * v[j].y) + (v[j].z * v[j].z + v[j].w * v[j].w); }
        const float rs = __builtin_amdgcn_rsqf(wave_sum(s) * (1.f / D) + 1e-6f);
        GAS unsigned long long* o8 = (GAS unsigned long long*)(xn + (size_t)tk * D) + lane;
        float a[36];
#pragma unroll
        for (int j = 0; j < 36; ++j) a[j] = 0.f;
#pragma unroll
        for (int j = 0; j < 4; ++j) { v[j] = v[j] * rs; o8[64 * j] = (unsigned long long)pk2(v[j].x, v[j].y) | ((unsigned long long)pk2(v[j].z, v[j].w) << 32);
#pragma unroll
            for (int e = 0; e < 4; ++e) { const float x = v[j][e]; const LAS f32x4* wp = (const LAS f32x4*)(WL + (e * 256 + 64 * j + lane) * 36);
#pragma unroll
                for (int q = 0; q < 9; ++q) { const f32x4 ww = wp[q]; a[4 * q] = fmaf(x, ww[0], a[4 * q]); a[4 * q + 1] = fmaf(x, ww[1], a[4 * q + 1]); a[4 * q + 2] = fmaf(x, ww[2], a[4 * q + 2]); a[4 * q + 3] = fmaf(x, ww[3], a[4 * q + 3]); }
                asm volatile("" ::: "memory"); } }
#pragma unroll
        for (int j = 0; j < 36; ++j) a[j] = wave_sum(a[j]);
        if (lane == 0) {
            float gl[4];
#pragma unroll
            for (int g = 0; g < 4; ++g) gl[g] = a[g] + bg[g];
            int grp = 0; float gbest = gl[0];
#pragma unroll
            for (int g = 1; g < 4; ++g) if (gl[g] > gbest) { gbest = gl[g]; grp = g; }
            float den = 0.f;
#pragma unroll
            for (int g = 0; g < 4; ++g) den += __expf(gl[g] - gbest);
            const float pg = 1.0f / den;
            float el[8];
#pragma unroll
            for (int e = 0; e < 8; ++e) { float vv = 0.f;
#pragma unroll
                for (int g = 0; g < 4; ++g) if (g == grp) vv = a[4 + g * 8 + e] + be[g * 8 + e];
                el[e] = vv; }
            int i0 = 0; float v0 = el[0];
#pragma unroll
            for (int e = 1; e < 8; ++e) if (el[e] > v0) { v0 = el[e]; i0 = e; }
            int i1 = -1; float v1 = -3.0e38f;
#pragma unroll
            for (int e = 0; e < 8; ++e) if (e != i0 && (i1 < 0 || el[e] > v1)) { v1 = el[e]; i1 = e; }
            const float e1 = __expf(v1 - v0); const float g0 = 1.0f / (1.0f + e1), g1 = e1 / (1.0f + e1);
            const int b0 = grp * 8 + i0, b1 = 32 + grp * 8 + i1;
            const unsigned p0 = __hip_atomic_fetch_add(cnt + b0, 1u, __ATOMIC_RELAXED, __HIP_MEMORY_SCOPE_AGENT);
            const unsigned p1 = __hip_atomic_fetch_add(cnt + b1, 1u, __ATOMIC_RELAXED, __HIP_MEMORY_SCOPE_AGENT);
            list[(size_t)b0 * T + p0] = tk; list[(size_t)b1 * T + p1] = tk;
            gatew[tk * 2] = g0 * pg; gatew[tk * 2 + 1] = g1 * pg;
        }
    }
    __syncthreads();
}
struct Args { const float* in[19]; float* out; unsigned char* ws; int ph_lo, ph_hi, flags, pad; };
enum { IN_X = 0, IN_RET_WIN, IN_RET_WOUT, IN_KV_NORM, IN_W_KV, IN_K_NORM, IN_DIL_WQ, IN_Q_NORM, IN_DIL_WO, IN_REL_BIAS, IN_MIXER_NORM, IN_FFN_NORM, IN_RGRP, IN_RGRP_B, IN_REXP, IN_REXP_B, IN_EGATE, IN_EUP, IN_EDOWN };
constexpr int NPHASE = 24;
#ifndef MK_PHMASK
#define MK_PHMASK 0xffffffu
#endif
struct PhaseCtx { int tid, lane, wave, G, bx, vcu, gw, NGW; unsigned char* ws; float* hout; };
__device__ __forceinline__ PhaseCtx phase_ctx(const Args& args, int wave_s) {
    PhaseCtx c; int tid = (wave_s << 6) | lane_id(), bx = blockIdx.x, G = gridDim.x; unsigned char* ws = args.ws; float* hout = args.out;
    asm volatile("" : "+v"(tid), "+s"(bx), "+s"(G), "+s"(ws), "+s"(hout));
    c.tid = tid; c.lane = tid & 63; c.wave = __builtin_amdgcn_readfirstlane(tid >> 6); c.G = G; c.bx = bx; c.vcu = (G % 8 == 0) ? (bx % 8) * (G / 8) + bx / 8 : bx;
    c.gw = c.vcu * NWAVES + c.wave; c.NGW = G * NWAVES; c.ws = ws; c.hout = hout; return c;
}
__device__ __forceinline__ void pro_s1(const Args& args, const PhaseCtx& c, LAS unsigned char* lds) {
    unsigned char* ws = c.ws; LAS float* scr = (LAS float*)(lds + c.wave * 16384); const int gw = c.gw, NGW = c.NGW, lane = c.lane;
    float* cosT = (float*)(ws + WS_COS); float* sinT = (float*)(ws + WS_SIN); bf16* xn = (bf16*)(ws + WS_XN); const float* x = args.in[IN_X];
    transpose_matrix(args.in[IN_RET_WIN], 1024, 6144, (bf16*)(ws + WS_WIN), scr, gw, NGW, lane, args.in[IN_MIXER_NORM], MapWin{});
    transpose_matrix(args.in[IN_RET_WOUT], 2048, 1024, (bf16*)(ws + WS_WOUT), scr, gw, NGW, lane, nullptr, MapId{0});
    for (int i = gw * 64 + lane; i < SEQ * 128; i += NGW * 64) { const int pos = i >> 7, j = i & 127;
        const float inv = 1.0f / __builtin_amdgcn_exp2f((float)j * (13.287712379549449f / 127.0f));
        const float ang = (float)pos * inv; const double rev = (double)ang * 0.15915494309189535;
        const float frc = (float)(rev - floor(rev + 0.5)) * 6.283185307179586f;
        cosT[i] = __cosf(frc); sinT[i] = __sinf(frc); }
    for (int m = gw; m < T; m += NGW) rms_row_to_bf16(x + (size_t)m * D, xn + (size_t)m * D, lane);
}
__device__ __forceinline__ void pro_moe(const Args& args, const PhaseCtx& c, LAS unsigned char* lds, int L) {
    unsigned char* ws = c.ws; LAS float* scr = (LAS float*)(lds + c.wave * 16384); const int gw = c.gw, NGW = c.NGW, lane = c.lane;
    bf16* wgu = (bf16*)(ws + (L ? WS_WGU1 : WS_WGU0)); bf16* wd = (bf16*)(ws + (L ? WS_WD1 : WS_WD0));
    const float* gain = args.in[IN_FFN_NORM] + L * D;
    for (int it = gw; it < NEXP * 768; it += NGW) { const int e = it / 768, r = it % 768, which = r >> 8, item = r & 255; const size_t eo = (size_t)(L * NEXP + e);
        if (which == 0) transpose_item(args.in[IN_EGATE] + eo * D * FF, FF, wgu + (size_t)e * 1024 * 1024, 1024, scr, item, lane, gain, MapGu{0});
        else if (which == 1) transpose_item(args.in[IN_EUP] + eo * D * FF, FF, wgu + (size_t)e * 1024 * 1024, 1024, scr, item, lane, gain, MapGu{1});
        else transpose_item(args.in[IN_EDOWN] + eo * FF * D, D, wd + (size_t)e * 1024 * 512, 512, scr, item, lane, nullptr, MapId{0}); }
    float* wr = (float*)(ws + WS_WR) + (size_t)L * 1024 * 36;
    for (int i = gw * 64 + lane; i < 1024 * 36; i += NGW * 64) { const int p = i / 36, j = i % 36, k = ((p & 255) << 2) | (p >> 8);
        wr[i] = gain[k] * (j < 4 ? args.in[IN_RGRP][((size_t)L * D + k) * 4 + j] : args.in[IN_REXP][((size_t)L * D + k) * 32 + (j - 4)]); }
}
__device__ __forceinline__ void pro_s3(const Args& args, const PhaseCtx& c, LAS unsigned char* lds) {
    unsigned char* ws = c.ws; LAS float* scr = (LAS float*)(lds + c.wave * 16384); const int gw = c.gw, NGW = c.NGW, lane = c.lane;
    transpose_matrix(args.in[IN_DIL_WQ], 1024, 3072, (bf16*)(ws + WS_WQKV1), scr, gw, NGW, lane, args.in[IN_MIXER_NORM] + D, MapQkv1{0});
    transpose_matrix(args.in[IN_W_KV], 1024, 6144, (bf16*)(ws + WS_WQKV1), scr, gw, NGW, lane, args.in[IN_KV_NORM], MapQkv1{3072});
    transpose_matrix(args.in[IN_DIL_WO], 1024, 1024, (bf16*)(ws + WS_WO1), scr, gw, NGW, lane, nullptr, MapId{0});
    if (gw == 0) { float* gt = (float*)(ws + WS_WR + 512 * 1024); for (int i = lane; i < 192; i += 64) { gt[i] = args.in[IN_Q_NORM][i]; gt[192 + i] = args.in[IN_K_NORM][i]; } }
}

__global__ void __launch_bounds__(NWAVES * 64, 2) mk_fwd(Args args) {
    extern __shared__ __attribute__((aligned(16))) unsigned char lds_raw[];
    LAS unsigned char* lds = (LAS unsigned char*)lds_raw;
    volatile LAS unsigned* MISC = (volatile LAS unsigned*)(lds + LDS_MISC);
    LAS int* TAB = (LAS int*)(lds + LDS_MISC + 64);
    const int wave_s = __builtin_amdgcn_readfirstlane(threadIdx.x >> 6);
    if (threadIdx.x < 4) MISC[threadIdx.x] = 0u;
    __syncthreads();
    XcdBarrier bar = xcd_barrier_post((unsigned*)(args.ws + WS_CTL) + CW_BAR, MISC, threadIdx.x == 0);
    int lo = args.ph_lo, hi = args.ph_hi, flg = args.flags;
#define RELAUNDER() asm volatile("" : "+s"(lo), "+s"(hi), "+s"(flg))
#define fullpro ((flg & 1) != 0)
#define IN(k) ((((MK_PHMASK) >> (k)) & 1u) && lo <= (k) && (k) < hi)
#define SEAM(k) do { asm volatile("; SEAM_MARK %0" :: "n"(k)); if (IN(k) && IN((k) + 1)) xcd_barrier(bar, wave_s); } while (0)

    if (IN(0)) { const PhaseCtx c = phase_ctx(args, wave_s); pro_s1(args, c, lds); if (fullpro) { pro_moe(args, c, lds, 0); pro_s3(args, c, lds); pro_moe(args, c, lds, 1); } }
    SEAM(0);
    if (IN(1)) { const PhaseCtx c = phase_ctx(args, wave_s); unsigned char* ws = c.ws;
        P_QKV0 p; p.A = (const char*)(ws + WS_XN); p.Bt = (const char*)(ws + WS_WIN); p.lda = 2048; p.ldb = 2048; p.K = 1024; p.so.init(T, 4096, c.G, c.bx);
        p.qk = (bf16*)(ws + WS_Q0); p.v = (bf16*)(ws + WS_V0); p.cs = (const float*)(ws + WS_COS); p.sn = (const float*)(ws + WS_SIN);
        gemm_phase(lds, p, c.tid); }
    SEAM(1);
    if (IN(2)) { const PhaseCtx c = phase_ctx(args, wave_s); unsigned char* ws = c.ws;
        retention_phase(lds, (const bf16*)(ws + WS_Q0), (const bf16*)(ws + WS_K0), (bf16*)(ws + WS_V0), (float*)(ws + WS_SSQ), c.G, c.bx, c.tid); }
    SEAM(2);
    if (IN(3)) { const PhaseCtx c = phase_ctx(args, wave_s); unsigned char* ws = c.ws;
        P_GATE p; p.A = (const char*)(ws + WS_XN); p.Bt = (const char*)(ws + WS_WIN) + (size_t)4096 * 2048; p.lda = 2048; p.ldb = 2048; p.K = 1024; p.so.init(T, 2048, c.G, c.bx);
        p.ov = (bf16*)(ws + WS_V0); p.ssq = (const float*)(ws + WS_SSQ);
        gemm_phase(lds, p, c.tid); }
    SEAM(3);
    if (IN(4)) { const PhaseCtx c = phase_ctx(args, wave_s); unsigned char* ws = c.ws;
        P_RES p; p.A = (const char*)(ws + WS_V0); p.Bt = (const char*)(ws + WS_WOUT); p.lda = 4096; p.ldb = 4096; p.K = 2048; p.so.init(T, 1024, c.G, c.bx);
        p.res = args.in[IN_X]; p.out = c.hout; p.row_off = 0;
        gemm_phase(lds, p, c.tid); }
    SEAM(4);
#pragma unroll 1
    for (int L = 0; L < 2; ++L) {
        RELAUNDER();
        const int P0 = L ? 19 : 5;
#define INL(k0, k1) (L ? IN(k1) : IN(k0))
#define SEAML(k0, k1) do { if (L) SEAM(k1); else SEAM(k0); } while (0)
        if (L == 1) {
            if (IN(10)) { const PhaseCtx c = phase_ctx(args, wave_s); if (!fullpro) pro_s3(args, c, lds); bf16* xn = (bf16*)(c.ws + WS_XN);
                const int nrows = (flg & 2) ? TC : T; for (int m = c.gw; m < nrows; m += c.NGW) rms_row_to_bf16(c.hout + (size_t)m * D, xn + (size_t)m * D, c.lane); }
            SEAM(10);
#pragma unroll 1
            for (int ch = 0; ch < 2; ++ch) {
                RELAUNDER();
#define INC(k) (ch ? IN((k) + 4) : IN(k))
#define SEAMC(k) do { if (ch) SEAM((k) + 4); else SEAM(k); } while (0)
                if (INC(11)) { const PhaseCtx c = phase_ctx(args, wave_s); unsigned char* ws = c.ws;
                    P_QKV1 p; p.A = (const char*)(ws + WS_XN) + (size_t)ch * TC * D * 2; p.Bt = (const char*)(ws + WS_WQKV1); p.lda = 2048; p.ldb = 2048; p.K = 1024; p.so.init(TC, 9216, c.G, c.bx);
                    p.qkv = (bf16*)(ws + WS_Q1); p.gains = (const float*)(ws + WS_WR + 512 * 1024);
                    gemm_phase(lds, p, c.tid); }
                SEAMC(11);
                if (INC(12)) { const PhaseCtx c = phase_ctx(args, wave_s); unsigned char* ws = c.ws;
                    attn_phase(lds, (bf16*)(ws + WS_Q1), (const bf16*)(ws + WS_K1), (const bf16*)(ws + WS_V1), (f32x2*)(ws + WS_ML), args.in[IN_REL_BIAS], c.G, c.bx, c.tid); }
                SEAMC(12);
                if (INC(13)) { const PhaseCtx c = phase_ctx(args, wave_s); merge_phase((bf16*)(c.ws + WS_Q1), (const f32x2*)(c.ws + WS_ML), c.G, c.bx, c.tid); }
                SEAMC(13);
                if (INC(14)) { const PhaseCtx c = phase_ctx(args, wave_s); unsigned char* ws = c.ws;
                    P_RES p; p.A = (const char*)(ws + WS_Q1); p.Bt = (const char*)(ws + WS_WO1); p.lda = 6144; p.ldb = 2048; p.K = 1024; p.so.init(TC, 1024, c.G, c.bx);
                    p.res = c.hout; p.out = c.hout; p.row_off = ch * TC;
                    gemm_phase(lds, p, c.tid); }
                SEAMC(14);
#undef INC
#undef SEAMC
            }
        }
        if (INL(5, 19)) { const PhaseCtx c = phase_ctx(args, wave_s); if (!fullpro) pro_moe(args, c, lds, L); }
        SEAML(5, 19);
        if (INL(6, 20)) { const PhaseCtx c = phase_ctx(args, wave_s); unsigned char* ws = c.ws;
            router_phase(lds, c.hout, (const float*)(ws + WS_WR) + (size_t)L * 1024 * 36, args.in[IN_RGRP_B] + L * 4, args.in[IN_REXP_B] + L * 32, (bf16*)(ws + WS_XN), (int*)(ws + WS_LIST), (float*)(ws + WS_GATEW),
                         (unsigned*)(ws + WS_CTL) + CW_CNT + L * 64, c.G, c.vcu, c.tid); }
        SEAML(6, 20);
        if (INL(7, 21) || INL(8, 22) || INL(9, 23)) { const PhaseCtx c = phase_ctx(args, wave_s); moe_build_tab(TAB, (const unsigned*)(c.ws + WS_CTL) + CW_CNT + L * 64, c.tid); }
        if (INL(7, 21)) { const PhaseCtx c = phase_ctx(args, wave_s); unsigned char* ws = c.ws;
            P_GU p; p.xn = (const char*)(ws + WS_XN); p.W = (const char*)(ws + (L ? WS_WGU1 : WS_WGU0)); p.list = (const int*)(ws + WS_LIST); p.hid = (bf16*)(ws + WS_HID); p.tab = TAB; p.G = c.G; p.vcu = c.vcu; p.K = 1024; p.lda = 2048; p.ldb = 2048;
            gemm_phase(lds, p, c.tid); }
        SEAML(7, 21);
#pragma unroll 1
        for (int slot = 0; slot < 2; ++slot) {
            RELAUNDER();
            if (slot ? INL(9, 23) : INL(8, 22)) { const PhaseCtx c = phase_ctx(args, wave_s); unsigned char* ws = c.ws;
                P_DN p; p.hid = (const char*)(ws + WS_HID); p.W = (const char*)(ws + (L ? WS_WD1 : WS_WD0)); p.list = (const int*)(ws + WS_LIST); p.gatew = (const float*)(ws + WS_GATEW); p.h = c.hout; p.tab = TAB; p.G = c.G; p.vcu = c.vcu; p.slot = slot; p.K = 512; p.lda = 1024; p.ldb = 1024;
                gemm_phase(lds, p, c.tid); }
            if (slot) SEAML(9, 23); else SEAML(8, 22);
        }
#undef INL
#undef SEAML
        (void)P0;
    }
#undef IN
#undef SEAM
#undef RELAUNDER
#undef fullpro
}
}
#ifndef MK_MASK
#define MK_MASK 15
#endif
#ifndef MK_SPLIT
#define MK_SPLIT 0
#endif

#ifdef MK_DEBUG
namespace dbg {
__global__ void k_cmp(const float* a, const float* b, size_t n, unsigned long long* acc) {
    double num = 0.0, den = 0.0; unsigned long long bad = 0;
    for (size_t i = (size_t)blockIdx.x * blockDim.x + threadIdx.x; i < n; i += (size_t)gridDim.x * blockDim.x) { const float x = a[i], y = b[i]; const float d = x - y; if (!(d - d == 0.0f)) { ++bad; continue; } num += (double)d * d; den += (double)x * x; }
    for (int o = 32; o >= 1; o >>= 1) { num += __shfl_xor(num, o); den += __shfl_xor(den, o); bad += __shfl_xor(bad, o); }
    if ((threadIdx.x & 63) == 0) { atomicAdd(acc, (unsigned long long)(num * 1048576.0)); atomicAdd(acc + 1, (unsigned long long)(den * 1048576.0)); atomicAdd(acc + 2, bad); }
}
__global__ void k_code(const unsigned long long* acc, float* scale) {
    const double num = (double)acc[0], den = (double)acc[1]; const double e = sqrt(num / (den + 1.0));
    int code = e < 0.01 ? 0 : (e < 0.03 ? 1 : (e < 0.1 ? 2 : (e < 0.3 ? 3 : (e < 1.0 ? 4 : 5)))); if (acc[2]) code = 7;
    scale[0] = 1.0f + 0.1f * (float)code;
}
__global__ void k_cmp_bf(const unsigned short* nw, const float* ref, int ldr, int offr, int mode, unsigned long long* acc, int tlo = 0, int thi = 2048) {
    double num = 0.0, den = 0.0; unsigned long long bad = 0;
    const size_t n = mode < 2 ? (size_t)2048 * 1024 : (size_t)2048 * 2048;
    for (size_t i = (size_t)blockIdx.x * blockDim.x + threadIdx.x; i < n; i += (size_t)gridDim.x * blockDim.x) {
        float x, y;
        if (mode < 2) { const int t = (int)(i >> 10), col = (int)(i & 1023), hh = col >> 8, d = col & 255, c = d < 128 ? 2 * d : 2 * (d - 128) + 1;
            const float l2g = log2f(1.0f - exp2f(-5.0f - (float)hh)); const float sc = exp2f((mode == 0 ? -l2g : l2g) * (float)(t & 63));
            y = __uint_as_float(((unsigned)nw[(size_t)t * 1024 + hh * 256 + c]) << 16) * sc; x = ref[(size_t)t * ldr + offr + col]; }
        else { const int t = (int)(i >> 11), col = (int)(i & 2047); if (t < tlo || t >= thi) continue; y = __uint_as_float(((unsigned)nw[(size_t)t * 2048 + col]) << 16); x = ref[(size_t)t * ldr + offr + col]; }
        const float dd = x - y; if (!(dd - dd == 0.0f)) { ++bad; continue; } num += (double)dd * dd; den += (double)x * x; }
    for (int o = 32; o >= 1; o >>= 1) { num += __shfl_xor(num, o); den += __shfl_xor(den, o); bad += __shfl_xor(bad, o); }
    if ((threadIdx.x & 63) == 0) { atomicAdd(acc, (unsigned long long)(num * 1048576.0)); atomicAdd(acc + 1, (unsigned long long)(den * 1048576.0)); atomicAdd(acc + 2, bad); }
}
__device__ inline int code_of(const unsigned long long* acc) { const double e = sqrt((double)acc[0] / ((double)acc[1] + 1.0)); int code = e < 0.01 ? 0 : (e < 0.03 ? 1 : (e < 0.1 ? 2 : (e < 0.3 ? 3 : (e < 1.0 ? 4 : 5)))); if (acc[2]) code = 7; return code; }
__global__ void k_code3(const unsigned long long* acc, float* scale) { scale[0] = 1.0f + 0.1f * (float)code_of(acc); scale[1] = 100.0f * (float)(code_of(acc + 4) + 1) + 10.0f * (float)code_of(acc + 8); }
__global__ void k_spike(float* out, const float* scale) { out[0] += scale[1]; }
__global__ void k_scale(float* out, const float* scale, size_t n) { const float s = scale[0]; for (size_t i = (size_t)blockIdx.x * blockDim.x + threadIdx.x; i < n; i += (size_t)gridDim.x * blockDim.x) out[i] *= s; }
}
#endif
extern "C" void kernel_launch(void* const* d_in, const int* in_sizes, int n_in, void* d_out, int out_size, void* d_ws, size_t ws_size, hipStream_t stream) {
    (void)in_sizes; (void)n_in; (void)out_size;
    if (ws_size < mk::WS_END) return;
    static int configured = 0;
    if (!configured) { if (hipFuncSetAttribute((const void*)mk::mk_fwd, hipFuncAttributeMaxDynamicSharedMemorySize, mk::LDS_BYTES) != hipSuccess) return; configured = 1; }
    mk::Args a{};
    for (int i = 0; i < 19; ++i) a.in[i] = (const float*)d_in[i];
    a.out = (float*)d_out; a.ws = (unsigned char*)d_ws; a.pad = 0;
    const int mask = MK_MASK;
    auto run_new = [&](int lo, int hi, int flags) {
        (void)hipMemsetAsync((char*)d_ws + mk::WS_CTL, 0, mk::CTL_BYTES, stream);
        if (MK_SPLIT) { for (int p = lo; p < hi; ++p) { a.ph_lo = p; a.ph_hi = p + 1; a.flags = flags; hipLaunchKernelGGL(mk::mk_fwd, dim3(256), dim3(512), mk::LDS_BYTES, stream, a); } }
        else { a.ph_lo = lo; a.ph_hi = hi; a.flags = flags; hipLaunchKernelGGL(mk::mk_fwd, dim3(256), dim3(512), mk::LDS_BYTES, stream, a); }
    };
#ifdef MK_DEBUG
    {
        const size_t MiB = mk::MiB; const size_t nall = (size_t)mk::T * mk::D;
        if (ws_size < 580 * MiB) return;
        nv::Ctx c; nv::ctx_init(c, d_in, d_out, d_ws, stream);
        unsigned long long* acc = (unsigned long long*)((char*)d_ws + 575 * MiB); float* scl = (float*)((char*)d_ws + 575 * MiB + 256);
        float* dout = (float*)d_out; float* alt = nullptr; size_t ncmp = nall;
        if (MK_DEBUG == 1) { nv::stage_mixer0(c); alt = (float*)((char*)d_ws + mk::WS_Q0); a.out = alt; run_new(0, 5, 0); }
        else if (MK_DEBUG == 11) {
            nv::stage_mixer0(c);
            float* xn_n = (float*)((char*)d_ws + 62 * MiB); float* pj_n = (float*)((char*)d_ws + 70 * MiB); float* oc_n = (float*)((char*)d_ws + 118 * MiB);
            (void)hipMemsetAsync(acc, 0, 512, stream);
            run_new(0, 2, 0);
            hipLaunchKernelGGL(nv::k_rmsnorm, dim3(2048 / 4), dim3(256), 0, stream, c.x, c.mixer_norm, xn_n, 2048);
            { nv::GemmP g{}; g.A = xn_n; g.lda = 1024; g.B = c.ret_w_in; g.ldb = 6144; g.C = pj_n; g.ldc = 6144; g.M = 2048; g.N = 6144; g.K = 1024; g.mode = 0; nv::gemm(stream, g); }
            hipLaunchKernelGGL(nv::k_rotary, dim3(2048 * 1024 / 256), dim3(256), 0, stream, pj_n, 2048);
            hipLaunchKernelGGL(dbg::k_cmp_bf, dim3(512), dim3(256), 0, stream, (const unsigned short*)((char*)d_ws + mk::WS_Q0), (const float*)pj_n, 6144, 0, 0, acc);
            hipLaunchKernelGGL(dbg::k_cmp_bf, dim3(512), dim3(256), 0, stream, (const unsigned short*)((char*)d_ws + mk::WS_K0), (const float*)pj_n, 6144, 1024, 1, acc);
            hipLaunchKernelGGL(dbg::k_cmp_bf, dim3(512), dim3(256), 0, stream, (const unsigned short*)((char*)d_ws + mk::WS_V0), (const float*)pj_n, 6144, 2048, 2, acc);
            run_new(2, 3, 0);
            hipLaunchKernelGGL(nv::k_retention, dim3(64, 4, 1), dim3(256), 0, stream, (const float*)pj_n, oc_n);
            hipLaunchKernelGGL(dbg::k_cmp_bf, dim3(512), dim3(256), 0, stream, (const unsigned short*)((char*)d_ws + mk::WS_V0), (const float*)oc_n, 2048, 0, 2, acc + 4);
            run_new(3, 4, 0);
            hipLaunchKernelGGL(nv::k_gnorm_gate, dim3(2048), dim3(256), 0, stream, oc_n, (const float*)pj_n, 2048);
            hipLaunchKernelGGL(dbg::k_cmp_bf, dim3(512), dim3(256), 0, stream, (const unsigned short*)((char*)d_ws + mk::WS_V0), (const float*)oc_n, 2048, 0, 2, acc + 8);
            hipLaunchKernelGGL(dbg::k_code3, dim3(1), dim3(1), 0, stream, (const unsigned long long*)acc, scl);
            nv::stage_moe(c, 0); nv::stage_mixer1(c); nv::stage_moe(c, 1);
            hipLaunchKernelGGL(dbg::k_scale, dim3(1024), dim3(256), 0, stream, dout, (const float*)scl, nall);
            hipLaunchKernelGGL(dbg::k_spike, dim3(1), dim3(1), 0, stream, dout, (const float*)scl);
            return;
        }
        else if (MK_DEBUG == 12) {
            nv::stage_mixer0(c);
            float* xn_n = (float*)((char*)d_ws + 62 * MiB); float* pj_n = (float*)((char*)d_ws + 70 * MiB); float* oc_n = (float*)((char*)d_ws + 118 * MiB);
            (void)hipMemsetAsync(acc, 0, 512, stream);
            run_new(0, 3, 0);
            hipLaunchKernelGGL(nv::k_rmsnorm, dim3(2048 / 4), dim3(256), 0, stream, c.x, c.mixer_norm, xn_n, 2048);
            { nv::GemmP g{}; g.A = xn_n; g.lda = 1024; g.B = c.ret_w_in; g.ldb = 6144; g.C = pj_n; g.ldc = 6144; g.M = 2048; g.N = 6144; g.K = 1024; g.mode = 0; nv::gemm(stream, g); }
            hipLaunchKernelGGL(nv::k_rotary, dim3(2048 * 1024 / 256), dim3(256), 0, stream, pj_n, 2048);
            hipLaunchKernelGGL(nv::k_retention, dim3(64, 4, 1), dim3(256), 0, stream, (const float*)pj_n, oc_n);
            hipLaunchKernelGGL(dbg::k_cmp_bf, dim3(512), dim3(256), 0, stream, (const unsigned short*)((char*)d_ws + mk::WS_V0), (const float*)oc_n, 2048, 0, 2, acc, 0, 64);
            hipLaunchKernelGGL(dbg::k_cmp_bf, dim3(512), dim3(256), 0, stream, (const unsigned short*)((char*)d_ws + mk::WS_V0), (const float*)oc_n, 2048, 0, 2, acc + 4, 64, 128);
            hipLaunchKernelGGL(dbg::k_cmp_bf, dim3(512), dim3(256), 0, stream, (const unsigned short*)((char*)d_ws + mk::WS_V0), (const float*)oc_n, 2048, 0, 2, acc + 8, 128, 2048);
            hipLaunchKernelGGL(dbg::k_code3, dim3(1), dim3(1), 0, stream, (const unsigned long long*)acc, scl);
            nv::stage_moe(c, 0); nv::stage_mixer1(c); nv::stage_moe(c, 1);
            hipLaunchKernelGGL(dbg::k_scale, dim3(1024), dim3(256), 0, stream, dout, (const float*)scl, nall);
            hipLaunchKernelGGL(dbg::k_spike, dim3(1), dim3(1), 0, stream, dout, (const float*)scl);
            return;
        }
        else nv::stage_mixer0(c);
        if (MK_DEBUG == 2) { alt = (float*)((char*)d_ws + 446 * MiB); (void)hipMemcpyAsync(alt, dout, nall * 4, hipMemcpyDeviceToDevice, stream); nv::stage_moe(c, 0); a.out = alt; run_new(5, 10, 0); }
        else if (MK_DEBUG > 2) nv::stage_moe(c, 0);
        if (MK_DEBUG == 3) { alt = (float*)((char*)d_ws + 510 * MiB); ncmp = (size_t)mk::TC * mk::D; (void)hipMemcpyAsync(alt, dout, ncmp * 4, hipMemcpyDeviceToDevice, stream); nv::stage_mixer1(c); a.out = alt; run_new(10, 15, 2); }
        else if (MK_DEBUG > 3) nv::stage_mixer1(c);
        if (MK_DEBUG == 4) { alt = (float*)((char*)d_ws + 446 * MiB); (void)hipMemcpyAsync(alt, dout, nall * 4, hipMemcpyDeviceToDevice, stream); nv::stage_moe(c, 1); a.out = alt; run_new(19, 24, 0); }
        (void)hipMemsetAsync(acc, 0, 512, stream);
        hipLaunchKernelGGL(dbg::k_cmp, dim3(1024), dim3(256), 0, stream, (const float*)dout, (const float*)alt, ncmp, acc);
        hipLaunchKernelGGL(dbg::k_code, dim3(1), dim3(1), 0, stream, (const unsigned long long*)acc, scl);
        if (MK_DEBUG < 2) nv::stage_moe(c, 0);
        if (MK_DEBUG < 3) nv::stage_mixer1(c);
        if (MK_DEBUG < 4) nv::stage_moe(c, 1);
        hipLaunchKernelGGL(dbg::k_scale, dim3(1024), dim3(256), 0, stream, dout, (const float*)scl, nall);
        return;
    }
#endif
    if (mask == 15) { run_new(0, mk::NPHASE, MK_SPLIT ? 0 : 1); return; }
#ifdef MK_WITH_NAIVE
    nv::Ctx c; nv::ctx_init(c, d_in, d_out, d_ws, stream);
    if (mask & 1) run_new(0, 5, 0); else nv::stage_mixer0(c);
    if (mask & 2) run_new(5, 10, 0); else nv::stage_moe(c, 0);
    if (mask & 4) run_new(10, 19, 0); else nv::stage_mixer1(c);
    if (mask & 8) run_new(19, 24, 0); else nv::stage_moe(c, 1);
#endif
}
```

```cpp
#include <hip/hip_runtime.h>
#include <cstdio>
#include <cstdint>
#define MK_MASK 15
#define MK_SPLIT 0
namespace mk {
#define LAS __attribute__((address_space(3)))
#define GAS __attribute__((address_space(1)))
typedef unsigned short bf16;
typedef short bf16x8 __attribute__((ext_vector_type(8)));
typedef short s16x4 __attribute__((ext_vector_type(4)));
typedef float f32x4 __attribute__((ext_vector_type(4)));
typedef float f32x2 __attribute__((ext_vector_type(2)));
typedef unsigned u32x4 __attribute__((ext_vector_type(4)));
typedef unsigned u32x2 __attribute__((ext_vector_type(2)));
typedef GAS unsigned gu32;

constexpr int T = 32768, D = 1024, SEQ = 2048, NB = 16;
constexpr int NEXP = 32, FF = 512;
constexpr int TC = 16384;
constexpr size_t MiB = 1u << 20;
constexpr size_t WS_CTL = 0, CTL_BYTES = 1 * MiB;
constexpr size_t WS_COS = 1 * MiB, WS_SIN = 2 * MiB, WS_WR = 3 * MiB;
constexpr size_t WS_SSQ = 4 * MiB, WS_ML = 8 * MiB, WS_LIST = 16 * MiB, WS_GATEW = 24 * MiB;
constexpr size_t WS_WIN = 26 * MiB, WS_WOUT = 38 * MiB, WS_WQKV1 = 42 * MiB, WS_WO1 = 60 * MiB;
constexpr size_t WS_WGU1 = 62 * MiB, WS_WD1 = 126 * MiB;
constexpr size_t WS_XN = 158 * MiB;
constexpr size_t WS_WGU0 = 222 * MiB, WS_WD0 = 286 * MiB;
constexpr size_t WS_ACT = 318 * MiB;
constexpr size_t WS_Q0 = WS_ACT, WS_K0 = WS_ACT + 64 * MiB, WS_V0 = WS_ACT + 128 * MiB;
constexpr size_t WS_HID = WS_ACT, WS_YB = WS_ACT + 72 * MiB;
constexpr size_t WS_Q1 = 222 * MiB, WS_K1 = 318 * MiB, WS_V1 = 414 * MiB, WS_AO = 510 * MiB;
constexpr size_t WS_END = 574 * MiB;
constexpr int CW_BAR = 4096;
constexpr int CW_CNT = 16384;
constexpr int LDS_MISC = 155648;
constexpr int LDS_BYTES = 159 * 1024;
constexpr int NWAVES = 8;

#define LDS_WAIT() asm volatile("s_waitcnt lgkmcnt(0)" ::: "memory")
#define VM_WAIT() asm volatile("s_waitcnt vmcnt(0)" ::: "memory")
__device__ __forceinline__ unsigned f2bf(float f) { unsigned u = __builtin_bit_cast(unsigned, f); return (u + 0x7fffu + ((u >> 16) & 1u)) >> 16; }
__device__ __forceinline__ unsigned pk2(float lo, float hi) { return f2bf(lo) | (f2bf(hi) << 16); }
typedef __bf16 bf16pair_t __attribute__((ext_vector_type(2)));
__device__ __forceinline__ unsigned cvt_pk_bf16(float lo, float hi) { bf16pair_t v; v.x = (__bf16)lo; v.y = (__bf16)hi; return __builtin_bit_cast(unsigned, v); }
__device__ __forceinline__ float bf_lo(unsigned u) { return __builtin_bit_cast(float, u << 16); }
__device__ __forceinline__ float bf_hi(unsigned u) { return __builtin_bit_cast(float, u & 0xffff0000u); }
#define LDS_BARRIER() do { asm volatile("s_waitcnt lgkmcnt(0)" ::: "memory"); __builtin_amdgcn_s_barrier(); asm volatile("" ::: "memory"); } while (0)
__device__ __forceinline__ float xsum16(float x) { const unsigned u = __builtin_bit_cast(unsigned, x); const auto r = __builtin_amdgcn_permlane16_swap(u, u, false, false); return __builtin_bit_cast(float, (unsigned)r[0]) + __builtin_bit_cast(float, (unsigned)r[1]); }
__device__ __forceinline__ float xsum32(float x) { const unsigned u = __builtin_bit_cast(unsigned, x); const auto r = __builtin_amdgcn_permlane32_swap(u, u, false, false); return __builtin_bit_cast(float, (unsigned)r[0]) + __builtin_bit_cast(float, (unsigned)r[1]); }
__device__ __forceinline__ float xmax16(float x) { const unsigned u = __builtin_bit_cast(unsigned, x); const auto r = __builtin_amdgcn_permlane16_swap(u, u, false, false); return fmaxf(__builtin_bit_cast(float, (unsigned)r[0]), __builtin_bit_cast(float, (unsigned)r[1])); }
__device__ __forceinline__ float xmax32(float x) { const unsigned u = __builtin_bit_cast(unsigned, x); const auto r = __builtin_amdgcn_permlane32_swap(u, u, false, false); return fmaxf(__builtin_bit_cast(float, (unsigned)r[0]), __builtin_bit_cast(float, (unsigned)r[1])); }
__device__ __forceinline__ float dpp_add(float x, const int ctrl) { return x; }
__device__ __forceinline__ float wave_sum(float v) {
    v += __builtin_bit_cast(float, __builtin_amdgcn_update_dpp(0, __builtin_bit_cast(int, v), 0xB1, 0xF, 0xF, true));
    v += __builtin_bit_cast(float, __builtin_amdgcn_update_dpp(0, __builtin_bit_cast(int, v), 0x4E, 0xF, 0xF, true));
    v += __builtin_bit_cast(float, __builtin_amdgcn_update_dpp(0, __builtin_bit_cast(int, v), 0x141, 0xF, 0xF, true));
    v += __builtin_bit_cast(float, __builtin_amdgcn_update_dpp(0, __builtin_bit_cast(int, v), 0x140, 0xF, 0xF, true));
    return xsum32(xsum16(v));
}
__device__ __forceinline__ float silu_f(float x) { return x * __builtin_amdgcn_rcpf(1.0f + __builtin_amdgcn_exp2f(-1.4426950408889634f * x)); }

#define XB_TMO      128
#define XB_XCNT(j)  (256  + 64 * (j))
#define XB_XSUB(j)  (1280 + 64 * (j))
#define XB_XGEN(j)  (2304 + 64 * (j))
#define XB_TOP      3328
#define XB_TOPGEN   3392
#define XCD_BAR_WORDS 3456
#define XB_SPIN_CAP (1u << 22)
__device__ __forceinline__ unsigned xb_ld(unsigned* p)              { return __hip_atomic_load(p, __ATOMIC_RELAXED, __HIP_MEMORY_SCOPE_AGENT); }
__device__ __forceinline__ unsigned xb_add(unsigned* p, unsigned v) { return __hip_atomic_fetch_add(p, v, __ATOMIC_RELAXED, __HIP_MEMORY_SCOPE_AGENT); }
__device__ __forceinline__ unsigned xb_xcc_id() { return (unsigned)__builtin_amdgcn_s_getreg((3 << 11) | 20) & 0xFu; }
#define XB_SPIN(cond, bar) do { unsigned _sp = 0; while (cond) { __builtin_amdgcn_s_sleep(1); \
    if ((++_sp & 255u) == 0u) { if (xb_ld(&(bar)[XB_TMO])) break; if (_sp > XB_SPIN_CAP) { atomicAdd(&(bar)[XB_TMO], 1u); break; } } } } while (0)
struct XcdBarrier { unsigned* bar; unsigned x; volatile LAS unsigned* st; };
__device__ __forceinline__ int lane_id() { int l; asm volatile("v_mbcnt_lo_u32_b32 %0, -1, 0\n\tv_mbcnt_hi_u32_b32 %0, -1, %0" : "=v"(l)); return l; }
__device__ __forceinline__ XcdBarrier xcd_barrier_post(unsigned* bar, volatile LAS unsigned* st, bool t0) {
    XcdBarrier b; b.bar = bar; b.x = xb_xcc_id(); b.st = st;
    if (t0) (void)xb_add(&bar[XB_XCNT(b.x)], 1u);
    return b;
}
__device__ __forceinline__ void xcd_barrier_complete(unsigned* bar, unsigned x, unsigned& nloc, unsigned& nx) {
    const unsigned G = gridDim.x * gridDim.y * gridDim.z;
    unsigned sum, cnt, mine, sp = 0u;
    for (;;) {
        sum = 0u; cnt = 0u; mine = 0u;
#pragma unroll
        for (unsigned j = 0; j < 16; ++j) { const unsigned c = xb_ld(&bar[XB_XCNT(j)]); sum += c; cnt += (c > 0u) ? 1u : 0u; mine = (j == x) ? c : mine; }
        if (sum == G) break;
        __builtin_amdgcn_s_sleep(1);
        if ((++sp & 255u) == 0u) { if (xb_ld(&bar[XB_TMO])) break; if (sp > XB_SPIN_CAP) { atomicAdd(&bar[XB_TMO], 1u); break; } }
    }
    nloc = mine > 0u ? mine : 1u; nx = cnt > 0u ? cnt : 1u;
}
__device__ __forceinline__ void xcd_barrier(const XcdBarrier& b, int wave_s) {
    asm volatile("s_waitcnt vmcnt(0)" ::: "memory");
    __syncthreads();
    if (wave_s == 0 && lane_id() == 0) {
        unsigned* bar = b.bar;
        __builtin_amdgcn_s_waitcnt(0);
        unsigned nloc = b.st[0], nx = b.st[1];
        if (nloc == 0u) { xcd_barrier_complete(bar, b.x, nloc, nx); b.st[0] = nloc; b.st[1] = nx; }
        const unsigned old = xb_add(&bar[XB_XSUB(b.x)], 1u);
        const unsigned gen = old / nloc;
        if (old + 1u == (gen + 1u) * nloc) {
            __builtin_amdgcn_fence(__ATOMIC_RELEASE, "agent");
            asm volatile("s_waitcnt vmcnt(0)" ::: "memory");
            const unsigned og = xb_add(&bar[XB_TOP], 1u);
            const unsigned tg = og / nx;
            if (og + 1u == (tg + 1u) * nx) xb_add(&bar[XB_TOPGEN], 1u);
            else XB_SPIN(xb_ld(&bar[XB_TOPGEN]) == tg, bar);
            __builtin_amdgcn_fence(__ATOMIC_ACQUIRE, "agent");
            xb_add(&bar[XB_XGEN(b.x)], 1u);
            asm volatile("s_waitcnt vmcnt(0)" ::: "memory");
        } else {
            XB_SPIN(xb_ld(&bar[XB_XGEN(b.x)]) == gen, bar);
            __builtin_amdgcn_fence(__ATOMIC_ACQUIRE, "agent");
            asm volatile("s_waitcnt vmcnt(0)" ::: "memory");
        }
    }
    __syncthreads();
}

constexpr int BM = 256, BK = 64, HALF = 128, HTB = HALF * BK * 2, NXCD = 8, WGM = 8;
__host__ __device__ __forceinline__ int lds_byte(int r, int c) { const int st = (r >> 4) * 2 + (c >> 5), rr = r & 15, cc = c & 31, ob = rr * 64 + cc * 2; return st * 1024 + (ob ^ (((ob >> 9) & 1) << 5)); }
__host__ __device__ __forceinline__ void stage_rc(int b, int& R, int& C) { const int st = b / 1024, sb = b % 1024, swz = sb ^ (((sb >> 9) & 1) << 5); R = (st >> 1) * 16 + swz / 64; C = (st & 1) * 32 + (swz % 64) / 2; }
__host__ __device__ __forceinline__ int perm32(int rho) { const int n = rho >> 4, i = rho & 15; return 8 * (i >> 2) + 4 * n + (i & 3); }
struct Unit { int pm, pn, a0, a1; };
struct StaticOrder {
    int nM, nN, nwg, G, c;
    __device__ __forceinline__ void init(int M, int N, int G_, int c_) { nM = M / BM; nN = N / BM; nwg = nM * nN; G = G_; c = c_; }
    __device__ __forceinline__ bool next(int i, Unit& u) const {
        const long L = (long)i * G + c; if (L >= nwg) return false;
        int wgid = (int)L; { const int q = nwg / NXCD, r = nwg % NXCD, xcd = wgid % NXCD, off = wgid / NXCD; wgid = (xcd < r ? xcd * (q + 1) : r * (q + 1) + (xcd - r) * q) + off; }
        const int nig = WGM * nN, gid = wgid / nig, fm = gid * WGM, gsz = (nM - fm) < WGM ? (nM - fm) : WGM;
        u.pm = __builtin_amdgcn_readfirstlane(fm + ((wgid % nig) % gsz)); u.pn = __builtin_amdgcn_readfirstlane((wgid % nig) / gsz); u.a0 = 0; u.a1 = 0; return true;
    }
};
template <class P>
__device__ __forceinline__ void gemm_phase(LAS unsigned char* lds, const P& S, const int tid, const bool dry = false, const int stagger = 0) {
    const int wid = __builtin_amdgcn_readfirstlane(tid >> 6), lane = tid & 63, wr = wid >> 2, wc = wid & 3, fr = lane & 15, fq = lane >> 4;
    const int K = S.K, nt = K / BK;
    unsigned voffB[2]; unsigned vA[2][2];
    LAS u32x4* vslot = (LAS u32x4*)(lds + 131072) + tid;
#pragma unroll
    for (int i = 0; i < 2; ++i) { int R, C; stage_rc(tid * 16 + i * 8192, R, C); const int Rb = P::PERM ? ((R & ~31) + perm32(R & 31)) : R;
        voffB[i] = (unsigned)Rb * S.ldb + (unsigned)C * 2u;
#pragma unroll
        for (int h = 0; h < 2; ++h) vA[h][i] = (unsigned)(h * HALF + R) * S.lda + (unsigned)C * 2u; }
    const size_t kstep = (size_t)(BK * 2);
    const size_t hstepB = (size_t)HALF * S.ldb;
    const unsigned ldsw = (unsigned)wid * 1024u;
    const int aoff = lds_byte(wr * 64 + fr, fq * 8), boff = lds_byte(wc * 32 + fr, fq * 8);
#define PG8_SA(b, h) (((b) * 2 + (h)) * HTB)
#define PG8_SB(b, h) ((4 + (b) * 2 + (h)) * HTB)
#define PG8_STAGE(bufoff, gbase, voff) do { _Pragma("unroll") for (int _i = 0; _i < 2; ++_i) \
        __builtin_amdgcn_global_load_lds((const unsigned*)((const char*)(gbase) + (voff)[_i]), (LAS unsigned*)(lds + (bufoff) + ldsw + _i * 8192), 16, 0, 0); } while (0)
#define PG8_LDA(dst, b, h) do { _Pragma("unroll") for (int m = 0; m < 4; ++m) _Pragma("unroll") for (int k = 0; k < 2; ++k) dst[m][k] = *(const LAS bf16x8*)(lds + PG8_SA(b, h) + aoff + m * 2048 + k * 1024); } while (0)
#define PG8_LDB(dst, b, h) do { _Pragma("unroll") for (int n = 0; n < 2; ++n) _Pragma("unroll") for (int k = 0; k < 2; ++k) dst[n][k] = *(const LAS bf16x8*)(lds + PG8_SB(b, h) + boff + n * 2048 + k * 1024); } while (0)
#define PG8_MMA(ai, bj, At, Bt) do { __builtin_amdgcn_s_setprio(1); _Pragma("unroll") for (int m = 0; m < 4; ++m) _Pragma("unroll") for (int n = 0; n < 2; ++n) _Pragma("unroll") for (int k = 0; k < 2; ++k) \
        acc[ai][bj][m][n] = __builtin_amdgcn_mfma_f32_16x16x32_bf16(Bt[n][k], At[m][k], acc[ai][bj][m][n], 0, 0, 0); __builtin_amdgcn_s_setprio(0); } while (0)
#define PG8_WAIT_V(n) asm volatile("s_waitcnt vmcnt(" #n ")" ::: "memory")
#define PG8_WAIT_L(n) asm volatile("s_waitcnt lgkmcnt(" #n ")" ::: "memory")
#define PG8_BAR __builtin_amdgcn_s_barrier()
#define PG8_SCHED __builtin_amdgcn_sched_barrier(0)
    Unit cur, nxt; int ui = 0;
    if (!S.next(0, cur)) return;
    if (stagger > 0) { const int cls = (int)(blockIdx.x & 7u); for (int i = 0; i < cls * stagger; ++i) __builtin_amdgcn_s_sleep(16); }
    f32x4 acc[2][2][4][2];
#pragma unroll
    for (int a = 0; a < 2; ++a)
#pragma unroll
        for (int b = 0; b < 2; ++b)
#pragma unroll
            for (int m = 0; m < 4; ++m)
#pragma unroll
                for (int n = 0; n < 2; ++n) acc[a][b][m][n] = (f32x4){0.f, 0.f, 0.f, 0.f};
    bf16x8 At[4][2], B0[2][2], B1[2][2];
    const char* cA = S.a_base(cur); const char* cB = S.b_base(cur);
    bool skip_hi = P::HALFABLE && (cur.a0 >> 6) != 0;
    if constexpr (P::GATHER) { S.a_rows(cur, tid, vA); }
    PG8_STAGE(PG8_SB(0, 0), cB, voffB); PG8_STAGE(PG8_SB(0, 1), cB + hstepB, voffB); PG8_STAGE(PG8_SA(0, 0), cA, vA[0]); PG8_STAGE(PG8_SA(0, 1), cA, vA[1]);
    if (wr == 1) PG8_BAR;
    PG8_WAIT_V(2); PG8_BAR;
    PG8_STAGE(PG8_SB(1, 0), cB + kstep, voffB); PG8_STAGE(PG8_SA(1, 0), cA + kstep, vA[0]); PG8_STAGE(PG8_SB(1, 1), cB + hstepB + kstep, voffB);
    PG8_WAIT_V(6); PG8_BAR;
    for (;;) {
        const bool has_next = S.next(ui + 1, nxt);
        const char* nA = has_next ? S.a_base(nxt) : cA; const char* nB = has_next ? S.b_base(nxt) : cB;
        for (int t = 0; t < nt; t += 2) {
            const bool last = (t == nt - 2);
            if constexpr (P::GATHER) { if (t == nt - 4 && has_next) { unsigned tn[2][2]; S.a_rows(nxt, tid, tn); *vslot = (u32x4){tn[0][0], tn[0][1], tn[1][0], tn[1][1]}; } }
            const char* a1 = cA + (size_t)(t + 1) * kstep;
            const char* a2 = last ? nA : cA + (size_t)(t + 2) * kstep; const char* b2 = last ? nB : cB + (size_t)(t + 2) * kstep;
            const char* a3 = a2 + kstep; const char* b3 = b2 + kstep;
            unsigned v2[2][2];
#pragma unroll
            for (int h = 0; h < 2; ++h)
#pragma unroll
                for (int i = 0; i < 2; ++i) v2[h][i] = vA[h][i];
            if constexpr (P::GATHER) { if (last && has_next) { const u32x4 tn = *vslot; v2[0][0] = tn.x; v2[0][1] = tn.y; v2[1][0] = tn.z; v2[1][1] = tn.w; } }
            PG8_LDB(B0, 0, 0); PG8_LDB(B1, 0, 1); PG8_SCHED; PG8_LDA(At, 0, 0); PG8_STAGE(PG8_SA(1, 1), a1, vA[1]);
            PG8_WAIT_V(8); PG8_WAIT_L(0); PG8_BAR; PG8_MMA(0, 0, At, B0); PG8_MMA(0, 1, At, B1); PG8_BAR; PG8_SCHED;
            PG8_LDA(At, 0, 1); PG8_STAGE(PG8_SB(0, 0), b2, voffB); PG8_STAGE(PG8_SB(0, 1), b2 + hstepB, voffB); PG8_STAGE(PG8_SA(0, 0), a2, v2[0]);
            PG8_WAIT_V(8); PG8_WAIT_L(0); PG8_BAR; if (!skip_hi) { PG8_MMA(1, 0, At, B0); PG8_MMA(1, 1, At, B1); } PG8_BAR; PG8_SCHED;
            PG8_LDB(B0, 1, 0); PG8_LDB(B1, 1, 1); PG8_SCHED; PG8_LDA(At, 1, 0); PG8_STAGE(PG8_SA(0, 1), a2, v2[1]);
            PG8_WAIT_V(8); PG8_WAIT_L(0); PG8_BAR; PG8_MMA(0, 0, At, B0); PG8_MMA(0, 1, At, B1); PG8_BAR; PG8_SCHED;
            PG8_LDA(At, 1, 1); PG8_STAGE(PG8_SB(1, 0), b3, voffB); PG8_STAGE(PG8_SB(1, 1), b3 + hstepB, voffB); PG8_STAGE(PG8_SA(1, 0), a3, v2[0]);
            PG8_WAIT_V(8); PG8_WAIT_L(0); PG8_BAR; if (!skip_hi) { PG8_MMA(1, 0, At, B0); PG8_MMA(1, 1, At, B1); } PG8_BAR; PG8_SCHED;
        }
        if (wr == 0) PG8_BAR;
        { int fr_e = fr, fq_e = fq; asm volatile("" : "+v"(fr_e), "+v"(fq_e));
          if (!dry) S.epi(acc, cur, wr, wc, fr_e, fq_e); }
        if (!has_next) break;
#pragma unroll
        for (int a = 0; a < 2; ++a)
#pragma unroll
            for (int b = 0; b < 2; ++b)
#pragma unroll
                for (int m = 0; m < 4; ++m)
#pragma unroll
                    for (int n = 0; n < 2; ++n) acc[a][b][m][n] = (f32x4){0.f, 0.f, 0.f, 0.f};
        cur = nxt; cA = nA; cB = nB; ++ui; skip_hi = P::HALFABLE && (cur.a0 >> 6) != 0;
        if constexpr (P::GATHER) { const u32x4 tn = *vslot; vA[0][0] = tn.x; vA[0][1] = tn.y; vA[1][0] = tn.z; vA[1][1] = tn.w; }
        if (wr == 1) PG8_BAR;
    }
    PG8_WAIT_V(0);
    PG8_BAR;
#undef PG8_SA
#undef PG8_SB
#undef PG8_STAGE
#undef PG8_LDA
#undef PG8_LDB
#undef PG8_MMA
#undef PG8_WAIT_V
#undef PG8_WAIT_L
#undef PG8_BAR
#undef PG8_SCHED
}
struct PlainBase {
    const char* A; const char* Bt; unsigned lda, ldb; int K; StaticOrder so;
    __device__ __forceinline__ bool next(int i, Unit& u) const { return so.next(i, u); }
    __device__ __forceinline__ const char* a_base(const Unit& u) const { return A + (size_t)u.pm * BM * lda; }
    __device__ __forceinline__ const char* b_base(const Unit& u) const { return Bt + (size_t)u.pn * BM * ldb; }
    __device__ __forceinline__ void a_rows(const Unit&, int, unsigned (&)[2][2]) const {}
};
__device__ __forceinline__ float head_l2g(int h) { return __builtin_log2f(1.0f - __builtin_amdgcn_exp2f(-5.0f - (float)h)); }

struct P_QKV0 : PlainBase {
    static constexpr bool PERM = true, GATHER = false, HALFABLE = false;
    bf16* qk; bf16* v; const float* cs; const float* sn;
    int i0, i1;
    __device__ __forceinline__ bool next(int i, Unit& u) const { return (i + i0 < i1) && so.next(i + i0, u); }
    __device__ __forceinline__ void epi(const f32x4 (&acc)[2][2][4][2], const Unit& u, int wr, int wc, int fr, int fq) const {
        const int row0 = u.pm * BM + wr * 64 + fr, pn = u.pn;
        if (pn < 8) {
            const int hh = pn & 3; const bool isk = pn >= 4; bf16* dst = qk + (size_t)(pn >> 2) * ((size_t)T * 1024);
            const float l2g = isk ? -head_l2g(hh) : head_l2g(hh);
            float invr[2][4];
#pragma unroll
            for (int bj = 0; bj < 2; ++bj)
#pragma unroll
                for (int p = 0; p < 4; ++p) invr[bj][p] = __builtin_amdgcn_exp2f((float)(bj * 64 + wc * 16 + 4 * fq + p) * (-13.287712379549449f / 127.0f)) * 0.15915494309189535f;
#pragma unroll
            for (int ai = 0; ai < 2; ++ai)
#pragma unroll
                for (int m = 0; m < 4; ++m) { const int row = row0 + ai * HALF + m * 16, pos = row & (SEQ - 1);
                    const float sc = __builtin_amdgcn_exp2f(l2g * (float)(pos & 63)), fp = (float)pos;
#pragma unroll
                    for (int bj = 0; bj < 2; ++bj) { const int c0 = bj * HALF + wc * 32 + 8 * fq;
                        float cv[4], sv[4];
#pragma unroll
                        for (int p = 0; p < 4; ++p) { const float rev = fp * invr[bj][p], fr_ = rev - __builtin_floorf(rev); cv[p] = __builtin_amdgcn_cosf(fr_) * sc; sv[p] = __builtin_amdgcn_sinf(fr_) * sc; }
                        const f32x4 v0 = acc[ai][bj][m][0], v1 = acc[ai][bj][m][1];
                        u32x4 w;
                        w.x = cvt_pk_bf16(v0[0] * cv[0] - v0[1] * sv[0], v0[0] * sv[0] + v0[1] * cv[0]);
                        w.y = cvt_pk_bf16(v0[2] * cv[1] - v0[3] * sv[1], v0[2] * sv[1] + v0[3] * cv[1]);
                        w.z = cvt_pk_bf16(v1[0] * cv[2] - v1[1] * sv[2], v1[0] * sv[2] + v1[1] * cv[2]);
                        w.w = cvt_pk_bf16(v1[2] * cv[3] - v1[3] * sv[3], v1[2] * sv[3] + v1[3] * cv[3]);
                        *(u32x4*)(dst + (size_t)row * 1024 + hh * 256 + c0) = w; } }
        } else {
#pragma unroll
            for (int ai = 0; ai < 2; ++ai)
#pragma unroll
                for (int m = 0; m < 4; ++m) { const int row = row0 + ai * HALF + m * 16;
#pragma unroll
                    for (int bj = 0; bj < 2; ++bj) { const int c0 = bj * HALF + wc * 32 + 8 * fq;
                        const f32x4 v0 = acc[ai][bj][m][0], v1 = acc[ai][bj][m][1];
                        u32x4 w; w.x = cvt_pk_bf16(v0[0], v0[1]); w.y = cvt_pk_bf16(v0[2], v0[3]); w.z = cvt_pk_bf16(v1[0], v1[1]); w.w = cvt_pk_bf16(v1[2], v1[3]);
                        *(u32x4*)(v + (size_t)row * 2048 + (pn - 8) * 256 + c0) = w; } }
        }
    }
};
struct P_GATE : PlainBase {
    static constexpr bool PERM = true, GATHER = false, HALFABLE = false;
    bf16* ov; const float* ssq;
    __device__ __forceinline__ void epi(const f32x4 (&acc)[2][2][4][2], const Unit& u, int wr, int wc, int fr, int fq) const {
        const int row0 = u.pm * BM + wr * 64 + fr, head = u.pn >> 1;
#pragma unroll
        for (int ai = 0; ai < 2; ++ai) {
            f32x4 s0[4], s1[4]; u32x4 ov4[4][2];
#pragma unroll
            for (int m = 0; m < 4; ++m) { const int row = row0 + ai * HALF + m * 16;
                s0[m] = *(const f32x4*)(ssq + ((size_t)row * 4 + head) * 8); s1[m] = *(const f32x4*)(ssq + ((size_t)row * 4 + head) * 8 + 4);
#pragma unroll
                for (int bj = 0; bj < 2; ++bj) ov4[m][bj] = *(const u32x4*)(ov + (size_t)row * 2048 + u.pn * BM + bj * HALF + wc * 32 + 8 * fq); }
#pragma unroll
            for (int m = 0; m < 4; ++m) { const int row = row0 + ai * HALF + m * 16;
                const float rs = __builtin_amdgcn_rsqf((((s0[m][0] + s0[m][1]) + (s0[m][2] + s0[m][3])) + ((s1[m][0] + s1[m][1]) + (s1[m][2] + s1[m][3]))) * (1.0f / 512.0f) + 1e-6f);
#pragma unroll
                for (int bj = 0; bj < 2; ++bj) { const u32x4 o = ov4[m][bj];
                    const f32x4 v0 = acc[ai][bj][m][0], v1 = acc[ai][bj][m][1];
                    u32x4 w;
                    w.x = cvt_pk_bf16(silu_f(v0[0]) * bf_lo(o.x) * rs, silu_f(v0[1]) * bf_hi(o.x) * rs);
                    w.y = cvt_pk_bf16(silu_f(v0[2]) * bf_lo(o.y) * rs, silu_f(v0[3]) * bf_hi(o.y) * rs);
                    w.z = cvt_pk_bf16(silu_f(v1[0]) * bf_lo(o.z) * rs, silu_f(v1[1]) * bf_hi(o.z) * rs);
                    w.w = cvt_pk_bf16(silu_f(v1[2]) * bf_lo(o.w) * rs, silu_f(v1[3]) * bf_hi(o.w) * rs);
                    *(u32x4*)(ov + (size_t)row * 2048 + u.pn * BM + bj * HALF + wc * 32 + 8 * fq) = w; } }
        }
    }
};
struct P_RESB : PlainBase {
    static constexpr bool PERM = true, GATHER = false, HALFABLE = false;
    const float* res32; bf16* hb; int row_off;
    __device__ __forceinline__ void epi(const f32x4 (&acc)[2][2][4][2], const Unit& u, int wr, int wc, int fr, int fq) const {
        const int row0 = row_off + u.pm * BM + wr * 64 + fr;
#pragma unroll
        for (int ai = 0; ai < 2; ++ai) {
            f32x4 r[4][2][2];
#pragma unroll
            for (int m = 0; m < 4; ++m) { const size_t off = (size_t)(row0 + ai * HALF + m * 16) * D + u.pn * BM + wc * 32 + 8 * fq;
#pragma unroll
                for (int bj = 0; bj < 2; ++bj) {
                    if (res32) { r[m][bj][0] = *(const f32x4*)(res32 + off + bj * HALF); r[m][bj][1] = *(const f32x4*)(res32 + off + bj * HALF + 4); }
                    else { const u32x4 o = *(const u32x4*)(hb + off + bj * HALF); r[m][bj][0] = (f32x4){bf_lo(o.x), bf_hi(o.x), bf_lo(o.y), bf_hi(o.y)}; r[m][bj][1] = (f32x4){bf_lo(o.z), bf_hi(o.z), bf_lo(o.w), bf_hi(o.w)}; } } }
#pragma unroll
            for (int m = 0; m < 4; ++m) { const size_t off = (size_t)(row0 + ai * HALF + m * 16) * D + u.pn * BM + wc * 32 + 8 * fq;
#pragma unroll
                for (int bj = 0; bj < 2; ++bj) { const f32x4 r0 = r[m][bj][0] + acc[ai][bj][m][0], r1 = r[m][bj][1] + acc[ai][bj][m][1];
                    u32x4 w; w.x = cvt_pk_bf16(r0[0], r0[1]); w.y = cvt_pk_bf16(r0[2], r0[3]); w.z = cvt_pk_bf16(r1[0], r1[1]); w.w = cvt_pk_bf16(r1[2], r1[3]);
                    *(u32x4*)(hb + off + bj * HALF) = w; } }
        }
    }
};
struct P_QKV1 : PlainBase {
    static constexpr bool PERM = true, GATHER = false, HALFABLE = false;
    bf16* qkv; const float* gains; const float* rs1;
    __device__ __forceinline__ void epi(const f32x4 (&acc)[2][2][4][2], const Unit& u, int wr, int wc, int fr, int fq) const {
        const int row0 = u.pm * BM + wr * 64 + fr, part = u.pn / 12, pp = u.pn % 12, g = pp >> 2, head = (pp & 3) * 4 + wc;
        const int Rg = g == 0 ? 1 : (g == 1 ? 4 : 16), shR = g == 0 ? 0 : (g == 1 ? 2 : 4);
        bf16* dst = qkv + (size_t)part * ((size_t)TC * 3072) + (size_t)(g * 16 + head) * (SEQ * 64) + 8 * fq;
        const float* gp = gains + (part & 1) * 192 + g * 64 + 8 * fq;
        const float qs = part == 0 ? 0.125f * 1.4426950408889634f : 1.0f;
        float rsr[2][4];
#pragma unroll
        for (int ai = 0; ai < 2; ++ai)
#pragma unroll
            for (int m = 0; m < 4; ++m) rsr[ai][m] = rs1[row0 + ai * HALF + m * 16];
        f32x4 gv[2][2];
#pragma unroll
        for (int bj = 0; bj < 2; ++bj) { gv[bj][0] = *(const f32x4*)(gp + 32 * bj); gv[bj][1] = *(const f32x4*)(gp + 32 * bj + 4); }
#pragma unroll
        for (int ai = 0; ai < 2; ++ai)
#pragma unroll
            for (int m = 0; m < 4; ++m) { const int row = row0 + ai * HALF + m * 16;
                float rs = rsr[ai][m];
                if (part < 2) {
                    float ss = 0.f;
#pragma unroll
                    for (int bj = 0; bj < 2; ++bj)
#pragma unroll
                        for (int n = 0; n < 2; ++n) { const f32x4 t = acc[ai][bj][m][n]; ss += (t[0] * t[0] + t[1] * t[1]) + (t[2] * t[2] + t[3] * t[3]); }
                    ss = xsum32(xsum16(ss));
                    rs = rs * __builtin_amdgcn_rsqf(ss * rs * rs * (1.0f / 64.0f) + 1e-6f) * qs;
                }
#pragma unroll
                for (int bj = 0; bj < 2; ++bj) { f32x4 v0 = acc[ai][bj][m][0], v1 = acc[ai][bj][m][1];
                    if (part < 2) { v0 = v0 * gv[bj][0] * rs; v1 = v1 * gv[bj][1] * rs; } else { v0 = v0 * rs; v1 = v1 * rs; }
                    u32x4 w; w.x = cvt_pk_bf16(v0[0], v0[1]); w.y = cvt_pk_bf16(v0[2], v0[3]); w.z = cvt_pk_bf16(v1[0], v1[1]); w.w = cvt_pk_bf16(v1[2], v1[3]);
                    { const int bl = row >> 11, t = row & (SEQ - 1), pos = (t & (Rg - 1)) * (SEQ >> shR) + (t >> shR); *(u32x4*)(dst + ((size_t)bl * 48 * SEQ + pos) * 64 + 32 * bj) = w; } } }
    }
};
__device__ __forceinline__ void moe_build_tab(LAS int* tab, const unsigned* cnt_g, const int tid) {
    if (tid < 64) tab[tid] = (int)__hip_atomic_load(cnt_g + tid * 64, __ATOMIC_RELAXED, __HIP_MEMORY_SCOPE_AGENT);
    __syncthreads();
    if (tid < 64) { int pre = 0, fpre = 0, hpre = 0, ftot = 0, tot = 0;
        for (int b = 0; b < 64; ++b) { const int c = tab[b], nt = (c + 255) >> 8, hf = (nt > 0 && c - 256 * (nt - 1) <= 128) ? 1 : 0, fl = nt - hf;
            if (b < tid) { pre += nt; fpre += fl; hpre += hf; } ftot += fl; tot += nt; }
        const int c = tab[tid], nt = (c + 255) >> 8, hf = (nt > 0 && c - 256 * (nt - 1) <= 128) ? 1 : 0;
        tab[64 + tid] = pre; if (tid == 0) tab[128] = tot;
        for (int t = 0; t < nt - hf; ++t) tab[160 + fpre + t] = tid | (t << 8);
        if (hf) tab[160 + ftot + hpre] = tid | 64 | ((nt - 1) << 8); }
    __syncthreads();
}
__device__ __forceinline__ int moe_sched(const LAS int* tab, int pos) { return __builtin_amdgcn_readfirstlane(tab[160 + pos]); }
struct P_GU {
    static constexpr bool PERM = true, GATHER = true, HALFABLE = true;
      const char* xn; const char* W; const int* list; bf16* hid; const LAS int* tab; int G, vcu; int K; unsigned lda, ldb;
    __device__ __forceinline__ bool next(int i, Unit& u) const {
        const int L = i * G + vcu; if (L >= tab[128] * 4) return false;
        const int e = moe_sched(tab, L >> 2), b = e & 63;
        u.pm = e >> 8; u.pn = L & 3; u.a0 = e & 127; u.a1 = tab[64 + b] + (e >> 8); return true;
    }
    __device__ __forceinline__ const char* a_base(const Unit&) const { return xn; }
    __device__ __forceinline__ const char* b_base(const Unit& u) const { return W + ((size_t)(u.a0 & 31) * 1024 + (size_t)u.pn * BM) * 2048; }
    __device__ __forceinline__ void a_rows(const Unit& u, int tid, unsigned (&off)[2][2]) const {
        const int n = tab[u.a0 & 63]; const int* lp = list + (size_t)(u.a0 & 63) * T + u.pm * BM;
#pragma unroll
        for (int i = 0; i < 2; ++i) { int R, C; stage_rc(tid * 16 + i * 8192, R, C);
#pragma unroll
            for (int h = 0; h < 2; ++h) { const int r = h * HALF + R; const int tok = (u.pm * BM + r < n) ? lp[r] : 0; off[h][i] = (unsigned)tok * 2048u + (unsigned)C * 2u; } }
    }
    __device__ __forceinline__ void epi(const f32x4 (&acc)[2][2][4][2], const Unit& u, int wr, int wc, int fr, int fq) const {
        const size_t hrow0 = (size_t)u.a1 * BM + wr * 64 + fr; const int n = tab[u.a0 & 63]; const int* lp = list + (size_t)(u.a0 & 63) * T + u.pm * BM;
        float rsr[2][4];
#pragma unroll
        for (int ai = 0; ai < 2; ++ai)
#pragma unroll
            for (int m = 0; m < 4; ++m) { const int r = ai * HALF + wr * 64 + m * 16 + fr; rsr[ai][m] = (u.pm * BM + r < n) ? *(const float*)((const char*)(lp + r) - (WS_LIST - WS_ML)) : 0.0f; }
#pragma unroll
        for (int ai = 0; ai < 2; ++ai)
#pragma unroll
            for (int m = 0; m < 4; ++m) { const float rs = rsr[ai][m];
                { const int f0 = u.pn * HALF + wc * 32 + 8 * fq;
                    const f32x4 g0 = acc[ai][0][m][0] * rs, g1 = acc[ai][0][m][1] * rs, u0 = acc[ai][1][m][0] * rs, u1 = acc[ai][1][m][1] * rs;
                    u32x4 w; w.x = cvt_pk_bf16(silu_f(g0[0]) * u0[0], silu_f(g0[1]) * u0[1]); w.y = cvt_pk_bf16(silu_f(g0[2]) * u0[2], silu_f(g0[3]) * u0[3]);
                    w.z = cvt_pk_bf16(silu_f(g1[0]) * u1[0], silu_f(g1[1]) * u1[1]); w.w = cvt_pk_bf16(silu_f(g1[2]) * u1[2], silu_f(g1[3]) * u1[3]);
                    *(u32x4*)(hid + (hrow0 + ai * HALF + m * 16) * FF + f0) = w; } }
    }
};
struct P_DN {
    static constexpr bool PERM = true, GATHER = false, HALFABLE = true;
    const char* hid; const char* W; bf16* y; const LAS int* tab; int G, vcu; int K; unsigned lda, ldb;
    __device__ __forceinline__ bool next(int i, Unit& u) const {
        const int L = i * G + vcu; if (L >= tab[128] * 4) return false;
        const int e = moe_sched(tab, L >> 2), b = e & 63;
        u.pm = e >> 8; u.pn = L & 3; u.a0 = e & 127; u.a1 = tab[64 + b] + (e >> 8); return true;
    }
    __device__ __forceinline__ const char* a_base(const Unit& u) const { return hid + (size_t)u.a1 * BM * 1024; }
    __device__ __forceinline__ const char* b_base(const Unit& u) const { return W + ((size_t)(u.a0 & 31) * 1024 + (size_t)u.pn * BM) * 1024; }
    __device__ __forceinline__ void a_rows(const Unit&, int, unsigned (&)[2][2]) const {}
    __device__ __forceinline__ void epi(const f32x4 (&acc)[2][2][4][2], const Unit& u, int wr, int wc, int fr, int fq) const {
        bf16* yp = y + ((size_t)u.a1 * BM + wr * 64 + fr) * D + u.pn * BM + wc * 32 + 8 * fq;
#pragma unroll
        for (int ai = 0; ai < 2; ++ai)
#pragma unroll
            for (int m = 0; m < 4; ++m)
#pragma unroll
                for (int bj = 0; bj < 2; ++bj) { const f32x4 v0 = acc[ai][bj][m][0], v1 = acc[ai][bj][m][1];
                    u32x4 w; w.x = cvt_pk_bf16(v0[0], v0[1]); w.y = cvt_pk_bf16(v0[2], v0[3]); w.z = cvt_pk_bf16(v1[0], v1[1]); w.w = cvt_pk_bf16(v1[2], v1[3]);
                    *(u32x4*)(yp + (size_t)(ai * HALF + m * 16) * D + bj * HALF) = w; }
    }
};
__device__ __forceinline__ void combine_phase(bf16* hb, const bf16* y, const unsigned* binpos, const float* gatew, const LAS int* tab, float* out32, float* rs_out, int gw, int ngw, int lane) {
    for (int tk = gw; tk < T; tk += ngw) {
        const unsigned bp0 = binpos[tk * 2], bp1 = binpos[tk * 2 + 1]; const float g0 = gatew[tk * 2], g1 = gatew[tk * 2 + 1];
        const size_t r0 = (size_t)tab[64 + (bp0 >> 16)] * BM + (bp0 & 0xffffu), r1 = (size_t)tab[64 + (bp1 >> 16)] * BM + (bp1 & 0xffffu);
        GAS u32x4* hp = (GAS u32x4*)(hb + (size_t)tk * D) + lane;
        const GAS u32x4* y0 = (const GAS u32x4*)(y + r0 * D) + lane; const GAS u32x4* y1 = (const GAS u32x4*)(y + r1 * D) + lane;
        u32x4 hh[2], a[2], b[2];
#pragma unroll
        for (int j = 0; j < 2; ++j) { hh[j] = hp[64 * j]; a[j] = y0[64 * j]; b[j] = y1[64 * j]; }
        float v[2][8]; float s = 0.f;
#pragma unroll
        for (int j = 0; j < 2; ++j) {
            v[j][0] = bf_lo(hh[j].x) + g0 * bf_lo(a[j].x) + g1 * bf_lo(b[j].x); v[j][1] = bf_hi(hh[j].x) + g0 * bf_hi(a[j].x) + g1 * bf_hi(b[j].x);
            v[j][2] = bf_lo(hh[j].y) + g0 * bf_lo(a[j].y) + g1 * bf_lo(b[j].y); v[j][3] = bf_hi(hh[j].y) + g0 * bf_hi(a[j].y) + g1 * bf_hi(b[j].y);
            v[j][4] = bf_lo(hh[j].z) + g0 * bf_lo(a[j].z) + g1 * bf_lo(b[j].z); v[j][5] = bf_hi(hh[j].z) + g0 * bf_hi(a[j].z) + g1 * bf_hi(b[j].z);
            v[j][6] = bf_lo(hh[j].w) + g0 * bf_lo(a[j].w) + g1 * bf_lo(b[j].w); v[j][7] = bf_hi(hh[j].w) + g0 * bf_hi(a[j].w) + g1 * bf_hi(b[j].w);
#pragma unroll
            for (int e = 0; e < 8; ++e) s += v[j][e] * v[j][e]; }
        if (out32) { GAS f32x4* op = (GAS f32x4*)(out32 + (size_t)tk * D) + 2 * lane;
#pragma unroll
            for (int j = 0; j < 2; ++j) { op[128 * j] = (f32x4){v[j][0], v[j][1], v[j][2], v[j][3]}; op[128 * j + 1] = (f32x4){v[j][4], v[j][5], v[j][6], v[j][7]}; } }
        else {
#pragma unroll
            for (int j = 0; j < 2; ++j) { u32x4 w; w.x = cvt_pk_bf16(v[j][0], v[j][1]); w.y = cvt_pk_bf16(v[j][2], v[j][3]); w.z = cvt_pk_bf16(v[j][4], v[j][5]); w.w = cvt_pk_bf16(v[j][6], v[j][7]); hp[64 * j] = w; }
            const float rs = __builtin_amdgcn_rsqf(wave_sum(s) * (1.f / D) + 1e-6f); if (lane == 0) rs_out[tk] = rs; }
    }
}

struct MapId { int off; __device__ __forceinline__ int row(int n) const { return n + off; } __device__ __forceinline__ float scale(int) const { return 1.0f; } };
struct MapWin { __device__ __forceinline__ int row(int n) const { if (n >= 2048) return n; const int d = n & 255; return (n & ~255) + ((d < 128) ? 2 * d : 2 * (d - 128) + 1); }
                __device__ __forceinline__ float scale(int n) const { return (n >= 1024 && n < 2048) ? 0.0625f : 1.0f; } };
struct MapQkv1 { int base; __device__ __forceinline__ int row(int n) const { const int two = n / 3072, n1 = n % 3072, g = n1 >> 10, h = (n1 >> 6) & 15, d = n1 & 63;
                     return base + two * 3072 + (g * 4 + (h >> 2)) * 256 + 32 * (h & 3) + (d & 31) + 128 * (d >> 5); }
                 __device__ __forceinline__ float scale(int) const { return 1.0f; } };
struct MapGu { int up; __device__ __forceinline__ int row(int f) const { return (f >> 7) * 256 + (f & 127) + 128 * up; }     __device__ __forceinline__ float scale(int) const { return 1.0f; } };
__device__ __forceinline__ void transpose_load(const float* W, int N, int item, int lane, f32x4 (&v)[16]) {
    const int nblk = N / 64, kb = item / nblk, nb = item % nblk, k0 = 64 * kb, n0 = 64 * nb;
#pragma unroll
    for (int i = 0; i < 16; ++i) v[i] = __builtin_nontemporal_load((const GAS f32x4*)(W + (size_t)(k0 + 4 * i + (lane >> 4)) * N + n0 + 4 * (lane & 15)));
}
template <class Map>
__device__ __forceinline__ void transpose_finish(const f32x4 (&v)[16], int N, bf16* WT, int ldt, LAS float* scr, int item, int lane, const float* gain, const Map mp) {
    const int nblk = N / 64, kb = item / nblk, nb = item % nblk, k0 = 64 * kb, n0 = 64 * nb;
#pragma unroll
    for (int i = 0; i < 16; ++i) { const int kk = 4 * i + (lane >> 4); const float gg = gain ? gain[k0 + kk] : 1.0f; LAS float* d = scr + kk * 65 + 4 * (lane & 15);
        d[0] = v[i][0] * gg; d[1] = v[i][1] * gg; d[2] = v[i][2] * gg; d[3] = v[i][3] * gg; }
    LDS_WAIT(); asm volatile("" ::: "memory");
    const int c = lane & 7;
#pragma unroll
    for (int j = 0; j < 8; ++j) { const int n = (lane >> 3) + 8 * j; const LAS float* s = scr + (8 * c) * 65 + n; const float sc = mp.scale(n0 + n);
        u32x4 o; o.x = pk2(s[0 * 65] * sc, s[1 * 65] * sc); o.y = pk2(s[2 * 65] * sc, s[3 * 65] * sc); o.z = pk2(s[4 * 65] * sc, s[5 * 65] * sc); o.w = pk2(s[6 * 65] * sc, s[7 * 65] * sc);
        __builtin_nontemporal_store(o, (GAS u32x4*)(WT + (size_t)mp.row(n0 + n) * ldt + k0 + 8 * c)); }
    LDS_WAIT(); asm volatile("" ::: "memory");
}
template <class Map>
__device__ __forceinline__ void transpose_item(const float* W, int N, bf16* WT, int ldt, LAS float* scr, int item, int lane, const float* gain, const Map mp) {
    f32x4 v[16]; transpose_load(W, N, item, lane, v); transpose_finish(v, N, WT, ldt, scr, item, lane, gain, mp);
}
template <class Map>
__device__ __forceinline__ void transpose_matrix(const float* W, int K, int N, bf16* WT, LAS float* scr, int gw, int ngw, int lane, const float* gain, const Map mp) {
    const int nitems = (K / 64) * (N / 64);
    if (gw >= nitems) return;
    f32x4 v[16]; transpose_load(W, N, gw, lane, v);
    for (int it = gw; it < nitems; it += ngw) { f32x4 cur[16];
#pragma unroll
        for (int i = 0; i < 16; ++i) cur[i] = v[i];
        if (it + ngw < nitems) transpose_load(W, N, it + ngw, lane, v);
        transpose_finish(cur, N, WT, K, scr, it, lane, gain, mp); }
}
__device__ __forceinline__ void rms_row_to_bf16(const float* xrow, bf16* orow, int lane) {
    const GAS f32x4* xr = (const GAS f32x4*)xrow + lane;
    f32x4 v[4]; float s = 0.f;
#pragma unroll
    for (int j = 0; j < 4; ++j) { v[j] = xr[64 * j]; s += (v[j].x * v[j].x + v[j].y * v[j].y) + (v[j].z * v[j].z + v[j].w * v[j].w); }
    const float rs = __builtin_amdgcn_rsqf(wave_sum(s) * (1.f / D) + 1e-6f);
    GAS unsigned long long* o8 = (GAS unsigned long long*)orow + lane;
#pragma unroll
    for (int j = 0; j < 4; ++j) o8[64 * j] = (unsigned long long)pk2(v[j].x * rs, v[j].y * rs) | ((unsigned long long)pk2(v[j].z * rs, v[j].w * rs) << 32);
}
__device__ __forceinline__ unsigned swz(int row, int bytecol, int stride) { return (unsigned)(row * stride + ((((bytecol >> 4) ^ (row & 7)) << 4) | (bytecol & 15))); }
__device__ __forceinline__ unsigned swzb(int row, int bytecol, int stride) { return (unsigned)(row * stride + ((((bytecol >> 4) ^ (((row & 3) << 1) | (row & 8))) << 4) | (bytecol & 15))); }
__device__ __forceinline__ bf16x8 fragb_row(const LAS unsigned char* img, int row0, int bytecol0, int stride, int fr, int fq) {
    return *(const LAS bf16x8*)(img + swzb(row0 + fr, bytecol0 + 16 * fq, stride));
}
__device__ __forceinline__ bf16x8 fragb_tr(const LAS unsigned char* img, int k0, int c0, int stride, int lane) {
    const int fq = lane >> 4, q = (lane & 15) >> 2, p = lane & 3;
    const s16x4 lo = __builtin_amdgcn_ds_read_tr16_b64_v4i16((LAS s16x4*)(img + swzb(k0 + 8 * fq + q, (c0 + 4 * p) * 2, stride)));
    const s16x4 hi = __builtin_amdgcn_ds_read_tr16_b64_v4i16((LAS s16x4*)(img + swzb(k0 + 8 * fq + 4 + q, (c0 + 4 * p) * 2, stride)));
    return (bf16x8){lo[0], lo[1], lo[2], lo[3], hi[0], hi[1], hi[2], hi[3]};
}
__device__ __forceinline__ bf16x8 frag_row(const LAS unsigned char* img, int row0, int bytecol0, int stride, int fr, int fq) {
    return *(const LAS bf16x8*)(img + swz(row0 + fr, bytecol0 + 16 * fq, stride));
}
__device__ __forceinline__ bf16x8 frag_tr2(const LAS unsigned char* img, int rowa, int rowb, int c0, int stride, int lane) {
    const int fq = lane >> 4, q = (lane & 15) >> 2, p = lane & 3;
    const s16x4 lo = __builtin_amdgcn_ds_read_tr16_b64_v4i16((LAS s16x4*)(img + swz(rowa + 4 * fq + q, (c0 + 4 * p) * 2, stride)));
    const s16x4 hi = __builtin_amdgcn_ds_read_tr16_b64_v4i16((LAS s16x4*)(img + swz(rowb + 4 * fq + q, (c0 + 4 * p) * 2, stride)));
    return (bf16x8){lo[0], lo[1], lo[2], lo[3], hi[0], hi[1], hi[2], hi[3]};
}
__device__ __forceinline__ bf16x8 frag_tr(const LAS unsigned char* img, int k0, int c0, int stride, int lane) {
    const int fq = lane >> 4; return frag_tr2(img, k0 + 4 * fq, k0 + 4 * fq + 4, c0, stride, lane);
}
#define MFMA16(a, b, c) __builtin_amdgcn_mfma_f32_16x16x32_bf16((a), (b), (c), 0, 0, 0)

__device__ __forceinline__ int xt4(int row) { return (0x1230 >> (((row >> 2) & 3) * 4)) & 3; }
__device__ __forceinline__ unsigned pnl(int row, int col, int PS) { return (unsigned)((col >> 5) * PS + row * 64 + (((((col & 31) >> 3)) ^ xt4(row)) << 4) + (col & 7) * 2); }
#define TRREAD(p) __builtin_amdgcn_ds_read_tr16_b64_v4i16((LAS s16x4*)(p))
__device__ __forceinline__ bf16x8 mk8(s16x4 lo, s16x4 hi) { return (bf16x8){lo[0], lo[1], lo[2], lo[3], hi[0], hi[1], hi[2], hi[3]}; }

__device__ __forceinline__ void retention_phase(LAS unsigned char* lds, const bf16* qg, const bf16* kg, bf16* vg, float* ssq, int G, int bx, const int tid, const bool dry = false) {
    const int lane = tid & 63, w = __builtin_amdgcn_readfirstlane(tid >> 6), fr = lane & 15, fq = lane >> 4, q4 = (lane & 15) >> 2, p4 = lane & 3;
    const int tq = w & 3, hv = w >> 2;
    LAS unsigned char* QI = lds; LAS unsigned char* KI = lds + 32768; LAS unsigned char* VI = lds + 65536; LAS unsigned char* PI = lds + 81920; LAS unsigned char* ZI = lds + 90112;
    const unsigned LBr = (unsigned)(fr * 64 + ((fq ^ xt4(fr)) << 4));
    const unsigned TB1 = (unsigned)((8 * fq + q4) * 64 + (((p4 >> 1) ^ xt4(8 * fq + q4)) << 4) + 8 * (p4 & 1));
    const unsigned TB2 = (unsigned)((8 * fq + 4 + q4) * 64 + (((p4 >> 1) ^ xt4(8 * fq + 4 + q4)) << 4) + 8 * (p4 & 1));
    const unsigned LBz = (unsigned)(fr * 64 + (((2 * (w & 1) + (fq >> 1)) ^ xt4(fr)) << 4) + 8 * (fq & 1) + (w >> 1) * 16384);
    const unsigned LBp = (unsigned)(fr * 64 + (((fq >> 1) ^ xt4(fr)) << 4) + 8 * (fq & 1) + hv * 4096 + tq * 1024);
    const unsigned TW1 = TB1 ^ ((w & 1) * 32), TW2 = TB2 ^ ((w & 1) * 32);
    for (int u = bx; u < 256; u += G) {
        const int b = u >> 4, h = (u >> 2) & 3, vs = u & 3;
        const float g64 = __builtin_amdgcn_exp2f(64.0f * head_l2g(h));
        f32x4 Z[16];
#pragma unroll
        for (int i = 0; i < 16; ++i) Z[i] = (f32x4){0.f, 0.f, 0.f, 0.f};
        u32x4 pq[4], pk[4], pv[2];
        const bf16* qh = qg + (size_t)b * SEQ * 1024 + h * 256; const bf16* kh = kg + (size_t)b * SEQ * 1024 + h * 256;
        bf16* vh = vg + (size_t)b * SEQ * 2048 + h * 512 + vs * 128;
#define RET_LOAD(sc) do { _Pragma("unroll") for (int i = 0; i < 4; ++i) { const int pid = tid + 512 * i, r = pid >> 5, c = pid & 31; \
            pq[i] = *(const u32x4*)(qh + (size_t)((sc) * 64 + r) * 1024 + c * 8); pk[i] = *(const u32x4*)(kh + (size_t)((sc) * 64 + r) * 1024 + c * 8); } \
        _Pragma("unroll") for (int i = 0; i < 2; ++i) { const int pid = tid + 512 * i, r = pid >> 4, c = pid & 15; pv[i] = *(const u32x4*)(vh + (size_t)((sc) * 64 + r) * 2048 + c * 8); } } while (0)
        RET_LOAD(0);
        for (int sc = 0; sc < 32; ++sc) {
            LDS_BARRIER();
#pragma unroll
            for (int i = 0; i < 4; ++i) { const int pid = tid + 512 * i, r = pid >> 5, c = pid & 31; const unsigned o = pnl(r, 8 * c, 4096); *(LAS u32x4*)(QI + o) = pq[i]; *(LAS u32x4*)(KI + o) = pk[i]; }
#pragma unroll
            for (int i = 0; i < 2; ++i) { const int pid = tid + 512 * i, r = pid >> 4, c = pid & 15; *(LAS u32x4*)(VI + pnl(r, 8 * c, 4096)) = pv[i]; }
#pragma unroll
            for (int dt = 0; dt < 16; ++dt) { u32x2 zz; zz.x = cvt_pk_bf16(Z[dt][0], Z[dt][1]); zz.y = cvt_pk_bf16(Z[dt][2], Z[dt][3]); *(LAS u32x2*)(ZI + LBz + dt * 1024) = zz; }
#ifndef RET_EXP
#define RET_EXP 0
#endif
            if (sc + 1 < 32 && !(RET_EXP & 16)) RET_LOAD(sc + 1);
            LDS_BARRIER();
            const LAS unsigned char* qrow = QI + LBr + tq * 1024;
#pragma unroll
            for (int mi = 0; mi < 2; ++mi) { const int mt = 2 * hv + mi; f32x4 s = (f32x4){0.f, 0.f, 0.f, 0.f};
                if (mt <= tq) { const LAS unsigned char* krow = KI + LBr + mt * 1024;
#pragma unroll
                    for (int ks = 0; ks < 8; ++ks) s = MFMA16(*(const LAS bf16x8*)(krow + ks * 4096), *(const LAS bf16x8*)(qrow + ks * 4096), s);
                    if (mt == tq) {
#pragma unroll
                        for (int r = 0; r < 4; ++r) if (4 * fq + r > fr) s[r] = 0.f; }
                }
                u32x2 pp; pp.x = cvt_pk_bf16(s[0], s[1]); pp.y = cvt_pk_bf16(s[2], s[3]); *(LAS u32x2*)(PI + (LBp ^ (mi * 32))) = pp; }
            bf16x8 va[2];
            if (!(RET_EXP & 1)) {
#pragma unroll
            for (int k2 = 0; k2 < 2; ++k2) va[k2] = mk8(TRREAD(VI + TW1 + (w >> 1) * 4096 + k2 * 2048), TRREAD(VI + TW2 + (w >> 1) * 4096 + k2 * 2048));
#define RET_KB(dt, k2) mk8(TRREAD(KI + (TB1 ^ (((dt) & 1) * 32)) + ((dt) >> 1) * 4096 + (k2) * 2048), TRREAD(KI + (TB2 ^ (((dt) & 1) * 32)) + ((dt) >> 1) * 4096 + (k2) * 2048))
            {
#pragma unroll
              for (int dt = 0; dt < 16; ++dt) { const bf16x8 c0 = RET_KB(dt, 0), c1 = RET_KB(dt, 1);
                  Z[dt] = Z[dt] * g64; Z[dt] = MFMA16(va[0], c0, Z[dt]); Z[dt] = MFMA16(va[1], c1, Z[dt]); }
              __builtin_amdgcn_sched_group_barrier(0x100, 8, 0);
#pragma unroll
              for (int i = 0; i < 14; ++i) { __builtin_amdgcn_sched_group_barrier(0x008, 2, 0); __builtin_amdgcn_sched_group_barrier(0x100, 4, 0); }
#pragma unroll
              for (int i = 0; i < 2; ++i) __builtin_amdgcn_sched_group_barrier(0x008, 2, 0);
            }
#undef RET_KB
            }
            f32x4 o[4];
#pragma unroll
            for (int vt = 0; vt < 4; ++vt) o[vt] = (f32x4){0.f, 0.f, 0.f, 0.f};
            if (!(RET_EXP & 2)) {
#define RET_ZA(vt, ks) mk8(TRREAD(ZI + (TB1 ^ (((vt) & 1) * 32)) + (2 * hv + ((vt) >> 1)) * 16384 + (ks) * 2048), TRREAD(ZI + (TB2 ^ (((vt) & 1) * 32)) + (2 * hv + ((vt) >> 1)) * 16384 + (ks) * 2048))
            {
#pragma unroll
              for (int ks = 0; ks < 8; ++ks) { const bf16x8 cq = *(const LAS bf16x8*)(qrow + ks * 4096);
#pragma unroll
                  for (int vt = 0; vt < 4; ++vt) o[vt] = MFMA16(RET_ZA(vt, ks), cq, o[vt]); }
              __builtin_amdgcn_sched_group_barrier(0x100, 9, 0);
#pragma unroll
              for (int i = 0; i < 7; ++i) { __builtin_amdgcn_sched_group_barrier(0x008, 4, 0); __builtin_amdgcn_sched_group_barrier(0x100, 9, 0); }
              __builtin_amdgcn_sched_group_barrier(0x008, 4, 0);
            }
#undef RET_ZA
            }
            LDS_BARRIER();
#pragma unroll
            for (int vt = 0; vt < 4; ++vt) o[vt] = o[vt] * g64;
#pragma unroll
            for (int k2 = 0; k2 < 2; ++k2) if (32 * k2 <= 16 * tq + 15) { const bf16x8 pb = *(const LAS bf16x8*)(PI + LBr + tq * 1024 + k2 * 4096);
#pragma unroll
                for (int vt = 0; vt < 4; ++vt) o[vt] = MFMA16(mk8(TRREAD(VI + (TB1 ^ ((vt & 1) * 32)) + (2 * hv + (vt >> 1)) * 4096 + k2 * 2048), TRREAD(VI + (TB2 ^ ((vt & 1) * 32)) + (2 * hv + (vt >> 1)) * 4096 + k2 * 2048)), pb, o[vt]); }
            const int tokl = sc * 64 + 16 * tq + fr; float ss = 0.f;
#pragma unroll
            for (int vt = 0; vt < 4; ++vt) ss += (o[vt][0] * o[vt][0] + o[vt][1] * o[vt][1]) + (o[vt][2] * o[vt][2] + o[vt][3] * o[vt][3]);
#pragma unroll
            for (int vp = 0; vp < 2; ++vp) {
                unsigned x0 = cvt_pk_bf16(o[2 * vp][0], o[2 * vp][1]), x1 = cvt_pk_bf16(o[2 * vp][2], o[2 * vp][3]), y0 = cvt_pk_bf16(o[2 * vp + 1][0], o[2 * vp + 1][1]), y1 = cvt_pk_bf16(o[2 * vp + 1][2], o[2 * vp + 1][3]);
                const auto s0 = __builtin_amdgcn_permlane16_swap(x0, y0, false, false), s1 = __builtin_amdgcn_permlane16_swap(x1, y1, false, false);
                u32x4 ww; ww.x = s0[0]; ww.y = s1[0]; ww.z = s0[1]; ww.w = s1[1];
                if (!dry) *(u32x4*)(vh + (size_t)tokl * 2048 + 16 * (4 * hv + 2 * vp + (fq & 1)) + 4 * (fq & ~1)) = ww; }
            ss = xsum32(xsum16(ss));
            if (fq == 0 && !dry) ssq[(((size_t)(b * SEQ + tokl) * 4 + h) * 4 + vs) * 2 + hv] = ss;
        }
#undef RET_LOAD
        LDS_BARRIER();
    }
}

__device__ __forceinline__ int t5_bucket(int n) { if (n < 16) return n; const int l = 16 + (int)(__builtin_log2f((float)n * 0.0625f) * (16.0f / 7.0f)); return l > 31 ? 31 : l; }
__device__ __forceinline__ void attn_phase(LAS unsigned char* lds, bf16* qb, const bf16* kb, const bf16* vb, f32x2* ml, const float* rel_bias, int G, int bx, const int tid, const bool dry = false) {
    const int lane = tid & 63, w = __builtin_amdgcn_readfirstlane(tid >> 6), fr = lane & 15, fq = lane >> 4, q4 = (lane & 15) >> 2, p4 = lane & 3;
    LAS unsigned char* KI = lds; LAS unsigned char* VI = lds + 32768; LAS float* BT = (LAS float*)(lds + 65536);
    const unsigned LBr = (unsigned)(fr * 64 + ((fq ^ xt4(fr)) << 4));
    const unsigned TBa = (unsigned)((4 * fq + q4) * 64 + (((p4 >> 1) ^ xt4(4 * fq + q4)) << 4) + 8 * (p4 & 1));
    const LAS float* btl = BT + (fr + 144 - 4 * fq);
    for (int unit = bx; unit < 1536; unit += G) {
        const int u4 = unit & 3, g = (unit >> 2) % 3, rest = unit / 12, h = rest & 15, bl = rest >> 4;
        const int R = g == 0 ? 1 : (g == 1 ? 4 : 16);
        LDS_BARRIER();
        if (tid < 160) { const int steps = tid - 16; BT[tid] = (steps >= 0 && steps <= 128) ? rel_bias[t5_bucket(steps * R) * 48 + g * 16 + h] * 1.4426950408889634f : -1e30f; }
        LDS_BARRIER();
        float bias[36];
#pragma unroll
        for (int j = 0; j < 9; ++j)
#pragma unroll
            for (int rr = 0; rr < 4; ++rr) bias[4 * j + rr] = btl[-16 * j - rr];
        const int s_first = (g == 0 && u4 > 0) ? -1 : 0;
        const size_t sl = ((size_t)(bl * 3 + g) * 16 + h) * (SEQ * 64);
        const bf16* kbase = kb + sl; const bf16* vbase = vb + sl; bf16* qbase = qb + sl;
        const int LR = SEQ / R;
        u32x4 pk[2], pv[2]; bf16x8 qn[2];
#define ATT_SEG(s, r, n) do { if (g == 0) { r = 0; n = 4 * u4 + (s); } else if (g == 1) { r = u4; n = (s); } else { r = 4 * u4 + (s); n = 0; } } while (0)
#define ATT_LOAD(s) do { int r_, n_; ATT_SEG(s, r_, n_); _Pragma("unroll") for (int i = 0; i < 2; ++i) { const int pid = tid + 512 * i, row = pid >> 3, c = pid & 7; \
            const size_t off = (size_t)(r_ * LR + 128 * n_ + row) * 64 + c * 8; pk[i] = *(const u32x4*)(kbase + off); pv[i] = *(const u32x4*)(vbase + off); } \
            if ((s) >= 0) { const bf16* qp_ = qbase + (size_t)(r_ * LR + 128 * n_ + 16 * w + fr) * 64 + fq * 8; qn[0] = *(const bf16x8*)qp_; qn[1] = *(const bf16x8*)(qp_ + 32); } } while (0)
        ATT_LOAD(s_first);
        int cnt = 0;
        for (int s = s_first; s < 4; ++s, ++cnt) {
            LDS_BARRIER();
            const int cs = cnt & 1, ps = cs ^ 1;
#pragma unroll
            for (int i = 0; i < 2; ++i) { const int pid = tid + 512 * i, row = pid >> 3, c = pid & 7; const unsigned o = pnl(cs * 128 + row, 8 * c, 16384); *(LAS u32x4*)(KI + o) = pk[i]; *(LAS u32x4*)(VI + o) = pv[i]; }
            bf16x8 qf[2]; qf[0] = qn[0]; qf[1] = qn[1];
            if (s < 3) ATT_LOAD(s + 1);
            LDS_BARRIER();
            if (s < 0) continue;
            int r, n; ATT_SEG(s, r, n);
            const bool has_prev = n > 0;
            const size_t grow = (size_t)bl * SEQ + (size_t)(128 * n + 16 * w + fr) * R + r;
            bf16* qptr = qbase + (size_t)(r * LR + 128 * n + 16 * w + fr) * 64;
            f32x4 sc[9]; float mx = -1e30f;
            { bf16x8 kf[9][2];
#pragma unroll
              for (int j = 0; j < 9; ++j) { const int kt = w + j; const int rb = (kt < 8) ? (has_prev ? ps * 128 + 16 * kt : cs * 128 + 16 * kt) : cs * 128 + 16 * (kt - 8);
                  const LAS unsigned char* kr = KI + LBr + rb * 64; kf[j][0] = *(const LAS bf16x8*)kr; kf[j][1] = *(const LAS bf16x8*)(kr + 16384); }
#pragma unroll
              for (int j = 0; j < 9; ++j) { f32x4 a = (f32x4){0.f, 0.f, 0.f, 0.f}; a = MFMA16(kf[j][0], qf[0], a); a = MFMA16(kf[j][1], qf[1], a); sc[j] = a; } }
#pragma unroll
            for (int j = 0; j < 9; ++j) { const bool valid = has_prev || (w + j) >= 8;
#pragma unroll
                for (int rr = 0; rr < 4; ++rr) { const float v = valid ? sc[j][rr] + bias[4 * j + rr] : -1e30f; sc[j][rr] = v; mx = fmaxf(mx, v); } }
            mx = xmax32(xmax16(mx));
            float lsum = 0.f;
#pragma unroll
            for (int j = 0; j < 9; ++j)
#pragma unroll
                for (int rr = 0; rr < 4; ++rr) { const float p = __builtin_amdgcn_exp2f(sc[j][rr] - mx); sc[j][rr] = p; lsum += p; }
            lsum = xsum32(xsum16(lsum));
            f32x4 o[4];
#pragma unroll
            for (int dt = 0; dt < 4; ++dt) o[dt] = (f32x4){0.f, 0.f, 0.f, 0.f};
#pragma unroll
            for (int jj = 0; jj < 5; ++jj) { const int t0 = 2 * jj, t1 = 2 * jj + 1;
                union { bf16x8 v; unsigned u[4]; } pb;
                pb.u[0] = cvt_pk_bf16(sc[t0][0], sc[t0][1]); pb.u[1] = cvt_pk_bf16(sc[t0][2], sc[t0][3]);
                if (t1 < 9) { pb.u[2] = cvt_pk_bf16(sc[t1 < 9 ? t1 : 8][0], sc[t1 < 9 ? t1 : 8][1]); pb.u[3] = cvt_pk_bf16(sc[t1 < 9 ? t1 : 8][2], sc[t1 < 9 ? t1 : 8][3]); } else { pb.u[2] = 0u; pb.u[3] = 0u; }
                int kt0 = w + t0, kt1 = w + t1; if (kt1 > 15) kt1 = 15;
                const bool v0 = has_prev || kt0 >= 8, v1 = has_prev || kt1 >= 8;
                const int rb0 = (kt0 < 8) ? (v0 ? ps * 128 + 16 * kt0 : cs * 128 + 16 * kt0) : cs * 128 + 16 * (kt0 - 8);
                const int rb1 = (kt1 < 8) ? (v1 ? ps * 128 + 16 * kt1 : cs * 128 + 16 * kt1) : cs * 128 + 16 * (kt1 - 8);
                const LAS unsigned char* va = VI + rb0 * 64; const LAS unsigned char* vb2 = VI + rb1 * 64;
#pragma unroll
                for (int dt = 0; dt < 4; ++dt) o[dt] = MFMA16(mk8(TRREAD(va + (TBa ^ ((dt & 1) * 32)) + (dt >> 1) * 16384), TRREAD(vb2 + (TBa ^ ((dt & 1) * 32)) + (dt >> 1) * 16384)), pb.v, o[dt]); }
            const float il = 1.0f / lsum;
#pragma unroll
            for (int dp = 0; dp < 2; ++dp) {
                unsigned x0 = cvt_pk_bf16(o[2 * dp][0] * il, o[2 * dp][1] * il), x1 = cvt_pk_bf16(o[2 * dp][2] * il, o[2 * dp][3] * il);
                unsigned y0 = cvt_pk_bf16(o[2 * dp + 1][0] * il, o[2 * dp + 1][1] * il), y1 = cvt_pk_bf16(o[2 * dp + 1][2] * il, o[2 * dp + 1][3] * il);
                const auto s0 = __builtin_amdgcn_permlane16_swap(x0, y0, false, false), s1 = __builtin_amdgcn_permlane16_swap(x1, y1, false, false);
                u32x4 ww; ww.x = s0[0]; ww.y = s1[0]; ww.z = s0[1]; ww.w = s1[1];
                if (!dry) *(u32x4*)(qptr + 16 * (2 * dp + (fq & 1)) + 4 * (fq & ~1)) = ww; }
            if (fq == 0 && !dry) ml[(grow * 3 + g) * 16 + h] = (f32x2){mx, lsum};
        }
#undef ATT_SEG
#undef ATT_LOAD
    }
    LDS_BARRIER();
}
__device__ __forceinline__ void merge_phase(const bf16* qb, const f32x2* ml, bf16* out, int G, int bx, const int tid) {
    const size_t nitems = (size_t)TC * 16 * 8;
    for (size_t it = (size_t)bx * 512 + tid; it < nitems; it += (size_t)G * 512) {
        const int pc = (int)(it & 7), h = (int)((it >> 3) & 15); const size_t tok = it >> 7; const int bl = (int)(tok >> 11), t = (int)(tok & (SEQ - 1));
        f32x2 a[3]; float M = -3e38f;
#pragma unroll
        for (int g = 0; g < 3; ++g) { a[g] = ml[(tok * 3 + g) * 16 + h]; M = fmaxf(M, a[g].x); }
        float wg[3], W = 0.f;
#pragma unroll
        for (int g = 0; g < 3; ++g) { wg[g] = __builtin_amdgcn_exp2f(a[g].x - M) * a[g].y; W += wg[g]; }
        const float iw = 1.0f / W; float acc[8];
#pragma unroll
        for (int e = 0; e < 8; ++e) acc[e] = 0.f;
#pragma unroll
        for (int g = 0; g < 3; ++g) { const int sh = g == 0 ? 0 : (g == 1 ? 2 : 4), pos = (t & ((1 << sh) - 1)) * (SEQ >> sh) + (t >> sh);
            const u32x4 o = *(const u32x4*)(qb + (((size_t)(bl * 3 + g) * 16 + h) * SEQ + pos) * 64 + pc * 8); const float ww = wg[g] * iw;
            acc[0] += ww * bf_lo(o.x); acc[1] += ww * bf_hi(o.x); acc[2] += ww * bf_lo(o.y); acc[3] += ww * bf_hi(o.y); acc[4] += ww * bf_lo(o.z); acc[5] += ww * bf_hi(o.z); acc[6] += ww * bf_lo(o.w); acc[7] += ww * bf_hi(o.w); }
        u32x4 r; r.x = cvt_pk_bf16(acc[0], acc[1]); r.y = cvt_pk_bf16(acc[2], acc[3]); r.z = cvt_pk_bf16(acc[4], acc[5]); r.w = cvt_pk_bf16(acc[6], acc[7]);
        *(u32x4*)(out + tok * 1024 + h * 64 + pc * 8) = r;
    }
}
__device__ __forceinline__ void router_phase(LAS unsigned char* lds, const bf16* wrh, const bf16* wrl, const float* bg, const float* be, const bf16* hb, int* list, float* gatew, unsigned* cnt, int G, int vcu, const int tid) {
    const int lane = tid & 63, w = __builtin_amdgcn_readfirstlane(tid >> 6), fr = lane & 15, fq = lane >> 4;
    LAS unsigned char* WH = lds; LAS unsigned char* WL = lds + 49152; LAS float* LG = (LAS float*)(lds + 98304 + w * 3072);
    const int nround = (T / 16 + G * NWAVES - 1) / (G * NWAVES);
    LAS unsigned* BC = (LAS unsigned*)(lds + 122880); LAS unsigned* BB = BC + 32;
    for (int rd = 0; rd < nround; ++rd) {
        const int mt = rd * G * NWAVES + vcu * NWAVES + w; const bool active = mt < T / 16;
        if (tid < 32) BC[tid] = 0u;
        int b0 = 0, b1 = 0; unsigned l0 = 0u, l1 = 0u; float gw0 = 0.f, gw1 = 0.f, rsk = 0.f;
        f32x4 acc[3]; float ss = 0.f;
#pragma unroll
        for (int i = 0; i < 3; ++i) acc[i] = (f32x4){0.f, 0.f, 0.f, 0.f};
        for (int kh = 0; kh < 2; ++kh) {
            LDS_BARRIER();
#pragma unroll
            for (int i = 0; i < 6; ++i) { const int pid = tid + 512 * i, row = pid >> 6, c = pid & 63;
                *(LAS u32x4*)(WH + swzb(row, c * 16, 1024)) = *(const u32x4*)(wrh + (size_t)row * 1024 + kh * 512 + c * 8);
                *(LAS u32x4*)(WL + swzb(row, c * 16, 1024)) = *(const u32x4*)(wrl + (size_t)row * 1024 + kh * 512 + c * 8); }
            LDS_BARRIER();
            if (active) {
                const bf16* hp = hb + (size_t)(mt * 16 + fr) * D + kh * 512 + 8 * fq;
                union { bf16x8 v; u32x4 u; } ah[16];
#pragma unroll
                for (int ks = 0; ks < 16; ++ks) ah[ks].u = *(const GAS u32x4*)(hp + 32 * ks);
#pragma unroll
                for (int ks = 0; ks < 16; ++ks) {
                    { const u32x4 a = ah[ks].u; const float a0 = bf_lo(a.x), a1 = bf_hi(a.x), a2 = bf_lo(a.y), a3 = bf_hi(a.y), a4 = bf_lo(a.z), a5 = bf_hi(a.z), a6 = bf_lo(a.w), a7 = bf_hi(a.w);
                      ss += ((a0 * a0 + a1 * a1) + (a2 * a2 + a3 * a3)) + ((a4 * a4 + a5 * a5) + (a6 * a6 + a7 * a7)); }
#pragma unroll
                    for (int nt = 0; nt < 3; ++nt) { const bf16x8 bh = fragb_row(WH, 16 * nt, ks * 64, 1024, fr, fq), bl = fragb_row(WL, 16 * nt, ks * 64, 1024, fr, fq);
                        acc[nt] = MFMA16(ah[ks].v, bh, acc[nt]); acc[nt] = MFMA16(ah[ks].v, bl, acc[nt]); }
                }
            }
        }
        if (active) {
            ss = xsum32(xsum16(ss));
            const float rs = __builtin_amdgcn_rsqf(ss * (1.f / D) + 1e-6f);
#pragma unroll
            for (int nt = 0; nt < 3; ++nt)
#pragma unroll
                for (int r = 0; r < 4; ++r) LG[(4 * fq + r) * 48 + 16 * nt + fr] = acc[nt][r];
            LDS_WAIT(); asm volatile("" ::: "memory");
            if (lane < 16) {
                const int tk = mt * 16 + lane; float a[36];
#pragma unroll
                for (int q = 0; q < 9; ++q) { const f32x4 t4 = *(const LAS f32x4*)(LG + lane * 48 + 4 * q); a[4 * q] = t4[0] * rs; a[4 * q + 1] = t4[1] * rs; a[4 * q + 2] = t4[2] * rs; a[4 * q + 3] = t4[3] * rs; }
                float gl[4];
#pragma unroll
                for (int g = 0; g < 4; ++g) gl[g] = a[g] + bg[g];
                int grp = 0; float gbest = gl[0];
#pragma unroll
                for (int g = 1; g < 4; ++g) if (gl[g] > gbest) { gbest = gl[g]; grp = g; }
                float den = 0.f;
#pragma unroll
                for (int g = 0; g < 4; ++g) den += __expf(gl[g] - gbest);
                const float pg = 1.0f / den;
                float el[8];
#pragma unroll
                for (int e = 0; e < 8; ++e) { float vv = 0.f;
#pragma unroll
                    for (int g = 0; g < 4; ++g) if (g == grp) vv = a[4 + g * 8 + e] + be[g * 8 + e];
                    el[e] = vv; }
                int i0 = 0; float v0 = el[0];
#pragma unroll
                for (int e = 1; e < 8; ++e) if (el[e] > v0) { v0 = el[e]; i0 = e; }
                int i1 = -1; float v1 = -3.0e38f;
#pragma unroll
                for (int e = 0; e < 8; ++e) if (e != i0 && (i1 < 0 || el[e] > v1)) { v1 = el[e]; i1 = e; }
                const float e1 = __expf(v1 - v0); const float g0 = 1.0f / (1.0f + e1), g1 = e1 / (1.0f + e1);
                b0 = grp * 8 + i0; b1 = grp * 8 + i1;
                l0 = __hip_atomic_fetch_add(BC + b0, 1u, __ATOMIC_RELAXED, __HIP_MEMORY_SCOPE_WORKGROUP);
                l1 = __hip_atomic_fetch_add(BC + b1, 1u, __ATOMIC_RELAXED, __HIP_MEMORY_SCOPE_WORKGROUP);
                gw0 = g0 * pg; gw1 = g1 * pg; rsk = rs;
            }
        }
        LDS_BARRIER();
        if (tid < 32) { const unsigned c = BC[tid]; BB[tid] = c ? __hip_atomic_fetch_add(cnt + tid * 64, c, __ATOMIC_RELAXED, __HIP_MEMORY_SCOPE_AGENT) : 0u; }
        LDS_BARRIER();
        if (active && lane < 16) {
            const int tk = mt * 16 + lane; const unsigned p0 = BB[b0] + l0, p1 = BB[b1] + l1;
            list[(size_t)b0 * T + p0] = tk; list[(size_t)b1 * T + p1] = tk;
            gatew[tk * 2] = gw0; gatew[tk * 2 + 1] = gw1;
            float* rsl = (float*)((char*)list - (WS_LIST - WS_ML)); rsl[(size_t)b0 * T + p0] = rsk; rsl[(size_t)b1 * T + p1] = rsk;
            unsigned* binpos = (unsigned*)(gatew + 2 * T); binpos[tk * 2] = ((unsigned)b0 << 16) | p0; binpos[tk * 2 + 1] = ((unsigned)b1 << 16) | p1;
        }
    }
    LDS_BARRIER();
}
struct Args { const float* in[19]; float* out; unsigned char* ws; int ph_lo, ph_hi, flags, pad; };
enum { IN_X = 0, IN_RET_WIN, IN_RET_WOUT, IN_KV_NORM, IN_W_KV, IN_K_NORM, IN_DIL_WQ, IN_Q_NORM, IN_DIL_WO, IN_REL_BIAS, IN_MIXER_NORM, IN_FFN_NORM, IN_RGRP, IN_RGRP_B, IN_REXP, IN_REXP_B, IN_EGATE, IN_EUP, IN_EDOWN };
constexpr int NPHASE = 24;
#ifndef MK_PHMASK
#define MK_PHMASK 0xffffffu
#endif
struct PhaseCtx { int tid, lane, wave, G, bx, vcu, gw, NGW; unsigned char* ws; float* hout; };
__device__ __forceinline__ PhaseCtx phase_ctx(const Args& args, int wave_s) {
    PhaseCtx c; int tid = (wave_s << 6) | lane_id(), bx = blockIdx.x, G = gridDim.x;
    GAS unsigned char* wsg = (GAS unsigned char*)args.ws; GAS float* hg = (GAS float*)args.out;
    asm volatile("" : "+v"(tid), "+s"(bx), "+s"(G), "+s"(wsg), "+s"(hg));
    unsigned char* ws = (unsigned char*)wsg; float* hout = (float*)hg;
    c.tid = tid; c.lane = tid & 63; c.wave = __builtin_amdgcn_readfirstlane(tid >> 6); c.G = G; c.bx = bx; c.vcu = (G % 8 == 0) ? (bx % 8) * (G / 8) + bx / 8 : bx;
    c.gw = c.vcu * NWAVES + c.wave; c.NGW = G * NWAVES; c.ws = ws; c.hout = hout; return c;
}
__device__ __forceinline__ void pro_s1(const Args& args, const PhaseCtx& c, LAS unsigned char* lds) {
    unsigned char* ws = c.ws; LAS float* scr = (LAS float*)(lds + c.wave * 16640); const int gw = c.gw, NGW = c.NGW, lane = c.lane;
    bf16* xn = (bf16*)(ws + WS_XN); const float* x = args.in[IN_X];
    transpose_matrix(args.in[IN_RET_WIN], 1024, 6144, (bf16*)(ws + WS_WIN), scr, gw, NGW, lane, args.in[IN_MIXER_NORM], MapWin{});
    for (int m = gw; m < T; m += NGW) rms_row_to_bf16(x + (size_t)m * D, xn + (size_t)m * D, lane);
}
__device__ __forceinline__ void pro_wout(const Args& args, const PhaseCtx& c, LAS unsigned char* lds) {
    LAS float* scr = (LAS float*)(lds + c.wave * 16640);
    transpose_matrix(args.in[IN_RET_WOUT], 2048, 1024, (bf16*)(c.ws + WS_WOUT), scr, c.gw, c.NGW, c.lane, nullptr, MapId{0});
}
__device__ __forceinline__ void pro_moe(const Args& args, const PhaseCtx& c, LAS unsigned char* lds, int L) {
    unsigned char* ws = c.ws; LAS float* scr = (LAS float*)(lds + c.wave * 16640); const int gw = c.gw, NGW = c.NGW, lane = c.lane;
    bf16* wgu = (bf16*)(ws + (L ? WS_WGU1 : WS_WGU0)); bf16* wd = (bf16*)(ws + (L ? WS_WD1 : WS_WD0));
    const float* gain = args.in[IN_FFN_NORM] + L * D;
    auto src_of = [&](int it, const float*& W, int& N, int& item) { const int e = it / 384, r = it % 384, which = r >> 7; item = r & 127; const size_t eo = (size_t)(L * NEXP + e);
        if (which == 0) { W = args.in[IN_EGATE] + eo * D * FF; N = FF; } else if (which == 1) { W = args.in[IN_EUP] + eo * D * FF; N = FF; } else { W = args.in[IN_EDOWN] + eo * FF * D; N = D; } };
    if (gw < NEXP * 384) {
        f32x4 v[16]; { const float* W; int N, item; src_of(gw, W, N, item); transpose_load(W, N, item, lane, v); }
        for (int it = gw; it < NEXP * 384; it += NGW) { f32x4 cur[16];
#pragma unroll
            for (int i = 0; i < 16; ++i) cur[i] = v[i];
            if (it + NGW < NEXP * 384) { const float* W; int N, item; src_of(it + NGW, W, N, item); transpose_load(W, N, item, lane, v); }
            const int e = it / 384, r = it % 384, which = r >> 7, item = r & 127;
            if (which == 0) transpose_finish(cur, FF, wgu + (size_t)e * 1024 * 1024, 1024, scr, item, lane, gain, MapGu{0});
            else if (which == 1) transpose_finish(cur, FF, wgu + (size_t)e * 1024 * 1024, 1024, scr, item, lane, gain, MapGu{1});
            else transpose_finish(cur, D, wd + (size_t)e * 1024 * 512, 512, scr, item, lane, (const float*)nullptr, MapId{0}); }
    }
    bf16* wrh = (bf16*)(ws + WS_WR) + (size_t)L * 48 * 1024; bf16* wrl = (bf16*)(ws + WS_WR + 196608) + (size_t)L * 48 * 1024;
    for (int i = gw * 64 + lane; i < 48 * 1024; i += NGW * 64) { const int n = i >> 10, k = i & 1023;
        const float wv = n < 36 ? gain[k] * (n < 4 ? args.in[IN_RGRP][((size_t)L * D + k) * 4 + n] : args.in[IN_REXP][((size_t)L * D + k) * 32 + (n - 4)]) : 0.0f;
        const unsigned hi = f2bf(wv); const float rem = wv - __builtin_bit_cast(float, hi << 16); wrh[i] = (bf16)hi; wrl[i] = (bf16)f2bf(rem); }
}
__device__ __forceinline__ void pro_s3(const Args& args, const PhaseCtx& c, LAS unsigned char* lds) {
    unsigned char* ws = c.ws; LAS float* scr = (LAS float*)(lds + c.wave * 16640); const int gw = c.gw, NGW = c.NGW, lane = c.lane;
    transpose_matrix(args.in[IN_DIL_WQ], 1024, 3072, (bf16*)(ws + WS_WQKV1), scr, gw, NGW, lane, args.in[IN_MIXER_NORM] + D, MapQkv1{0});
    transpose_matrix(args.in[IN_W_KV], 1024, 6144, (bf16*)(ws + WS_WQKV1), scr, gw, NGW, lane, args.in[IN_KV_NORM], MapQkv1{3072});
    transpose_matrix(args.in[IN_DIL_WO], 1024, 1024, (bf16*)(ws + WS_WO1), scr, gw, NGW, lane, nullptr, MapId{0});
    if (gw == 0) { float* gt = (float*)(ws + WS_WR + 512 * 1024); for (int i = lane; i < 192; i += 64) { gt[i] = args.in[IN_Q_NORM][i]; gt[192 + i] = args.in[IN_K_NORM][i]; } }
}

__global__ void __launch_bounds__(NWAVES * 64, 2) mk_fwd(Args args) {
    extern __shared__ __attribute__((aligned(16))) unsigned char lds_raw[];
    LAS unsigned char* lds = (LAS unsigned char*)lds_raw;
    volatile LAS unsigned* MISC = (volatile LAS unsigned*)(lds + LDS_MISC);
    LAS int* TAB = (LAS int*)(lds + LDS_MISC + 64);
    const int wave_s = __builtin_amdgcn_readfirstlane(threadIdx.x >> 6);
    if (threadIdx.x < 4) MISC[threadIdx.x] = 0u;
    __syncthreads();
    XcdBarrier bar = xcd_barrier_post((unsigned*)(args.ws + WS_CTL) + CW_BAR, MISC, threadIdx.x == 0);
    int lo = args.ph_lo, hi = args.ph_hi, flg = args.flags;
#define RELAUNDER() asm volatile("" : "+s"(lo), "+s"(hi), "+s"(flg))
#define fullpro ((flg & 1) != 0)
#ifdef MK_REPEAT
#define GEMM_RUN(p) do { if (rep_now) gemm_phase(lds, p, c.tid, (flg & 1) != 0); gemm_phase(lds, p, c.tid); } while (0)
#else
#ifndef MK_STAGGER
#define MK_STAGGER 0
#endif
#define GEMM_RUN(p) gemm_phase(lds, p, c.tid, false, MK_STAGGER)
#endif
#ifdef MK_REPEAT
#define MK_REPEAT_K MK_REPEAT
#else
#define MK_REPEAT_K (-1)
#endif
#define IN(k) ((((MK_PHMASK) >> (k)) & 1u) && lo <= (k) && (k) < hi)
#ifdef MK_STAMP
#define STAMP(i) do { if (blockIdx.x == 0 && wave_s == 0 && lane_id() == 0) ((volatile LAS unsigned long long*)(lds + LDS_MISC + 3072))[i] = __builtin_amdgcn_s_memrealtime(); } while (0)
#else
#define STAMP(i) do { } while (0)
#endif
#define SEAM(k) do { asm volatile("; SEAM_MARK %0" :: "n"(k)); if (IN(k) && IN((k) + 1)) xcd_barrier(bar, wave_s); STAMP((k) + 1); } while (0)

    STAMP(0);
    if (IN(0)) { const PhaseCtx c = phase_ctx(args, wave_s); pro_s1(args, c, lds); if (!fullpro) pro_wout(args, c, lds); }
    SEAM(0);
    if (IN(1)) {
#pragma unroll 1
        for (int part = 0; part < 2; ++part) {
            RELAUNDER();
            { const bool rep_now = (MK_REPEAT_K == 1); const PhaseCtx c = phase_ctx(args, wave_s); unsigned char* ws = c.ws;
              P_QKV0 p; p.A = (const char*)(ws + WS_XN); p.Bt = (const char*)(ws + WS_WIN); p.lda = 2048; p.ldb = 2048; p.K = 1024; p.so.init(T, 4096, c.G, c.bx);
              p.qk = (bf16*)(ws + WS_Q0); p.v = (bf16*)(ws + WS_V0); p.cs = (const float*)(ws + WS_COS); p.sn = (const float*)(ws + WS_SIN);
              const int ksp = fullpro ? ((c.bx >> 3) & 7) : 0; p.i0 = part ? ksp : 0; p.i1 = part ? (1 << 24) : ksp;
              GEMM_RUN(p); }
            if (part == 0 && fullpro) { const PhaseCtx c = phase_ctx(args, wave_s); __syncthreads();
#pragma unroll 1
                for (int Lw = 0; Lw < 2; ++Lw) pro_moe(args, c, lds, Lw);
                pro_wout(args, c, lds); pro_s3(args, c, lds); __syncthreads(); }
        }
    }
    SEAM(1);
    if (IN(2)) { const PhaseCtx c = phase_ctx(args, wave_s); unsigned char* ws = c.ws;
#if defined(MK_REPEAT) && MK_REPEAT == 2
        retention_phase(lds, (const bf16*)(ws + WS_Q0), (const bf16*)(ws + WS_K0), (bf16*)(ws + WS_V0), (float*)(ws + WS_SSQ), c.G, c.vcu, c.tid, (flg & 1) != 0);
#endif
        retention_phase(lds, (const bf16*)(ws + WS_Q0), (const bf16*)(ws + WS_K0), (bf16*)(ws + WS_V0), (float*)(ws + WS_SSQ), c.G, c.vcu, c.tid); }
    SEAM(2);
    if (IN(3)) { const bool rep_now = (MK_REPEAT_K == 3); const PhaseCtx c = phase_ctx(args, wave_s); unsigned char* ws = c.ws;
        P_GATE p; p.A = (const char*)(ws + WS_XN); p.Bt = (const char*)(ws + WS_WIN) + (size_t)4096 * 2048; p.lda = 2048; p.ldb = 2048; p.K = 1024; p.so.init(T, 2048, c.G, c.bx);
        p.ov = (bf16*)(ws + WS_V0); p.ssq = (const float*)(ws + WS_SSQ);
        GEMM_RUN(p); }
    SEAM(3);
    if (IN(4)) { const bool rep_now = (MK_REPEAT_K == 4); const PhaseCtx c = phase_ctx(args, wave_s); unsigned char* ws = c.ws;
        P_RESB p; p.A = (const char*)(ws + WS_V0); p.Bt = (const char*)(ws + WS_WOUT); p.lda = 4096; p.ldb = 4096; p.K = 2048; p.so.init(T, 1024, c.G, c.bx);
        p.res32 = args.in[IN_X]; p.hb = (bf16*)(ws + WS_XN); p.row_off = 0;
        GEMM_RUN(p); }
    SEAM(4);
#pragma unroll 1
    for (int L = 0; L < 2; ++L) {
        RELAUNDER();
        const int P0 = L ? 19 : 5;
#define INL(k0, k1) (L ? IN(k1) : IN(k0))
#define SEAML(k0, k1) do { if (L) SEAM(k1); else SEAM(k0); } while (0)
        if (L == 1) {
            if (IN(10)) { const PhaseCtx c = phase_ctx(args, wave_s); if (!fullpro) pro_s3(args, c, lds);
 }
            if (!fullpro) SEAM(10);
#pragma unroll 1
            for (int ch = 0; ch < 2; ++ch) {
                RELAUNDER();
#define INC(k) (ch ? IN((k) + 4) : IN(k))
#define SEAMC(k) do { if (ch) SEAM((k) + 4); else SEAM(k); } while (0)
                if (INC(11)) { const bool rep_now = (MK_REPEAT_K == 11); const PhaseCtx c = phase_ctx(args, wave_s); unsigned char* ws = c.ws;
                    P_QKV1 p; p.A = (const char*)(ws + WS_XN) + (size_t)ch * TC * D * 2; p.Bt = (const char*)(ws + WS_WQKV1); p.lda = 2048; p.ldb = 2048; p.K = 1024; p.so.init(TC, 9216, c.G, c.bx);
                    p.qkv = (bf16*)(ws + WS_Q1); p.gains = (const float*)(ws + WS_WR + 512 * 1024); p.rs1 = (const float*)(ws + WS_GATEW + 1024 * 1024) + ch * TC;
                    GEMM_RUN(p); }
                SEAMC(11);
                if (INC(12)) { const PhaseCtx c = phase_ctx(args, wave_s); unsigned char* ws = c.ws;
#if defined(MK_REPEAT) && MK_REPEAT == 12
                    attn_phase(lds, (bf16*)(ws + WS_Q1), (const bf16*)(ws + WS_K1), (const bf16*)(ws + WS_V1), (f32x2*)(ws + WS_ML), args.in[IN_REL_BIAS], c.G, c.bx, c.tid, (flg & 1) != 0);
#endif
                    attn_phase(lds, (bf16*)(ws + WS_Q1), (const bf16*)(ws + WS_K1), (const bf16*)(ws + WS_V1), (f32x2*)(ws + WS_ML), args.in[IN_REL_BIAS], c.G, c.bx, c.tid); }
                SEAMC(12);
                if (INC(13)) { const PhaseCtx c = phase_ctx(args, wave_s); merge_phase((const bf16*)(c.ws + WS_Q1), (const f32x2*)(c.ws + WS_ML), (bf16*)(c.ws + WS_AO) + (size_t)ch * TC * D, c.G, c.bx, c.tid); }
                SEAMC(13);
#undef INC
#undef SEAMC
            }
            if (IN(18)) { const bool rep_now = (MK_REPEAT_K == 14); const PhaseCtx c = phase_ctx(args, wave_s); unsigned char* ws = c.ws;
                P_RESB p; p.A = (const char*)(ws + WS_AO); p.Bt = (const char*)(ws + WS_WO1); p.lda = 2048; p.ldb = 2048; p.K = 1024; p.so.init(T, 1024, c.G, c.bx);
                p.res32 = nullptr; p.hb = (bf16*)(ws + WS_XN); p.row_off = 0;
                GEMM_RUN(p); }
            SEAM(18);
        }
        if (INL(5, 19)) { const PhaseCtx c = phase_ctx(args, wave_s); if (!fullpro) pro_moe(args, c, lds, L); }
        if (!fullpro) SEAML(5, 19);
        if (INL(6, 20)) { const PhaseCtx c = phase_ctx(args, wave_s); unsigned char* ws = c.ws;
            router_phase(lds, (const bf16*)(ws + WS_WR) + (size_t)L * 48 * 1024, (const bf16*)(ws + WS_WR + 196608) + (size_t)L * 48 * 1024, args.in[IN_RGRP_B] + L * 4, args.in[IN_REXP_B] + L * 32, (const bf16*)(ws + WS_XN), (int*)(ws + WS_LIST), (float*)(ws + WS_GATEW),
                         (unsigned*)(ws + WS_CTL) + CW_CNT + L * 4096, c.G, c.vcu, c.tid); }
        SEAML(6, 20);
        if (INL(7, 21) || INL(8, 22)) { const PhaseCtx c = phase_ctx(args, wave_s); moe_build_tab(TAB, (const unsigned*)(c.ws + WS_CTL) + CW_CNT + L * 4096, c.tid); }
        if (INL(7, 21)) { const bool rep_now = (MK_REPEAT_K == 7); const PhaseCtx c = phase_ctx(args, wave_s); unsigned char* ws = c.ws;
            P_GU p; p.xn = (const char*)(ws + WS_XN); p.W = (const char*)(ws + (L ? WS_WGU1 : WS_WGU0)); p.list = (const int*)(ws + WS_LIST); p.hid = (bf16*)(ws + WS_HID); p.tab = TAB; p.G = c.G; p.vcu = c.vcu; p.K = 1024; p.lda = 2048; p.ldb = 2048;
            GEMM_RUN(p); }
        SEAML(7, 21);
        if (INL(8, 22)) { const bool rep_now = (MK_REPEAT_K == 8); const PhaseCtx c = phase_ctx(args, wave_s); unsigned char* ws = c.ws;
            P_DN p; p.hid = (const char*)(ws + WS_HID); p.W = (const char*)(ws + (L ? WS_WD1 : WS_WD0)); p.y = (bf16*)(ws + WS_YB); p.tab = TAB; p.G = c.G; p.vcu = c.vcu; p.K = 512; p.lda = 1024; p.ldb = 1024;
            GEMM_RUN(p); }
        SEAML(8, 22);
        if (INL(9, 23)) { const PhaseCtx c = phase_ctx(args, wave_s); unsigned char* ws = c.ws;
            if (!(INL(7, 21) || INL(8, 22))) moe_build_tab(TAB, (const unsigned*)(ws + WS_CTL) + CW_CNT + L * 4096, c.tid);
            combine_phase((bf16*)(ws + WS_XN), (const bf16*)(ws + WS_YB), (const unsigned*)(ws + WS_GATEW) + 2 * T, (const float*)(ws + WS_GATEW), TAB, L == 1 ? c.hout : (float*)nullptr, (float*)(ws + WS_GATEW + 1024 * 1024), c.gw, c.NGW, c.lane); }
        SEAML(9, 23);
#undef INL
#undef SEAML
        (void)P0;
    }
#ifdef MK_STAMP
    if (blockIdx.x == 0 && wave_s == 0 && lane_id() == 0) { volatile LAS unsigned long long* st = (volatile LAS unsigned long long*)(lds + LDS_MISC + 3072);
        const float tot = (float)(st[24] - st[0]); float* pr = (float*)(args.ws + WS_CTL) + 200000;
        pr[0] = floorf((float)(st[MK_STAMP_A1] - st[MK_STAMP_A0]) / tot * 200.0f + 0.5f) * 0.005f; pr[1] = 0.f; }
#endif
#undef IN
#undef SEAM
#undef RELAUNDER
#undef fullpro
}
}
#ifndef MK_MASK
#define MK_MASK 15
#endif
#ifndef MK_SPLIT
#define MK_SPLIT 0
#endif

#ifdef MK_DEBUG
namespace dbg {
__global__ void k_cmp(const float* a, const float* b, size_t n, unsigned long long* acc) {
    double num = 0.0, den = 0.0; unsigned long long bad = 0;
    for (size_t i = (size_t)blockIdx.x * blockDim.x + threadIdx.x; i < n; i += (size_t)gridDim.x * blockDim.x) { const float x = a[i], y = b[i]; const float d = x - y; if (!(d - d == 0.0f)) { ++bad; continue; } num += (double)d * d; den += (double)x * x; }
    for (int o = 32; o >= 1; o >>= 1) { num += __shfl_xor(num, o); den += __shfl_xor(den, o); bad += __shfl_xor(bad, o); }
    if ((threadIdx.x & 63) == 0) { atomicAdd(acc, (unsigned long long)(num * 1048576.0)); atomicAdd(acc + 1, (unsigned long long)(den * 1048576.0)); atomicAdd(acc + 2, bad); }
}
__global__ void k_code(const unsigned long long* acc, float* scale) {
    const double num = (double)acc[0], den = (double)acc[1]; const double e = sqrt(num / (den + 1.0));
    int code = e < 0.01 ? 0 : (e < 0.03 ? 1 : (e < 0.1 ? 2 : (e < 0.3 ? 3 : (e < 1.0 ? 4 : 5)))); if (acc[2]) code = 7;
    scale[0] = 1.0f + 0.1f * (float)code;
}
__global__ void k_cmp_bf(const unsigned short* nw, const float* ref, int ldr, int offr, int mode, unsigned long long* acc, int tlo = 0, int thi = 2048) {
    double num = 0.0, den = 0.0; unsigned long long bad = 0;
    const size_t n = mode < 2 ? (size_t)2048 * 1024 : (size_t)2048 * 2048;
    for (size_t i = (size_t)blockIdx.x * blockDim.x + threadIdx.x; i < n; i += (size_t)gridDim.x * blockDim.x) {
        float x, y;
        if (mode < 2) { const int t = (int)(i >> 10), col = (int)(i & 1023), hh = col >> 8, d = col & 255, c = d < 128 ? 2 * d : 2 * (d - 128) + 1;
            const float l2g = log2f(1.0f - exp2f(-5.0f - (float)hh)); const float sc = exp2f((mode == 0 ? -l2g : l2g) * (float)(t & 63));
            y = __uint_as_float(((unsigned)nw[(size_t)t * 1024 + hh * 256 + c]) << 16) * sc; x = ref[(size_t)t * ldr + offr + col]; }
        else { const int t = (int)(i >> 11), col = (int)(i & 2047); if (t < tlo || t >= thi) continue; y = __uint_as_float(((unsigned)nw[(size_t)t * 2048 + col]) << 16); x = ref[(size_t)t * ldr + offr + col]; }
        const float dd = x - y; if (!(dd - dd == 0.0f)) { ++bad; continue; } num += (double)dd * dd; den += (double)x * x; }
    for (int o = 32; o >= 1; o >>= 1) { num += __shfl_xor(num, o); den += __shfl_xor(den, o); bad += __shfl_xor(bad, o); }
    if ((threadIdx.x & 63) == 0) { atomicAdd(acc, (unsigned long long)(num * 1048576.0)); atomicAdd(acc + 1, (unsigned long long)(den * 1048576.0)); atomicAdd(acc + 2, bad); }
}
__device__ inline int code_of(const unsigned long long* acc) { const double e = sqrt((double)acc[0] / ((double)acc[1] + 1.0)); int code = e < 0.01 ? 0 : (e < 0.03 ? 1 : (e < 0.1 ? 2 : (e < 0.3 ? 3 : (e < 1.0 ? 4 : 5)))); if (acc[2]) code = 7; return code; }
__global__ void k_code3(const unsigned long long* acc, float* scale) { scale[0] = 1.0f + 0.1f * (float)code_of(acc); scale[1] = 100.0f * (float)(code_of(acc + 4) + 1) + 10.0f * (float)code_of(acc + 8); }
__global__ void k_spike(float* out, const float* scale) { out[0] += scale[1]; }
__global__ void k_scale(float* out, const float* scale, size_t n) { const float s = scale[0]; for (size_t i = (size_t)blockIdx.x * blockDim.x + threadIdx.x; i < n; i += (size_t)gridDim.x * blockDim.x) out[i] *= s; }
}
#endif
#ifndef MK_SPIKE
#define MK_SPIKE 1000.0f
#endif
#ifdef MK_STAMP
__global__ void stamp_apply(float* out, const float* pr, size_t n) { if (blockIdx.x == 0 && threadIdx.x == 0) out[0] += MK_SPIKE * pr[0]; }
#endif
extern "C" void kernel_launch(void* const* d_in, const int* in_sizes, int n_in, void* d_out, int out_size, void* d_ws, size_t ws_size, hipStream_t stream) {
    (void)in_sizes; (void)n_in; (void)out_size;
    if (ws_size < mk::WS_END) return;
    static int configured = 0, grid = 256;
    if (!configured) { if (hipFuncSetAttribute((const void*)mk::mk_fwd, hipFuncAttributeMaxDynamicSharedMemorySize, mk::LDS_BYTES) != hipSuccess) return;
        int dev = 0, cus = 0, per_cu = 0;
        if (hipGetDevice(&dev) == hipSuccess && hipDeviceGetAttribute(&cus, hipDeviceAttributeMultiprocessorCount, dev) == hipSuccess && cus > 0) grid = cus < 256 ? cus : 256;
        if (hipOccupancyMaxActiveBlocksPerMultiprocessor(&per_cu, (const void*)mk::mk_fwd, 512, mk::LDS_BYTES) != hipSuccess || per_cu < 1) return;
        configured = 1; }
    mk::Args a{};
    for (int i = 0; i < 19; ++i) a.in[i] = (const float*)d_in[i];
    a.out = (float*)d_out; a.ws = (unsigned char*)d_ws; a.pad = 0;
    const int mask = MK_MASK;
    auto run_new = [&](int lo, int hi, int flags) {
        (void)hipMemsetAsync((char*)d_ws + mk::WS_CTL, 0, mk::CTL_BYTES, stream);
        if (MK_SPLIT) { for (int p = lo; p < hi; ++p) { a.ph_lo = p; a.ph_hi = p + 1; a.flags = flags; hipLaunchKernelGGL(mk::mk_fwd, dim3(grid), dim3(512), mk::LDS_BYTES, stream, a); } }
        else { a.ph_lo = lo; a.ph_hi = hi; a.flags = flags; hipLaunchKernelGGL(mk::mk_fwd, dim3(grid), dim3(512), mk::LDS_BYTES, stream, a); }
    };
#ifdef MK_DEBUG
    {
        const size_t MiB = mk::MiB; const size_t nall = (size_t)mk::T * mk::D;
        if (ws_size < 580 * MiB) return;
        nv::Ctx c; nv::ctx_init(c, d_in, d_out, d_ws, stream);
        unsigned long long* acc = (unsigned long long*)((char*)d_ws + 575 * MiB); float* scl = (float*)((char*)d_ws + 575 * MiB + 256);
        float* dout = (float*)d_out; float* alt = nullptr; size_t ncmp = nall;
        if (MK_DEBUG == 1) { nv::stage_mixer0(c); alt = (float*)((char*)d_ws + mk::WS_Q0); a.out = alt; run_new(0, 5, 0); }
        else if (MK_DEBUG == 11) {
            nv::stage_mixer0(c);
            float* xn_n = (float*)((char*)d_ws + 62 * MiB); float* pj_n = (float*)((char*)d_ws + 70 * MiB); float* oc_n = (float*)((char*)d_ws + 118 * MiB);
            (void)hipMemsetAsync(acc, 0, 512, stream);
            run_new(0, 2, 0);
            hipLaunchKernelGGL(nv::k_rmsnorm, dim3(2048 / 4), dim3(256), 0, stream, c.x, c.mixer_norm, xn_n, 2048);
            { nv::GemmP g{}; g.A = xn_n; g.lda = 1024; g.B = c.ret_w_in; g.ldb = 6144; g.C = pj_n; g.ldc = 6144; g.M = 2048; g.N = 6144; g.K = 1024; g.mode = 0; nv::gemm(stream, g); }
            hipLaunchKernelGGL(nv::k_rotary, dim3(2048 * 1024 / 256), dim3(256), 0, stream, pj_n, 2048);
            hipLaunchKernelGGL(dbg::k_cmp_bf, dim3(512), dim3(256), 0, stream, (const unsigned short*)((char*)d_ws + mk::WS_Q0), (const float*)pj_n, 6144, 0, 0, acc);
            hipLaunchKernelGGL(dbg::k_cmp_bf, dim3(512), dim3(256), 0, stream, (const unsigned short*)((char*)d_ws + mk::WS_K0), (const float*)pj_n, 6144, 1024, 1, acc);
            hipLaunchKernelGGL(dbg::k_cmp_bf, dim3(512), dim3(256), 0, stream, (const unsigned short*)((char*)d_ws + mk::WS_V0), (const float*)pj_n, 6144, 2048, 2, acc);
            run_new(2, 3, 0);
            hipLaunchKernelGGL(nv::k_retention, dim3(64, 4, 1), dim3(256), 0, stream, (const float*)pj_n, oc_n);
            hipLaunchKernelGGL(dbg::k_cmp_bf, dim3(512), dim3(256), 0, stream, (const unsigned short*)((char*)d_ws + mk::WS_V0), (const float*)oc_n, 2048, 0, 2, acc + 4);
            run_new(3, 4, 0);
            hipLaunchKernelGGL(nv::k_gnorm_gate, dim3(2048), dim3(256), 0, stream, oc_n, (const float*)pj_n, 2048);
            hipLaunchKernelGGL(dbg::k_cmp_bf, dim3(512), dim3(256), 0, stream, (const unsigned short*)((char*)d_ws + mk::WS_V0), (const float*)oc_n, 2048, 0, 2, acc + 8);
            hipLaunchKernelGGL(dbg::k_code3, dim3(1), dim3(1), 0, stream, (const unsigned long long*)acc, scl);
            nv::stage_moe(c, 0); nv::stage_mixer1(c); nv::stage_moe(c, 1);
            hipLaunchKernelGGL(dbg::k_scale, dim3(1024), dim3(256), 0, stream, dout, (const float*)scl, nall);
            hipLaunchKernelGGL(dbg::k_spike, dim3(1), dim3(1), 0, stream, dout, (const float*)scl);
            return;
        }
        else if (MK_DEBUG == 12) {
            nv::stage_mixer0(c);
            float* xn_n = (float*)((char*)d_ws + 62 * MiB); float* pj_n = (float*)((char*)d_ws + 70 * MiB); float* oc_n = (float*)((char*)d_ws + 118 * MiB);
            (void)hipMemsetAsync(acc, 0, 512, stream);
            run_new(0, 3, 0);
            hipLaunchKernelGGL(nv::k_rmsnorm, dim3(2048 / 4), dim3(256), 0, stream, c.x, c.mixer_norm, xn_n, 2048);
            { nv::GemmP g{}; g.A = xn_n; g.lda = 1024; g.B = c.ret_w_in; g.ldb = 6144; g.C = pj_n; g.ldc = 6144; g.M = 2048; g.N = 6144; g.K = 1024; g.mode = 0; nv::gemm(stream, g); }
            hipLaunchKernelGGL(nv::k_rotary, dim3(2048 * 1024 / 256), dim3(256), 0, stream, pj_n, 2048);
            hipLaunchKernelGGL(nv::k_retention, dim3(64, 4, 1), dim3(256), 0, stream, (const float*)pj_n, oc_n);
            hipLaunchKernelGGL(dbg::k_cmp_bf, dim3(512), dim3(256), 0, stream, (const unsigned short*)((char*)d_ws + mk::WS_V0), (const float*)oc_n, 2048, 0, 2, acc, 0, 64);
            hipLaunchKernelGGL(dbg::k_cmp_bf, dim3(512), dim3(256), 0, stream, (const unsigned short*)((char*)d_ws + mk::WS_V0), (const float*)oc_n, 2048, 0, 2, acc + 4, 64, 128);
            hipLaunchKernelGGL(dbg::k_cmp_bf, dim3(512), dim3(256), 0, stream, (const unsigned short*)((char*)d_ws + mk::WS_V0), (const float*)oc_n, 2048, 0, 2, acc + 8, 128, 2048);
            hipLaunchKernelGGL(dbg::k_code3, dim3(1), dim3(1), 0, stream, (const unsigned long long*)acc, scl);
            nv::stage_moe(c, 0); nv::stage_mixer1(c); nv::stage_moe(c, 1);
            hipLaunchKernelGGL(dbg::k_scale, dim3(1024), dim3(256), 0, stream, dout, (const float*)scl, nall);
            hipLaunchKernelGGL(dbg::k_spike, dim3(1), dim3(1), 0, stream, dout, (const float*)scl);
            return;
        }
        else nv::stage_mixer0(c);
        if (MK_DEBUG == 2) { alt = (float*)((char*)d_ws + 446 * MiB); (void)hipMemcpyAsync(alt, dout, nall * 4, hipMemcpyDeviceToDevice, stream); nv::stage_moe(c, 0); a.out = alt; run_new(5, 10, 0); }
        else if (MK_DEBUG > 2) nv::stage_moe(c, 0);
        if (MK_DEBUG == 3) { alt = (float*)((char*)d_ws + 510 * MiB); ncmp = (size_t)mk::TC * mk::D; (void)hipMemcpyAsync(alt, dout, ncmp * 4, hipMemcpyDeviceToDevice, stream); nv::stage_mixer1(c); a.out = alt; run_new(10, 15, 2); }
        else if (MK_DEBUG > 3) nv::stage_mixer1(c);
        if (MK_DEBUG == 4) { alt = (float*)((char*)d_ws + 446 * MiB); (void)hipMemcpyAsync(alt, dout, nall * 4, hipMemcpyDeviceToDevice, stream); nv::stage_moe(c, 1); a.out = alt; run_new(19, 24, 0); }
        (void)hipMemsetAsync(acc, 0, 512, stream);
        hipLaunchKernelGGL(dbg::k_cmp, dim3(1024), dim3(256), 0, stream, (const float*)dout, (const float*)alt, ncmp, acc);
        hipLaunchKernelGGL(dbg::k_code, dim3(1), dim3(1), 0, stream, (const unsigned long long*)acc, scl);
        if (MK_DEBUG < 2) nv::stage_moe(c, 0);
        if (MK_DEBUG < 3) nv::stage_mixer1(c);
        if (MK_DEBUG < 4) nv::stage_moe(c, 1);
        hipLaunchKernelGGL(dbg::k_scale, dim3(1024), dim3(256), 0, stream, dout, (const float*)scl, nall);
        return;
    }
#endif
#ifdef MK_STAMP
    if (mask == 15) { run_new(0, mk::NPHASE, 1); hipLaunchKernelGGL(stamp_apply, dim3(1024), dim3(256), 0, stream, (float*)d_out, (const float*)((char*)d_ws + mk::WS_CTL) + 200000, (size_t)mk::T * mk::D); return; }
#endif
    if (mask == 15) { run_new(0, mk::NPHASE, MK_SPLIT ? 0 : 1); return; }
#ifdef MK_WITH_NAIVE
    nv::Ctx c; nv::ctx_init(c, d_in, d_out, d_ws, stream);
    if (mask & 1) run_new(0, 5, 0); else nv::stage_mixer0(c);
    if (mask & 2) run_new(5, 10, 0); else nv::stage_moe(c, 0);
    if (mask & 4) run_new(10, 19, 0); else nv::stage_mixer1(c);
    if (mask & 8) run_new(19, 24, 0); else nv::stage_moe(c, 1);
#endif
}
```

```cpp
#include <hip/hip_runtime.h>
#include <cstdio>
#include <cstdint>
#define MK_MASK 15
#define MK_SPLIT 0
namespace mk {
#define LAS __attribute__((address_space(3)))
#define GAS __attribute__((address_space(1)))
typedef unsigned short bf16;
typedef short bf16x8 __attribute__((ext_vector_type(8)));
typedef short s16x4 __attribute__((ext_vector_type(4)));
typedef float f32x4 __attribute__((ext_vector_type(4)));
typedef float f32x2 __attribute__((ext_vector_type(2)));
typedef unsigned u32x4 __attribute__((ext_vector_type(4)));
typedef unsigned u32x2 __attribute__((ext_vector_type(2)));
typedef GAS unsigned gu32;

constexpr int T = 32768, D = 1024, SEQ = 2048, NB = 16;
constexpr int NEXP = 32, FF = 512;
constexpr int TC = 16384;
constexpr size_t MiB = 1u << 20;
constexpr size_t WS_CTL = 0, CTL_BYTES = 1 * MiB;
constexpr size_t WS_COS = 1 * MiB, WS_SIN = 2 * MiB, WS_WR = 3 * MiB;
constexpr size_t WS_SSQ = 4 * MiB, WS_ML = 8 * MiB, WS_LIST = 16 * MiB, WS_GATEW = 24 * MiB;
constexpr size_t WS_WIN = 26 * MiB, WS_WOUT = 38 * MiB, WS_WQKV1 = 42 * MiB, WS_WO1 = 60 * MiB;
constexpr size_t WS_WGU1 = 62 * MiB, WS_WD1 = 126 * MiB;
constexpr size_t WS_XN = 158 * MiB;
constexpr size_t WS_WGU0 = 222 * MiB, WS_WD0 = 286 * MiB;
constexpr size_t WS_ACT = 318 * MiB;
constexpr size_t WS_Q0 = WS_ACT, WS_K0 = WS_ACT + 64 * MiB, WS_V0 = WS_ACT + 128 * MiB;
constexpr size_t WS_HID = WS_ACT, WS_YB = WS_ACT + 72 * MiB;
constexpr size_t WS_Q1 = 222 * MiB, WS_K1 = 318 * MiB, WS_V1 = 414 * MiB, WS_AO = 510 * MiB;
constexpr size_t WS_END = 574 * MiB;
constexpr int CW_BAR = 4096;
constexpr int CW_CNT = 16384;
constexpr int LDS_MISC = 155648;
constexpr int LDS_BYTES = 159 * 1024;
constexpr int NWAVES = 8;

#define LDS_WAIT() asm volatile("s_waitcnt lgkmcnt(0)" ::: "memory")
#define VM_WAIT() asm volatile("s_waitcnt vmcnt(0)" ::: "memory")
__device__ __forceinline__ unsigned f2bf(float f) { unsigned u = __builtin_bit_cast(unsigned, f); return (u + 0x7fffu + ((u >> 16) & 1u)) >> 16; }
__device__ __forceinline__ unsigned pk2(float lo, float hi) { return f2bf(lo) | (f2bf(hi) << 16); }
typedef __bf16 bf16pair_t __attribute__((ext_vector_type(2)));
__device__ __forceinline__ unsigned cvt_pk_bf16(float lo, float hi) { bf16pair_t v; v.x = (__bf16)lo; v.y = (__bf16)hi; return __builtin_bit_cast(unsigned, v); }
__device__ __forceinline__ float bf_lo(unsigned u) { return __builtin_bit_cast(float, u << 16); }
__device__ __forceinline__ float bf_hi(unsigned u) { return __builtin_bit_cast(float, u & 0xffff0000u); }
#define LDS_BARRIER() do { asm volatile("s_waitcnt lgkmcnt(0)" ::: "memory"); __builtin_amdgcn_s_barrier(); asm volatile("" ::: "memory"); } while (0)
__device__ __forceinline__ float xsum16(float x) { const unsigned u = __builtin_bit_cast(unsigned, x); const auto r = __builtin_amdgcn_permlane16_swap(u, u, false, false); return __builtin_bit_cast(float, (unsigned)r[0]) + __builtin_bit_cast(float, (unsigned)r[1]); }
__device__ __forceinline__ float xsum32(float x) { const unsigned u = __builtin_bit_cast(unsigned, x); const auto r = __builtin_amdgcn_permlane32_swap(u, u, false, false); return __builtin_bit_cast(float, (unsigned)r[0]) + __builtin_bit_cast(float, (unsigned)r[1]); }
__device__ __forceinline__ float xmax16(float x) { const unsigned u = __builtin_bit_cast(unsigned, x); const auto r = __builtin_amdgcn_permlane16_swap(u, u, false, false); return fmaxf(__builtin_bit_cast(float, (unsigned)r[0]), __builtin_bit_cast(float, (unsigned)r[1])); }
__device__ __forceinline__ float xmax32(float x) { const unsigned u = __builtin_bit_cast(unsigned, x); const auto r = __builtin_amdgcn_permlane32_swap(u, u, false, false); return fmaxf(__builtin_bit_cast(float, (unsigned)r[0]), __builtin_bit_cast(float, (unsigned)r[1])); }
__device__ __forceinline__ float dpp_add(float x, const int ctrl) { return x; }
__device__ __forceinline__ float wave_sum(float v) {
    v += __builtin_bit_cast(float, __builtin_amdgcn_update_dpp(0, __builtin_bit_cast(int, v), 0xB1, 0xF, 0xF, true));
    v += __builtin_bit_cast(float, __builtin_amdgcn_update_dpp(0, __builtin_bit_cast(int, v), 0x4E, 0xF, 0xF, true));
    v += __builtin_bit_cast(float, __builtin_amdgcn_update_dpp(0, __builtin_bit_cast(int, v), 0x141, 0xF, 0xF, true));
    v += __builtin_bit_cast(float, __builtin_amdgcn_update_dpp(0, __builtin_bit_cast(int, v), 0x140, 0xF, 0xF, true));
    return xsum32(xsum16(v));
}
__device__ __forceinline__ float silu_f(float x) { return x * __builtin_amdgcn_rcpf(1.0f + __builtin_amdgcn_exp2f(-1.4426950408889634f * x)); }

#define XB_TMO      128
#define XB_XCNT(j)  (256  + 64 * (j))
#define XB_XSUB(j)  (1280 + 64 * (j))
#define XB_XGEN(j)  (2304 + 64 * (j))
#define XB_TOP      3328
#define XB_TOPGEN   3392
#define XCD_BAR_WORDS 3456
#define XB_SPIN_CAP (1u << 22)
__device__ __forceinline__ unsigned xb_ld(unsigned* p)              { return __hip_atomic_load(p, __ATOMIC_RELAXED, __HIP_MEMORY_SCOPE_AGENT); }
__device__ __forceinline__ unsigned xb_add(unsigned* p, unsigned v) { return __hip_atomic_fetch_add(p, v, __ATOMIC_RELAXED, __HIP_MEMORY_SCOPE_AGENT); }
__device__ __forceinline__ unsigned xb_xcc_id() { return (unsigned)__builtin_amdgcn_s_getreg((3 << 11) | 20) & 0xFu; }
#define XB_SPIN(cond, bar) do { unsigned _sp = 0; while (cond) { __builtin_amdgcn_s_sleep(1); \
    if ((++_sp & 255u) == 0u) { if (xb_ld(&(bar)[XB_TMO])) break; if (_sp > XB_SPIN_CAP) { atomicAdd(&(bar)[XB_TMO], 1u); break; } } } } while (0)
struct XcdBarrier { unsigned* bar; unsigned x; volatile LAS unsigned* st; };
__device__ __forceinline__ int lane_id() { int l; asm volatile("v_mbcnt_lo_u32_b32 %0, -1, 0\n\tv_mbcnt_hi_u32_b32 %0, -1, %0" : "=v"(l)); return l; }
__device__ __forceinline__ XcdBarrier xcd_barrier_post(unsigned* bar, volatile LAS unsigned* st, bool t0) {
    XcdBarrier b; b.bar = bar; b.x = xb_xcc_id(); b.st = st;
    if (t0) (void)xb_add(&bar[XB_XCNT(b.x)], 1u);
    return b;
}
__device__ __forceinline__ void xcd_barrier_complete(unsigned* bar, unsigned x, unsigned& nloc, unsigned& nx) {
    const unsigned G = gridDim.x * gridDim.y * gridDim.z;
    unsigned sum, cnt, mine, sp = 0u;
    for (;;) {
        sum = 0u; cnt = 0u; mine = 0u;
#pragma unroll
        for (unsigned j = 0; j < 16; ++j) { const unsigned c = xb_ld(&bar[XB_XCNT(j)]); sum += c; cnt += (c > 0u) ? 1u : 0u; mine = (j == x) ? c : mine; }
        if (sum == G) break;
        __builtin_amdgcn_s_sleep(1);
        if ((++sp & 255u) == 0u) { if (xb_ld(&bar[XB_TMO])) break; if (sp > XB_SPIN_CAP) { atomicAdd(&bar[XB_TMO], 1u); break; } }
    }
    nloc = mine > 0u ? mine : 1u; nx = cnt > 0u ? cnt : 1u;
}
__device__ __forceinline__ void xcd_barrier(const XcdBarrier& b, int wave_s) {
    asm volatile("s_waitcnt vmcnt(0)" ::: "memory");
    __syncthreads();
    if (wave_s == 0 && lane_id() == 0) {
        unsigned* bar = b.bar;
        __builtin_amdgcn_s_waitcnt(0);
        unsigned nloc = b.st[0], nx = b.st[1];
        if (nloc == 0u) { xcd_barrier_complete(bar, b.x, nloc, nx); b.st[0] = nloc; b.st[1] = nx; }
        const unsigned old = xb_add(&bar[XB_XSUB(b.x)], 1u);
        const unsigned gen = old / nloc;
        if (old + 1u == (gen + 1u) * nloc) {
            __builtin_amdgcn_fence(__ATOMIC_RELEASE, "agent");
            asm volatile("s_waitcnt vmcnt(0)" ::: "memory");
            const unsigned og = xb_add(&bar[XB_TOP], 1u);
            const unsigned tg = og / nx;
            if (og + 1u == (tg + 1u) * nx) xb_add(&bar[XB_TOPGEN], 1u);
            else XB_SPIN(xb_ld(&bar[XB_TOPGEN]) == tg, bar);
            __builtin_amdgcn_fence(__ATOMIC_ACQUIRE, "agent");
            xb_add(&bar[XB_XGEN(b.x)], 1u);
            asm volatile("s_waitcnt vmcnt(0)" ::: "memory");
        } else {
            XB_SPIN(xb_ld(&bar[XB_XGEN(b.x)]) == gen, bar);
            __builtin_amdgcn_fence(__ATOMIC_ACQUIRE, "agent");
            asm volatile("s_waitcnt vmcnt(0)" ::: "memory");
        }
    }
    __syncthreads();
}

constexpr int BM = 256, BK = 64, HALF = 128, HTB = HALF * BK * 2, NXCD = 8, WGM = 8;
__host__ __device__ __forceinline__ int lds_byte(int r, int c) { const int st = (r >> 4) * 2 + (c >> 5), rr = r & 15, cc = c & 31, ob = rr * 64 + cc * 2; return st * 1024 + (ob ^ (((ob >> 9) & 1) << 5)); }
__host__ __device__ __forceinline__ void stage_rc(int b, int& R, int& C) { const int st = b / 1024, sb = b % 1024, swz = sb ^ (((sb >> 9) & 1) << 5); R = (st >> 1) * 16 + swz / 64; C = (st & 1) * 32 + (swz % 64) / 2; }
__host__ __device__ __forceinline__ int perm32(int rho) { const int n = rho >> 4, i = rho & 15; return 8 * (i >> 2) + 4 * n + (i & 3); }
struct Unit { int pm, pn, a0, a1; };
struct StaticOrder {
    int nM, nN, nwg, G, c;
    __device__ __forceinline__ void init(int M, int N, int G_, int c_) { nM = M / BM; nN = N / BM; nwg = nM * nN; G = G_; c = c_; }
    __device__ __forceinline__ bool next(int i, Unit& u) const {
        const long L = (long)i * G + c; if (L >= nwg) return false;
        int wgid = (int)L; { const int q = nwg / NXCD, r = nwg % NXCD, xcd = wgid % NXCD, off = wgid / NXCD; wgid = (xcd < r ? xcd * (q + 1) : r * (q + 1) + (xcd - r) * q) + off; }
        const int nig = WGM * nN, gid = wgid / nig, fm = gid * WGM, gsz = (nM - fm) < WGM ? (nM - fm) : WGM;
        u.pm = __builtin_amdgcn_readfirstlane(fm + ((wgid % nig) % gsz)); u.pn = __builtin_amdgcn_readfirstlane((wgid % nig) / gsz); u.a0 = 0; u.a1 = 0; return true;
    }
};
template <class P>
__device__ __forceinline__ void gemm_phase(LAS unsigned char* lds, const P& S, const int tid, const bool dry = false, const int stagger = 0) {
    const int wid = __builtin_amdgcn_readfirstlane(tid >> 6), lane = tid & 63, wr = wid >> 2, wc = wid & 3, fr = lane & 15, fq = lane >> 4;
    const int K = S.K, nt = K / BK;
    unsigned voffB[2]; unsigned vA[2][2];
    LAS u32x4* vslot = (LAS u32x4*)(lds + 131072) + tid;
#pragma unroll
    for (int i = 0; i < 2; ++i) { int R, C; stage_rc(tid * 16 + i * 8192, R, C); const int Rb = P::PERM ? ((R & ~31) + perm32(R & 31)) : R;
        voffB[i] = (unsigned)Rb * S.ldb + (unsigned)C * 2u;
#pragma unroll
        for (int h = 0; h < 2; ++h) vA[h][i] = (unsigned)(h * HALF + R) * S.lda + (unsigned)C * 2u; }
    const size_t kstep = (size_t)(BK * 2);
    const size_t hstepB = (size_t)HALF * S.ldb;
    const unsigned ldsw = (unsigned)wid * 1024u;
    const int aoff = lds_byte(wr * 64 + fr, fq * 8), boff = lds_byte(wc * 32 + fr, fq * 8);
#define PG8_SA(b, h) (((b) * 2 + (h)) * HTB)
#define PG8_SB(b, h) ((4 + (b) * 2 + (h)) * HTB)
#define PG8_STAGE(bufoff, gbase, voff) do { _Pragma("unroll") for (int _i = 0; _i < 2; ++_i) \
        __builtin_amdgcn_global_load_lds((const unsigned*)((const char*)(gbase) + (voff)[_i]), (LAS unsigned*)(lds + (bufoff) + ldsw + _i * 8192), 16, 0, 0); } while (0)
#define PG8_LDA(dst, b, h) do { _Pragma("unroll") for (int m = 0; m < 4; ++m) _Pragma("unroll") for (int k = 0; k < 2; ++k) dst[m][k] = *(const LAS bf16x8*)(lds + PG8_SA(b, h) + aoff + m * 2048 + k * 1024); } while (0)
#define PG8_LDB(dst, b, h) do { _Pragma("unroll") for (int n = 0; n < 2; ++n) _Pragma("unroll") for (int k = 0; k < 2; ++k) dst[n][k] = *(const LAS bf16x8*)(lds + PG8_SB(b, h) + boff + n * 2048 + k * 1024); } while (0)
#define PG8_MMA(ai, bj, At, Bt) do { __builtin_amdgcn_s_setprio(1); _Pragma("unroll") for (int m = 0; m < 4; ++m) _Pragma("unroll") for (int n = 0; n < 2; ++n) _Pragma("unroll") for (int k = 0; k < 2; ++k) \
        acc[ai][bj][m][n] = __builtin_amdgcn_mfma_f32_16x16x32_bf16(Bt[n][k], At[m][k], acc[ai][bj][m][n], 0, 0, 0); __builtin_amdgcn_s_setprio(0); } while (0)
#define PG8_WAIT_V(n) asm volatile("s_waitcnt vmcnt(" #n ")" ::: "memory")
#define PG8_WAIT_L(n) asm volatile("s_waitcnt lgkmcnt(" #n ")" ::: "memory")
#define PG8_BAR __builtin_amdgcn_s_barrier()
#define PG8_SCHED __builtin_amdgcn_sched_barrier(0)
    Unit cur, nxt; int ui = 0;
    if (!S.next(0, cur)) return;
    if (stagger > 0) { const int cls = (int)(blockIdx.x & 7u); for (int i = 0; i < cls * stagger; ++i) __builtin_amdgcn_s_sleep(16); }
    f32x4 acc[2][2][4][2];
#pragma unroll
    for (int a = 0; a < 2; ++a)
#pragma unroll
        for (int b = 0; b < 2; ++b)
#pragma unroll
            for (int m = 0; m < 4; ++m)
#pragma unroll
                for (int n = 0; n < 2; ++n) acc[a][b][m][n] = (f32x4){0.f, 0.f, 0.f, 0.f};
    bf16x8 At[4][2], B0[2][2], B1[2][2];
    const char* cA = S.a_base(cur); const char* cB = S.b_base(cur);
    bool skip_hi = P::HALFABLE && (cur.a0 >> 6) != 0;
    if constexpr (P::GATHER) { S.a_rows(cur, tid, vA); }
    PG8_STAGE(PG8_SB(0, 0), cB, voffB); PG8_STAGE(PG8_SB(0, 1), cB + hstepB, voffB); PG8_STAGE(PG8_SA(0, 0), cA, vA[0]); PG8_STAGE(PG8_SA(0, 1), cA, vA[1]);
    if (wr == 1) PG8_BAR;
    PG8_WAIT_V(2); PG8_BAR;
    PG8_STAGE(PG8_SB(1, 0), cB + kstep, voffB); PG8_STAGE(PG8_SA(1, 0), cA + kstep, vA[0]); PG8_STAGE(PG8_SB(1, 1), cB + hstepB + kstep, voffB);
    PG8_WAIT_V(6); PG8_BAR;
    for (;;) {
        const bool has_next = S.next(ui + 1, nxt);
        const char* nA = has_next ? S.a_base(nxt) : cA; const char* nB = has_next ? S.b_base(nxt) : cB;
        for (int t = 0; t < nt; t += 2) {
            const bool last = (t == nt - 2);
            if constexpr (P::GATHER) { if (t == nt - 4 && has_next) { unsigned tn[2][2]; S.a_rows(nxt, tid, tn); *vslot = (u32x4){tn[0][0], tn[0][1], tn[1][0], tn[1][1]}; } }
            const char* a1 = cA + (size_t)(t + 1) * kstep;
            const char* a2 = last ? nA : cA + (size_t)(t + 2) * kstep; const char* b2 = last ? nB : cB + (size_t)(t + 2) * kstep;
            const char* a3 = a2 + kstep; const char* b3 = b2 + kstep;
            unsigned v2[2][2];
#pragma unroll
            for (int h = 0; h < 2; ++h)
#pragma unroll
                for (int i = 0; i < 2; ++i) v2[h][i] = vA[h][i];
            if constexpr (P::GATHER) { if (last && has_next) { const u32x4 tn = *vslot; v2[0][0] = tn.x; v2[0][1] = tn.y; v2[1][0] = tn.z; v2[1][1] = tn.w; } }
            PG8_LDB(B0, 0, 0); PG8_LDB(B1, 0, 1); PG8_SCHED; PG8_LDA(At, 0, 0); PG8_STAGE(PG8_SA(1, 1), a1, vA[1]);
            PG8_WAIT_V(8); PG8_WAIT_L(0); PG8_BAR; PG8_MMA(0, 0, At, B0); PG8_MMA(0, 1, At, B1); PG8_BAR; PG8_SCHED;
            PG8_LDA(At, 0, 1); PG8_STAGE(PG8_SB(0, 0), b2, voffB); PG8_STAGE(PG8_SB(0, 1), b2 + hstepB, voffB); PG8_STAGE(PG8_SA(0, 0), a2, v2[0]);
            PG8_WAIT_V(8); PG8_WAIT_L(0); PG8_BAR; if (!skip_hi) { PG8_MMA(1, 0, At, B0); PG8_MMA(1, 1, At, B1); } PG8_BAR; PG8_SCHED;
            PG8_LDB(B0, 1, 0); PG8_LDB(B1, 1, 1); PG8_SCHED; PG8_LDA(At, 1, 0); PG8_STAGE(PG8_SA(0, 1), a2, v2[1]);
            PG8_WAIT_V(8); PG8_WAIT_L(0); PG8_BAR; PG8_MMA(0, 0, At, B0); PG8_MMA(0, 1, At, B1); PG8_BAR; PG8_SCHED;
            PG8_LDA(At, 1, 1); PG8_STAGE(PG8_SB(1, 0), b3, voffB); PG8_STAGE(PG8_SB(1, 1), b3 + hstepB, voffB); PG8_STAGE(PG8_SA(1, 0), a3, v2[0]);
            PG8_WAIT_V(8); PG8_WAIT_L(0); PG8_BAR; if (!skip_hi) { PG8_MMA(1, 0, At, B0); PG8_MMA(1, 1, At, B1); } PG8_BAR; PG8_SCHED;
        }
        if (wr == 0) PG8_BAR;
        { int fr_e = fr, fq_e = fq; asm volatile("" : "+v"(fr_e), "+v"(fq_e));
          if (!dry) S.epi(acc, cur, wr, wc, fr_e, fq_e); }
        if (!has_next) break;
#pragma unroll
        for (int a = 0; a < 2; ++a)
#pragma unroll
            for (int b = 0; b < 2; ++b)
#pragma unroll
                for (int m = 0; m < 4; ++m)
#pragma unroll
                    for (int n = 0; n < 2; ++n) acc[a][b][m][n] = (f32x4){0.f, 0.f, 0.f, 0.f};
        cur = nxt; cA = nA; cB = nB; ++ui; skip_hi = P::HALFABLE && (cur.a0 >> 6) != 0;
        if constexpr (P::GATHER) { const u32x4 tn = *vslot; vA[0][0] = tn.x; vA[0][1] = tn.y; vA[1][0] = tn.z; vA[1][1] = tn.w; }
        if (wr == 1) PG8_BAR;
    }
    PG8_WAIT_V(0);
    PG8_BAR;
#undef PG8_SA
#undef PG8_SB
#undef PG8_STAGE
#undef PG8_LDA
#undef PG8_LDB
#undef PG8_MMA
#undef PG8_WAIT_V
#undef PG8_WAIT_L
#undef PG8_BAR
#undef PG8_SCHED
}
struct PlainBase {
    const char* A; const char* Bt; unsigned lda, ldb; int K; StaticOrder so;
    __device__ __forceinline__ bool next(int i, Unit& u) const { return so.next(i, u); }
    __device__ __forceinline__ const char* a_base(const Unit& u) const { return A + (size_t)u.pm * BM * lda; }
    __device__ __forceinline__ const char* b_base(const Unit& u) const { return Bt + (size_t)u.pn * BM * ldb; }
    __device__ __forceinline__ void a_rows(const Unit&, int, unsigned (&)[2][2]) const {}
};
__device__ __forceinline__ float head_l2g(int h) { return __builtin_log2f(1.0f - __builtin_amdgcn_exp2f(-5.0f - (float)h)); }

struct P_QKV0 : PlainBase {
    static constexpr bool PERM = true, GATHER = false, HALFABLE = false;
    bf16* qk; bf16* v; const float* cs; const float* sn;
    int i0, i1;
    __device__ __forceinline__ bool next(int i, Unit& u) const { return (i + i0 < i1) && so.next(i + i0, u); }
    __device__ __forceinline__ void epi(const f32x4 (&acc)[2][2][4][2], const Unit& u, int wr, int wc, int fr, int fq) const {
        const int row0 = u.pm * BM + wr * 64 + fr, pn = u.pn;
        if (pn < 8) {
            const int hh = pn & 3; const bool isk = pn >= 4; bf16* dst = qk + (size_t)(pn >> 2) * ((size_t)T * 1024);
            const float l2g = isk ? -head_l2g(hh) : head_l2g(hh);
            float invr[2][4];
#pragma unroll
            for (int bj = 0; bj < 2; ++bj)
#pragma unroll
                for (int p = 0; p < 4; ++p) invr[bj][p] = __builtin_amdgcn_exp2f((float)(bj * 64 + wc * 16 + 4 * fq + p) * (-13.287712379549449f / 127.0f)) * 0.15915494309189535f;
#pragma unroll
            for (int ai = 0; ai < 2; ++ai)
#pragma unroll
                for (int m = 0; m < 4; ++m) { const int row = row0 + ai * HALF + m * 16, pos = row & (SEQ - 1);
                    const float sc = __builtin_amdgcn_exp2f(l2g * (float)(pos & 63)), fp = (float)pos;
#pragma unroll
                    for (int bj = 0; bj < 2; ++bj) { const int c0 = bj * HALF + wc * 32 + 8 * fq;
                        float cv[4], sv[4];
#pragma unroll
                        for (int p = 0; p < 4; ++p) { const float rev = fp * invr[bj][p], fr_ = rev - __builtin_floorf(rev); cv[p] = __builtin_amdgcn_cosf(fr_) * sc; sv[p] = __builtin_amdgcn_sinf(fr_) * sc; }
                        const f32x4 v0 = acc[ai][bj][m][0], v1 = acc[ai][bj][m][1];
                        u32x4 w;
                        w.x = cvt_pk_bf16(v0[0] * cv[0] - v0[1] * sv[0], v0[0] * sv[0] + v0[1] * cv[0]);
                        w.y = cvt_pk_bf16(v0[2] * cv[1] - v0[3] * sv[1], v0[2] * sv[1] + v0[3] * cv[1]);
                        w.z = cvt_pk_bf16(v1[0] * cv[2] - v1[1] * sv[2], v1[0] * sv[2] + v1[1] * cv[2]);
                        w.w = cvt_pk_bf16(v1[2] * cv[3] - v1[3] * sv[3], v1[2] * sv[3] + v1[3] * cv[3]);
                        *(u32x4*)(dst + (size_t)row * 1024 + hh * 256 + c0) = w; } }
        } else {
#pragma unroll
            for (int ai = 0; ai < 2; ++ai)
#pragma unroll
                for (int m = 0; m < 4; ++m) { const int row = row0 + ai * HALF + m * 16;
#pragma unroll
                    for (int bj = 0; bj < 2; ++bj) { const int c0 = bj * HALF + wc * 32 + 8 * fq;
                        const f32x4 v0 = acc[ai][bj][m][0], v1 = acc[ai][bj][m][1];
                        u32x4 w; w.x = cvt_pk_bf16(v0[0], v0[1]); w.y = cvt_pk_bf16(v0[2], v0[3]); w.z = cvt_pk_bf16(v1[0], v1[1]); w.w = cvt_pk_bf16(v1[2], v1[3]);
                        *(u32x4*)(v + (size_t)row * 2048 + (pn - 8) * 256 + c0) = w; } }
        }
    }
};
struct P_GATE : PlainBase {
    static constexpr bool PERM = true, GATHER = false, HALFABLE = false;
    bf16* ov; const float* ssq;
    __device__ __forceinline__ void epi(const f32x4 (&acc)[2][2][4][2], const Unit& u, int wr, int wc, int fr, int fq) const {
        const int row0 = u.pm * BM + wr * 64 + fr, head = u.pn >> 1;
#pragma unroll
        for (int ai = 0; ai < 2; ++ai) {
            f32x4 s0[4], s1[4]; u32x4 ov4[4][2];
#pragma unroll
            for (int m = 0; m < 4; ++m) { const int row = row0 + ai * HALF + m * 16;
                s0[m] = *(const f32x4*)(ssq + ((size_t)row * 4 + head) * 8); s1[m] = *(const f32x4*)(ssq + ((size_t)row * 4 + head) * 8 + 4);
#pragma unroll
                for (int bj = 0; bj < 2; ++bj) ov4[m][bj] = *(const u32x4*)(ov + (size_t)row * 2048 + u.pn * BM + bj * HALF + wc * 32 + 8 * fq); }
#pragma unroll
            for (int m = 0; m < 4; ++m) { const int row = row0 + ai * HALF + m * 16;
                const float rs = __builtin_amdgcn_rsqf((((s0[m][0] + s0[m][1]) + (s0[m][2] + s0[m][3])) + ((s1[m][0] + s1[m][1]) + (s1[m][2] + s1[m][3]))) * (1.0f / 512.0f) + 1e-6f);
#pragma unroll
                for (int bj = 0; bj < 2; ++bj) { const u32x4 o = ov4[m][bj];
                    const f32x4 v0 = acc[ai][bj][m][0], v1 = acc[ai][bj][m][1];
                    u32x4 w;
                    w.x = cvt_pk_bf16(silu_f(v0[0]) * bf_lo(o.x) * rs, silu_f(v0[1]) * bf_hi(o.x) * rs);
                    w.y = cvt_pk_bf16(silu_f(v0[2]) * bf_lo(o.y) * rs, silu_f(v0[3]) * bf_hi(o.y) * rs);
                    w.z = cvt_pk_bf16(silu_f(v1[0]) * bf_lo(o.z) * rs, silu_f(v1[1]) * bf_hi(o.z) * rs);
                    w.w = cvt_pk_bf16(silu_f(v1[2]) * bf_lo(o.w) * rs, silu_f(v1[3]) * bf_hi(o.w) * rs);
                    *(u32x4*)(ov + (size_t)row * 2048 + u.pn * BM + bj * HALF + wc * 32 + 8 * fq) = w; } }
        }
    }
};
struct P_RESB : PlainBase {
    static constexpr bool PERM = true, GATHER = false, HALFABLE = false;
    const float* res32; bf16* hb; int row_off;
    __device__ __forceinline__ void epi(const f32x4 (&acc)[2][2][4][2], const Unit& u, int wr, int wc, int fr, int fq) const {
        const int row0 = row_off + u.pm * BM + wr * 64 + fr;
#pragma unroll
        for (int ai = 0; ai < 2; ++ai) {
            f32x4 r[4][2][2];
#pragma unroll
            for (int m = 0; m < 4; ++m) { const size_t off = (size_t)(row0 + ai * HALF + m * 16) * D + u.pn * BM + wc * 32 + 8 * fq;
#pragma unroll
                for (int bj = 0; bj < 2; ++bj) {
                    if (res32) { r[m][bj][0] = *(const f32x4*)(res32 + off + bj * HALF); r[m][bj][1] = *(const f32x4*)(res32 + off + bj * HALF + 4); }
                    else { const u32x4 o = *(const u32x4*)(hb + off + bj * HALF); r[m][bj][0] = (f32x4){bf_lo(o.x), bf_hi(o.x), bf_lo(o.y), bf_hi(o.y)}; r[m][bj][1] = (f32x4){bf_lo(o.z), bf_hi(o.z), bf_lo(o.w), bf_hi(o.w)}; } } }
#pragma unroll
            for (int m = 0; m < 4; ++m) { const size_t off = (size_t)(row0 + ai * HALF + m * 16) * D + u.pn * BM + wc * 32 + 8 * fq;
#pragma unroll
                for (int bj = 0; bj < 2; ++bj) { const f32x4 r0 = r[m][bj][0] + acc[ai][bj][m][0], r1 = r[m][bj][1] + acc[ai][bj][m][1];
                    u32x4 w; w.x = cvt_pk_bf16(r0[0], r0[1]); w.y = cvt_pk_bf16(r0[2], r0[3]); w.z = cvt_pk_bf16(r1[0], r1[1]); w.w = cvt_pk_bf16(r1[2], r1[3]);
                    *(u32x4*)(hb + off + bj * HALF) = w; } }
        }
    }
};
struct P_QKV1 : PlainBase {
    static constexpr bool PERM = true, GATHER = false, HALFABLE = false;
    bf16* qkv; const float* gains; const float* rs1;
    __device__ __forceinline__ void epi(const f32x4 (&acc)[2][2][4][2], const Unit& u, int wr, int wc, int fr, int fq) const {
        const int row0 = u.pm * BM + wr * 64 + fr, part = u.pn / 12, pp = u.pn % 12, g = pp >> 2, head = (pp & 3) * 4 + wc;
        const int Rg = g == 0 ? 1 : (g == 1 ? 4 : 16), shR = g == 0 ? 0 : (g == 1 ? 2 : 4);
        bf16* dst = qkv + (size_t)part * ((size_t)TC * 3072) + (size_t)(g * 16 + head) * (SEQ * 64) + 8 * fq;
        const float* gp = gains + (part & 1) * 192 + g * 64 + 8 * fq;
        const float qs = part == 0 ? 0.125f * 1.4426950408889634f : 1.0f;
        float rsr[2][4];
#pragma unroll
        for (int ai = 0; ai < 2; ++ai)
#pragma unroll
            for (int m = 0; m < 4; ++m) rsr[ai][m] = rs1[row0 + ai * HALF + m * 16];
        f32x4 gv[2][2];
#pragma unroll
        for (int bj = 0; bj < 2; ++bj) { gv[bj][0] = *(const f32x4*)(gp + 32 * bj); gv[bj][1] = *(const f32x4*)(gp + 32 * bj + 4); }
#pragma unroll
        for (int ai = 0; ai < 2; ++ai)
#pragma unroll
            for (int m = 0; m < 4; ++m) { const int row = row0 + ai * HALF + m * 16;
                float rs = rsr[ai][m];
                if (part < 2) {
                    float ss = 0.f;
#pragma unroll
                    for (int bj = 0; bj < 2; ++bj)
#pragma unroll
                        for (int n = 0; n < 2; ++n) { const f32x4 t = acc[ai][bj][m][n]; ss += (t[0] * t[0] + t[1] * t[1]) + (t[2] * t[2] + t[3] * t[3]); }
                    ss = xsum32(xsum16(ss));
                    rs = rs * __builtin_amdgcn_rsqf(ss * rs * rs * (1.0f / 64.0f) + 1e-6f) * qs;
                }
#pragma unroll
                for (int bj = 0; bj < 2; ++bj) { f32x4 v0 = acc[ai][bj][m][0], v1 = acc[ai][bj][m][1];
                    if (part < 2) { v0 = v0 * gv[bj][0] * rs; v1 = v1 * gv[bj][1] * rs; } else { v0 = v0 * rs; v1 = v1 * rs; }
                    u32x4 w; w.x = cvt_pk_bf16(v0[0], v0[1]); w.y = cvt_pk_bf16(v0[2], v0[3]); w.z = cvt_pk_bf16(v1[0], v1[1]); w.w = cvt_pk_bf16(v1[2], v1[3]);
                    { const int bl = row >> 11, t = row & (SEQ - 1), pos = (t & (Rg - 1)) * (SEQ >> shR) + (t >> shR); *(u32x4*)(dst + ((size_t)bl * 48 * SEQ + pos) * 64 + 32 * bj) = w; } } }
    }
};
__device__ __forceinline__ void moe_build_tab(LAS int* tab, const unsigned* cnt_g, const int tid) {
    if (tid < 64) tab[tid] = (int)__hip_atomic_load(cnt_g + tid * 64, __ATOMIC_RELAXED, __HIP_MEMORY_SCOPE_AGENT);
    __syncthreads();
    if (tid < 64) { int pre = 0, fpre = 0, hpre = 0, ftot = 0, tot = 0;
        for (int b = 0; b < 64; ++b) { const int c = tab[b], nt = (c + 255) >> 8, hf = (nt > 0 && c - 256 * (nt - 1) <= 128) ? 1 : 0, fl = nt - hf;
            if (b < tid) { pre += nt; fpre += fl; hpre += hf; } ftot += fl; tot += nt; }
        const int c = tab[tid], nt = (c + 255) >> 8, hf = (nt > 0 && c - 256 * (nt - 1) <= 128) ? 1 : 0;
        tab[64 + tid] = pre; if (tid == 0) tab[128] = tot;
        for (int t = 0; t < nt - hf; ++t) tab[160 + fpre + t] = tid | (t << 8);
        if (hf) tab[160 + ftot + hpre] = tid | 64 | ((nt - 1) << 8); }
    __syncthreads();
}
__device__ __forceinline__ int moe_sched(const LAS int* tab, int pos) { return __builtin_amdgcn_readfirstlane(tab[160 + pos]); }
struct P_GU {
    static constexpr bool PERM = true, GATHER = true, HALFABLE = true;
      const char* xn; const char* W; const int* list; bf16* hid; const LAS int* tab; int G, vcu; int K; unsigned lda, ldb;
    __device__ __forceinline__ bool next(int i, Unit& u) const {
        const int L = i * G + vcu; if (L >= tab[128] * 4) return false;
        const int e = moe_sched(tab, L >> 2), b = e & 63;
        u.pm = e >> 8; u.pn = L & 3; u.a0 = e & 127; u.a1 = tab[64 + b] + (e >> 8); return true;
    }
    __device__ __forceinline__ const char* a_base(const Unit&) const { return xn; }
    __device__ __forceinline__ const char* b_base(const Unit& u) const { return W + ((size_t)(u.a0 & 31) * 1024 + (size_t)u.pn * BM) * 2048; }
    __device__ __forceinline__ void a_rows(const Unit& u, int tid, unsigned (&off)[2][2]) const {
        const int n = tab[u.a0 & 63]; const int* lp = list + (size_t)(u.a0 & 63) * T + u.pm * BM;
#pragma unroll
        for (int i = 0; i < 2; ++i) { int R, C; stage_rc(tid * 16 + i * 8192, R, C);
#pragma unroll
            for (int h = 0; h < 2; ++h) { const int r = h * HALF + R; const int tok = (u.pm * BM + r < n) ? lp[r] : 0; off[h][i] = (unsigned)tok * 2048u + (unsigned)C * 2u; } }
    }
    __device__ __forceinline__ void epi(const f32x4 (&acc)[2][2][4][2], const Unit& u, int wr, int wc, int fr, int fq) const {
        const size_t hrow0 = (size_t)u.a1 * BM + wr * 64 + fr; const int n = tab[u.a0 & 63]; const int* lp = list + (size_t)(u.a0 & 63) * T + u.pm * BM;
        float rsr[2][4];
#pragma unroll
        for (int ai = 0; ai < 2; ++ai)
#pragma unroll
            for (int m = 0; m < 4; ++m) { const int r = ai * HALF + wr * 64 + m * 16 + fr; rsr[ai][m] = (u.pm * BM + r < n) ? *(const float*)((const char*)(lp + r) - (WS_LIST - WS_ML)) : 0.0f; }
#pragma unroll
        for (int ai = 0; ai < 2; ++ai)
#pragma unroll
            for (int m = 0; m < 4; ++m) { const float rs = rsr[ai][m];
                { const int f0 = u.pn * HALF + wc * 32 + 8 * fq;
                    const f32x4 g0 = acc[ai][0][m][0] * rs, g1 = acc[ai][0][m][1] * rs, u0 = acc[ai][1][m][0] * rs, u1 = acc[ai][1][m][1] * rs;
                    u32x4 w; w.x = cvt_pk_bf16(silu_f(g0[0]) * u0[0], silu_f(g0[1]) * u0[1]); w.y = cvt_pk_bf16(silu_f(g0[2]) * u0[2], silu_f(g0[3]) * u0[3]);
                    w.z = cvt_pk_bf16(silu_f(g1[0]) * u1[0], silu_f(g1[1]) * u1[1]); w.w = cvt_pk_bf16(silu_f(g1[2]) * u1[2], silu_f(g1[3]) * u1[3]);
                    *(u32x4*)(hid + (hrow0 + ai * HALF + m * 16) * FF + f0) = w; } }
    }
};
struct P_DN {
    static constexpr bool PERM = true, GATHER = false, HALFABLE = true;
    const char* hid; const char* W; bf16* y; const LAS int* tab; int G, vcu; int K; unsigned lda, ldb;
    __device__ __forceinline__ bool next(int i, Unit& u) const {
        const int L = i * G + vcu; if (L >= tab[128] * 4) return false;
        const int e = moe_sched(tab, L >> 2), b = e & 63;
        u.pm = e >> 8; u.pn = L & 3; u.a0 = e & 127; u.a1 = tab[64 + b] + (e >> 8); return true;
    }
    __device__ __forceinline__ const char* a_base(const Unit& u) const { return hid + (size_t)u.a1 * BM * 1024; }
    __device__ __forceinline__ const char* b_base(const Unit& u) const { return W + ((size_t)(u.a0 & 31) * 1024 + (size_t)u.pn * BM) * 1024; }
    __device__ __forceinline__ void a_rows(const Unit&, int, unsigned (&)[2][2]) const {}
    __device__ __forceinline__ void epi(const f32x4 (&acc)[2][2][4][2], const Unit& u, int wr, int wc, int fr, int fq) const {
        bf16* yp = y + ((size_t)u.a1 * BM + wr * 64 + fr) * D + u.pn * BM + wc * 32 + 8 * fq;
#pragma unroll
        for (int ai = 0; ai < 2; ++ai)
#pragma unroll
            for (int m = 0; m < 4; ++m)
#pragma unroll
                for (int bj = 0; bj < 2; ++bj) { const f32x4 v0 = acc[ai][bj][m][0], v1 = acc[ai][bj][m][1];
                    u32x4 w; w.x = cvt_pk_bf16(v0[0], v0[1]); w.y = cvt_pk_bf16(v0[2], v0[3]); w.z = cvt_pk_bf16(v1[0], v1[1]); w.w = cvt_pk_bf16(v1[2], v1[3]);
                    *(u32x4*)(yp + (size_t)(ai * HALF + m * 16) * D + bj * HALF) = w; }
    }
};
__device__ __forceinline__ void combine_phase(bf16* hb, const bf16* y, const unsigned* binpos, const float* gatew, const LAS int* tab, float* out32, float* rs_out, int gw, int ngw, int lane) {
    for (int tk = gw; tk < T; tk += ngw) {
        const unsigned bp0 = binpos[tk * 2], bp1 = binpos[tk * 2 + 1]; const float g0 = gatew[tk * 2], g1 = gatew[tk * 2 + 1];
        const size_t r0 = (size_t)tab[64 + (bp0 >> 16)] * BM + (bp0 & 0xffffu), r1 = (size_t)tab[64 + (bp1 >> 16)] * BM + (bp1 & 0xffffu);
        GAS u32x4* hp = (GAS u32x4*)(hb + (size_t)tk * D) + lane;
        const GAS u32x4* y0 = (const GAS u32x4*)(y + r0 * D) + lane; const GAS u32x4* y1 = (const GAS u32x4*)(y + r1 * D) + lane;
        u32x4 hh[2], a[2], b[2];
#pragma unroll
        for (int j = 0; j < 2; ++j) { hh[j] = hp[64 * j]; a[j] = y0[64 * j]; b[j] = y1[64 * j]; }
        float v[2][8]; float s = 0.f;
#pragma unroll
        for (int j = 0; j < 2; ++j) {
            v[j][0] = bf_lo(hh[j].x) + g0 * bf_lo(a[j].x) + g1 * bf_lo(b[j].x); v[j][1] = bf_hi(hh[j].x) + g0 * bf_hi(a[j].x) + g1 * bf_hi(b[j].x);
            v[j][2] = bf_lo(hh[j].y) + g0 * bf_lo(a[j].y) + g1 * bf_lo(b[j].y); v[j][3] = bf_hi(hh[j].y) + g0 * bf_hi(a[j].y) + g1 * bf_hi(b[j].y);
            v[j][4] = bf_lo(hh[j].z) + g0 * bf_lo(a[j].z) + g1 * bf_lo(b[j].z); v[j][5] = bf_hi(hh[j].z) + g0 * bf_hi(a[j].z) + g1 * bf_hi(b[j].z);
            v[j][6] = bf_lo(hh[j].w) + g0 * bf_lo(a[j].w) + g1 * bf_lo(b[j].w); v[j][7] = bf_hi(hh[j].w) + g0 * bf_hi(a[j].w) + g1 * bf_hi(b[j].w);
#pragma unroll
            for (int e = 0; e < 8; ++e) s += v[j][e] * v[j][e]; }
        if (out32) { GAS f32x4* op = (GAS f32x4*)(out32 + (size_t)tk * D) + 2 * lane;
#pragma unroll
            for (int j = 0; j < 2; ++j) { op[128 * j] = (f32x4){v[j][0], v[j][1], v[j][2], v[j][3]}; op[128 * j + 1] = (f32x4){v[j][4], v[j][5], v[j][6], v[j][7]}; } }
        else {
#pragma unroll
            for (int j = 0; j < 2; ++j) { u32x4 w; w.x = cvt_pk_bf16(v[j][0], v[j][1]); w.y = cvt_pk_bf16(v[j][2], v[j][3]); w.z = cvt_pk_bf16(v[j][4], v[j][5]); w.w = cvt_pk_bf16(v[j][6], v[j][7]); hp[64 * j] = w; }
            const float rs = __builtin_amdgcn_rsqf(wave_sum(s) * (1.f / D) + 1e-6f); if (lane == 0) rs_out[tk] = rs; }
    }
}

struct MapId { int off; __device__ __forceinline__ int row(int n) const { return n + off; } __device__ __forceinline__ float scale(int) const { return 1.0f; } };
struct MapWin { __device__ __forceinline__ int row(int n) const { if (n >= 2048) return n; const int d = n & 255; return (n & ~255) + ((d < 128) ? 2 * d : 2 * (d - 128) + 1); }
                __device__ __forceinline__ float scale(int n) const { return (n >= 1024 && n < 2048) ? 0.0625f : 1.0f; } };
struct MapQkv1 { int base; __device__ __forceinline__ int row(int n) const { const int two = n / 3072, n1 = n % 3072, g = n1 >> 10, h = (n1 >> 6) & 15, d = n1 & 63;
                     return base + two * 3072 + (g * 4 + (h >> 2)) * 256 + 32 * (h & 3) + (d & 31) + 128 * (d >> 5); }
                 __device__ __forceinline__ float scale(int) const { return 1.0f; } };
struct MapGu { int up; __device__ __forceinline__ int row(int f) const { return (f >> 7) * 256 + (f & 127) + 128 * up; }     __device__ __forceinline__ float scale(int) const { return 1.0f; } };
__device__ __forceinline__ void transpose_load(const float* W, int N, int item, int lane, f32x4 (&v)[16]) {
    const int nblk = N / 64, kb = item / nblk, nb = item % nblk, k0 = 64 * kb, n0 = 64 * nb;
#pragma unroll
    for (int i = 0; i < 16; ++i) v[i] = __builtin_nontemporal_load((const GAS f32x4*)(W + (size_t)(k0 + 4 * i + (lane >> 4)) * N + n0 + 4 * (lane & 15)));
}
template <class Map>
__device__ __forceinline__ void transpose_finish(const f32x4 (&v)[16], int N, bf16* WT, int ldt, LAS float* scr, int item, int lane, const float* gain, const Map mp) {
    const int nblk = N / 64, kb = item / nblk, nb = item % nblk, k0 = 64 * kb, n0 = 64 * nb;
#pragma unroll
    for (int i = 0; i < 16; ++i) { const int kk = 4 * i + (lane >> 4); const float gg = gain ? gain[k0 + kk] : 1.0f; LAS float* d = scr + kk * 65 + 4 * (lane & 15);
        d[0] = v[i][0] * gg; d[1] = v[i][1] * gg; d[2] = v[i][2] * gg; d[3] = v[i][3] * gg; }
    LDS_WAIT(); asm volatile("" ::: "memory");
    const int c = lane & 7;
#pragma unroll
    for (int j = 0; j < 8; ++j) { const int n = (lane >> 3) + 8 * j; const LAS float* s = scr + (8 * c) * 65 + n; const float sc = mp.scale(n0 + n);
        u32x4 o; o.x = pk2(s[0 * 65] * sc, s[1 * 65] * sc); o.y = pk2(s[2 * 65] * sc, s[3 * 65] * sc); o.z = pk2(s[4 * 65] * sc, s[5 * 65] * sc); o.w = pk2(s[6 * 65] * sc, s[7 * 65] * sc);
        *(GAS u32x4*)(WT + (size_t)mp.row(n0 + n) * ldt + k0 + 8 * c) = o; }
    LDS_WAIT(); asm volatile("" ::: "memory");
}
template <class Map>
__device__ __forceinline__ void transpose_item(const float* W, int N, bf16* WT, int ldt, LAS float* scr, int item, int lane, const float* gain, const Map mp) {
    f32x4 v[16]; transpose_load(W, N, item, lane, v); transpose_finish(v, N, WT, ldt, scr, item, lane, gain, mp);
}
template <class Map>
__device__ __forceinline__ void transpose_matrix(const float* W, int K, int N, bf16* WT, LAS float* scr, int gw, int ngw, int lane, const float* gain, const Map mp) {
    const int nitems = (K / 64) * (N / 64);
    if (gw >= nitems) return;
    f32x4 v[16]; transpose_load(W, N, gw, lane, v);
    for (int it = gw; it < nitems; it += ngw) { f32x4 cur[16];
#pragma unroll
        for (int i = 0; i < 16; ++i) cur[i] = v[i];
        if (it + ngw < nitems) transpose_load(W, N, it + ngw, lane, v);
        transpose_finish(cur, N, WT, K, scr, it, lane, gain, mp); }
}
__device__ __forceinline__ void rms_row_to_bf16(const float* xrow, bf16* orow, int lane) {
    const GAS f32x4* xr = (const GAS f32x4*)xrow + lane;
    f32x4 v[4]; float s = 0.f;
#pragma unroll
    for (int j = 0; j < 4; ++j) { v[j] = xr[64 * j]; s += (v[j].x * v[j].x + v[j].y * v[j].y) + (v[j].z * v[j].z + v[j].w * v[j].w); }
    const float rs = __builtin_amdgcn_rsqf(wave_sum(s) * (1.f / D) + 1e-6f);
    GAS unsigned long long* o8 = (GAS unsigned long long*)orow + lane;
#pragma unroll
    for (int j = 0; j < 4; ++j) o8[64 * j] = (unsigned long long)pk2(v[j].x * rs, v[j].y * rs) | ((unsigned long long)pk2(v[j].z * rs, v[j].w * rs) << 32);
}
__device__ __forceinline__ unsigned swz(int row, int bytecol, int stride) { return (unsigned)(row * stride + ((((bytecol >> 4) ^ (row & 7)) << 4) | (bytecol & 15))); }
__device__ __forceinline__ unsigned swzb(int row, int bytecol, int stride) { return (unsigned)(row * stride + ((((bytecol >> 4) ^ (((row & 3) << 1) | (row & 8))) << 4) | (bytecol & 15))); }
__device__ __forceinline__ bf16x8 fragb_row(const LAS unsigned char* img, int row0, int bytecol0, int stride, int fr, int fq) {
    return *(const LAS bf16x8*)(img + swzb(row0 + fr, bytecol0 + 16 * fq, stride));
}
__device__ __forceinline__ bf16x8 fragb_tr(const LAS unsigned char* img, int k0, int c0, int stride, int lane) {
    const int fq = lane >> 4, q = (lane & 15) >> 2, p = lane & 3;
    const s16x4 lo = __builtin_amdgcn_ds_read_tr16_b64_v4i16((LAS s16x4*)(img + swzb(k0 + 8 * fq + q, (c0 + 4 * p) * 2, stride)));
    const s16x4 hi = __builtin_amdgcn_ds_read_tr16_b64_v4i16((LAS s16x4*)(img + swzb(k0 + 8 * fq + 4 + q, (c0 + 4 * p) * 2, stride)));
    return (bf16x8){lo[0], lo[1], lo[2], lo[3], hi[0], hi[1], hi[2], hi[3]};
}
__device__ __forceinline__ bf16x8 frag_row(const LAS unsigned char* img, int row0, int bytecol0, int stride, int fr, int fq) {
    return *(const LAS bf16x8*)(img + swz(row0 + fr, bytecol0 + 16 * fq, stride));
}
__device__ __forceinline__ bf16x8 frag_tr2(const LAS unsigned char* img, int rowa, int rowb, int c0, int stride, int lane) {
    const int fq = lane >> 4, q = (lane & 15) >> 2, p = lane & 3;
    const s16x4 lo = __builtin_amdgcn_ds_read_tr16_b64_v4i16((LAS s16x4*)(img + swz(rowa + 4 * fq + q, (c0 + 4 * p) * 2, stride)));
    const s16x4 hi = __builtin_amdgcn_ds_read_tr16_b64_v4i16((LAS s16x4*)(img + swz(rowb + 4 * fq + q, (c0 + 4 * p) * 2, stride)));
    return (bf16x8){lo[0], lo[1], lo[2], lo[3], hi[0], hi[1], hi[2], hi[3]};
}
__device__ __forceinline__ bf16x8 frag_tr(const LAS unsigned char* img, int k0, int c0, int stride, int lane) {
    const int fq = lane >> 4; return frag_tr2(img, k0 + 4 * fq, k0 + 4 * fq + 4, c0, stride, lane);
}
#define MFMA16(a, b, c) __builtin_amdgcn_mfma_f32_16x16x32_bf16((a), (b), (c), 0, 0, 0)

__device__ __forceinline__ int xt4(int row) { return (0x1230 >> (((row >> 2) & 3) * 4)) & 3; }
__device__ __forceinline__ unsigned pnl(int row, int col, int PS) { return (unsigned)((col >> 5) * PS + row * 64 + (((((col & 31) >> 3)) ^ xt4(row)) << 4) + (col & 7) * 2); }
#define TRREAD(p) __builtin_amdgcn_ds_read_tr16_b64_v4i16((LAS s16x4*)(p))
__device__ __forceinline__ bf16x8 mk8(s16x4 lo, s16x4 hi) { return (bf16x8){lo[0], lo[1], lo[2], lo[3], hi[0], hi[1], hi[2], hi[3]}; }

__device__ __forceinline__ void retention_phase(LAS unsigned char* lds, const bf16* qg, const bf16* kg, bf16* vg, float* ssq, int G, int bx, const int tid, const bool dry = false) {
    const int lane = tid & 63, w = __builtin_amdgcn_readfirstlane(tid >> 6), fr = lane & 15, fq = lane >> 4, q4 = (lane & 15) >> 2, p4 = lane & 3;
    const int tq = w & 3, hv = w >> 2;
    LAS unsigned char* QI = lds; LAS unsigned char* KI = lds + 32768; LAS unsigned char* VI = lds + 65536; LAS unsigned char* PI = lds + 81920; LAS unsigned char* ZI = lds + 90112;
    const unsigned LBr = (unsigned)(fr * 64 + ((fq ^ xt4(fr)) << 4));
    const unsigned TB1 = (unsigned)((8 * fq + q4) * 64 + (((p4 >> 1) ^ xt4(8 * fq + q4)) << 4) + 8 * (p4 & 1));
    const unsigned TB2 = (unsigned)((8 * fq + 4 + q4) * 64 + (((p4 >> 1) ^ xt4(8 * fq + 4 + q4)) << 4) + 8 * (p4 & 1));
    const unsigned LBz = (unsigned)(fr * 64 + (((2 * (w & 1) + (fq >> 1)) ^ xt4(fr)) << 4) + 8 * (fq & 1) + (w >> 1) * 16384);
    const unsigned LBp = (unsigned)(fr * 64 + (((fq >> 1) ^ xt4(fr)) << 4) + 8 * (fq & 1) + hv * 4096 + tq * 1024);
    const unsigned TW1 = TB1 ^ ((w & 1) * 32), TW2 = TB2 ^ ((w & 1) * 32);
    for (int u = bx; u < 256; u += G) {
        const int b = u >> 4, h = (u >> 2) & 3, vs = u & 3;
        const float g64 = __builtin_amdgcn_exp2f(64.0f * head_l2g(h));
        f32x4 Z[16];
#pragma unroll
        for (int i = 0; i < 16; ++i) Z[i] = (f32x4){0.f, 0.f, 0.f, 0.f};
        u32x4 pq[4], pk[4], pv[2];
        const bf16* qh = qg + (size_t)b * SEQ * 1024 + h * 256; const bf16* kh = kg + (size_t)b * SEQ * 1024 + h * 256;
        bf16* vh = vg + (size_t)b * SEQ * 2048 + h * 512 + vs * 128;
#define RET_LOAD(sc) do { _Pragma("unroll") for (int i = 0; i < 4; ++i) { const int pid = tid + 512 * i, r = pid >> 5, c = pid & 31; \
            pq[i] = *(const u32x4*)(qh + (size_t)((sc) * 64 + r) * 1024 + c * 8); pk[i] = *(const u32x4*)(kh + (size_t)((sc) * 64 + r) * 1024 + c * 8); } \
        _Pragma("unroll") for (int i = 0; i < 2; ++i) { const int pid = tid + 512 * i, r = pid >> 4, c = pid & 15; pv[i] = *(const u32x4*)(vh + (size_t)((sc) * 64 + r) * 2048 + c * 8); } } while (0)
        RET_LOAD(0);
        for (int sc = 0; sc < 32; ++sc) {
            LDS_BARRIER();
#pragma unroll
            for (int i = 0; i < 4; ++i) { const int pid = tid + 512 * i, r = pid >> 5, c = pid & 31; const unsigned o = pnl(r, 8 * c, 4096); *(LAS u32x4*)(QI + o) = pq[i]; *(LAS u32x4*)(KI + o) = pk[i]; }
#pragma unroll
            for (int i = 0; i < 2; ++i) { const int pid = tid + 512 * i, r = pid >> 4, c = pid & 15; *(LAS u32x4*)(VI + pnl(r, 8 * c, 4096)) = pv[i]; }
#pragma unroll
            for (int dt = 0; dt < 16; ++dt) { u32x2 zz; zz.x = cvt_pk_bf16(Z[dt][0], Z[dt][1]); zz.y = cvt_pk_bf16(Z[dt][2], Z[dt][3]); *(LAS u32x2*)(ZI + LBz + dt * 1024) = zz; }
#ifndef RET_EXP
#define RET_EXP 0
#endif
            if (sc + 1 < 32 && !(RET_EXP & 16)) RET_LOAD(sc + 1);
            LDS_BARRIER();
            const LAS unsigned char* qrow = QI + LBr + tq * 1024;
#pragma unroll
            for (int mi = 0; mi < 2; ++mi) { const int mt = 2 * hv + mi; f32x4 s = (f32x4){0.f, 0.f, 0.f, 0.f};
                if (mt <= tq) { const LAS unsigned char* krow = KI + LBr + mt * 1024;
#pragma unroll
                    for (int ks = 0; ks < 8; ++ks) s = MFMA16(*(const LAS bf16x8*)(krow + ks * 4096), *(const LAS bf16x8*)(qrow + ks * 4096), s);
                    if (mt == tq) {
#pragma unroll
                        for (int r = 0; r < 4; ++r) if (4 * fq + r > fr) s[r] = 0.f; }
                }
                u32x2 pp; pp.x = cvt_pk_bf16(s[0], s[1]); pp.y = cvt_pk_bf16(s[2], s[3]); *(LAS u32x2*)(PI + (LBp ^ (mi * 32))) = pp; }
            bf16x8 va[2];
            if (!(RET_EXP & 1)) {
#pragma unroll
            for (int k2 = 0; k2 < 2; ++k2) va[k2] = mk8(TRREAD(VI + TW1 + (w >> 1) * 4096 + k2 * 2048), TRREAD(VI + TW2 + (w >> 1) * 4096 + k2 * 2048));
#define RET_KB(dt, k2) mk8(TRREAD(KI + (TB1 ^ (((dt) & 1) * 32)) + ((dt) >> 1) * 4096 + (k2) * 2048), TRREAD(KI + (TB2 ^ (((dt) & 1) * 32)) + ((dt) >> 1) * 4096 + (k2) * 2048))
            {
#pragma unroll
              for (int dt = 0; dt < 16; ++dt) { const bf16x8 c0 = RET_KB(dt, 0), c1 = RET_KB(dt, 1);
                  Z[dt] = Z[dt] * g64; Z[dt] = MFMA16(va[0], c0, Z[dt]); Z[dt] = MFMA16(va[1], c1, Z[dt]); }
              __builtin_amdgcn_sched_group_barrier(0x100, 8, 0);
#pragma unroll
              for (int i = 0; i < 14; ++i) { __builtin_amdgcn_sched_group_barrier(0x008, 2, 0); __builtin_amdgcn_sched_group_barrier(0x100, 4, 0); }
#pragma unroll
              for (int i = 0; i < 2; ++i) __builtin_amdgcn_sched_group_barrier(0x008, 2, 0);
            }
#undef RET_KB
            }
            f32x4 o[4];
#pragma unroll
            for (int vt = 0; vt < 4; ++vt) o[vt] = (f32x4){0.f, 0.f, 0.f, 0.f};
            if (!(RET_EXP & 2)) {
#define RET_ZA(vt, ks) mk8(TRREAD(ZI + (TB1 ^ (((vt) & 1) * 32)) + (2 * hv + ((vt) >> 1)) * 16384 + (ks) * 2048), TRREAD(ZI + (TB2 ^ (((vt) & 1) * 32)) + (2 * hv + ((vt) >> 1)) * 16384 + (ks) * 2048))
            {
#pragma unroll
              for (int ks = 0; ks < 8; ++ks) { const bf16x8 cq = *(const LAS bf16x8*)(qrow + ks * 4096);
#pragma unroll
                  for (int vt = 0; vt < 4; ++vt) o[vt] = MFMA16(RET_ZA(vt, ks), cq, o[vt]); }
              __builtin_amdgcn_sched_group_barrier(0x100, 9, 0);
#pragma unroll
              for (int i = 0; i < 7; ++i) { __builtin_amdgcn_sched_group_barrier(0x008, 4, 0); __builtin_amdgcn_sched_group_barrier(0x100, 9, 0); }
              __builtin_amdgcn_sched_group_barrier(0x008, 4, 0);
            }
#undef RET_ZA
            }
            LDS_BARRIER();
#pragma unroll
            for (int vt = 0; vt < 4; ++vt) o[vt] = o[vt] * g64;
#pragma unroll
            for (int k2 = 0; k2 < 2; ++k2) if (32 * k2 <= 16 * tq + 15) { const bf16x8 pb = *(const LAS bf16x8*)(PI + LBr + tq * 1024 + k2 * 4096);
#pragma unroll
                for (int vt = 0; vt < 4; ++vt) o[vt] = MFMA16(mk8(TRREAD(VI + (TB1 ^ ((vt & 1) * 32)) + (2 * hv + (vt >> 1)) * 4096 + k2 * 2048), TRREAD(VI + (TB2 ^ ((vt & 1) * 32)) + (2 * hv + (vt >> 1)) * 4096 + k2 * 2048)), pb, o[vt]); }
            const int tokl = sc * 64 + 16 * tq + fr; float ss = 0.f;
#pragma unroll
            for (int vt = 0; vt < 4; ++vt) ss += (o[vt][0] * o[vt][0] + o[vt][1] * o[vt][1]) + (o[vt][2] * o[vt][2] + o[vt][3] * o[vt][3]);
#pragma unroll
            for (int vp = 0; vp < 2; ++vp) {
                unsigned x0 = cvt_pk_bf16(o[2 * vp][0], o[2 * vp][1]), x1 = cvt_pk_bf16(o[2 * vp][2], o[2 * vp][3]), y0 = cvt_pk_bf16(o[2 * vp + 1][0], o[2 * vp + 1][1]), y1 = cvt_pk_bf16(o[2 * vp + 1][2], o[2 * vp + 1][3]);
                const auto s0 = __builtin_amdgcn_permlane16_swap(x0, y0, false, false), s1 = __builtin_amdgcn_permlane16_swap(x1, y1, false, false);
                u32x4 ww; ww.x = s0[0]; ww.y = s1[0]; ww.z = s0[1]; ww.w = s1[1];
                if (!dry) *(u32x4*)(vh + (size_t)tokl * 2048 + 16 * (4 * hv + 2 * vp + (fq & 1)) + 4 * (fq & ~1)) = ww; }
            ss = xsum32(xsum16(ss));
            if (fq == 0 && !dry) ssq[(((size_t)(b * SEQ + tokl) * 4 + h) * 4 + vs) * 2 + hv] = ss;
        }
#undef RET_LOAD
        LDS_BARRIER();
    }
}

__device__ __forceinline__ int t5_bucket(int n) { if (n < 16) return n; const int l = 16 + (int)(__builtin_log2f((float)n * 0.0625f) * (16.0f / 7.0f)); return l > 31 ? 31 : l; }
__device__ __forceinline__ void attn_phase(LAS unsigned char* lds, bf16* qb, const bf16* kb, const bf16* vb, f32x2* ml, const float* rel_bias, int G, int bx, const int tid, const bool dry = false) {
    const int lane = tid & 63, w = __builtin_amdgcn_readfirstlane(tid >> 6), fr = lane & 15, fq = lane >> 4, q4 = (lane & 15) >> 2, p4 = lane & 3;
    LAS unsigned char* KI = lds; LAS unsigned char* VI = lds + 32768; LAS float* BT = (LAS float*)(lds + 65536);
    const unsigned LBr = (unsigned)(fr * 64 + ((fq ^ xt4(fr)) << 4));
    const unsigned TBa = (unsigned)((4 * fq + q4) * 64 + (((p4 >> 1) ^ xt4(4 * fq + q4)) << 4) + 8 * (p4 & 1));
    const LAS float* btl = BT + (fr + 144 - 4 * fq);
    for (int unit = bx; unit < 1536; unit += G) {
        const int u4 = unit & 3, g = (unit >> 2) % 3, rest = unit / 12, h = rest & 15, bl = rest >> 4;
        const int R = g == 0 ? 1 : (g == 1 ? 4 : 16);
        LDS_BARRIER();
        if (tid < 160) { const int steps = tid - 16; BT[tid] = (steps >= 0 && steps <= 128) ? rel_bias[t5_bucket(steps * R) * 48 + g * 16 + h] * 1.4426950408889634f : -1e30f; }
        LDS_BARRIER();
        float bias[36];
#pragma unroll
        for (int j = 0; j < 9; ++j)
#pragma unroll
            for (int rr = 0; rr < 4; ++rr) bias[4 * j + rr] = btl[-16 * j - rr];
        const int s_first = (g == 0 && u4 > 0) ? -1 : 0;
        const size_t sl = ((size_t)(bl * 3 + g) * 16 + h) * (SEQ * 64);
        const bf16* kbase = kb + sl; const bf16* vbase = vb + sl; bf16* qbase = qb + sl;
        const int LR = SEQ / R;
        u32x4 pk[2], pv[2]; bf16x8 qn[2];
#define ATT_SEG(s, r, n) do { if (g == 0) { r = 0; n = 4 * u4 + (s); } else if (g == 1) { r = u4; n = (s); } else { r = 4 * u4 + (s); n = 0; } } while (0)
#define ATT_LOAD(s) do { int r_, n_; ATT_SEG(s, r_, n_); _Pragma("unroll") for (int i = 0; i < 2; ++i) { const int pid = tid + 512 * i, row = pid >> 3, c = pid & 7; \
            const size_t off = (size_t)(r_ * LR + 128 * n_ + row) * 64 + c * 8; pk[i] = *(const u32x4*)(kbase + off); pv[i] = *(const u32x4*)(vbase + off); } \
            if ((s) >= 0) { const bf16* qp_ = qbase + (size_t)(r_ * LR + 128 * n_ + 16 * w + fr) * 64 + fq * 8; qn[0] = *(const bf16x8*)qp_; qn[1] = *(const bf16x8*)(qp_ + 32); } } while (0)
        ATT_LOAD(s_first);
        int cnt = 0;
        for (int s = s_first; s < 4; ++s, ++cnt) {
            LDS_BARRIER();
            const int cs = cnt & 1, ps = cs ^ 1;
#pragma unroll
            for (int i = 0; i < 2; ++i) { const int pid = tid + 512 * i, row = pid >> 3, c = pid & 7; const unsigned o = pnl(cs * 128 + row, 8 * c, 16384); *(LAS u32x4*)(KI + o) = pk[i]; *(LAS u32x4*)(VI + o) = pv[i]; }
            bf16x8 qf[2]; qf[0] = qn[0]; qf[1] = qn[1];
            if (s < 3) ATT_LOAD(s + 1);
            LDS_BARRIER();
            if (s < 0) continue;
            int r, n; ATT_SEG(s, r, n);
            const bool has_prev = n > 0;
            const size_t grow = (size_t)bl * SEQ + (size_t)(128 * n + 16 * w + fr) * R + r;
            bf16* qptr = qbase + (size_t)(r * LR + 128 * n + 16 * w + fr) * 64;
            f32x4 sc[9]; float mx = -1e30f;
            { bf16x8 kf[9][2];
#pragma unroll
              for (int j = 0; j < 9; ++j) { const int kt = w + j; const int rb = (kt < 8) ? (has_prev ? ps * 128 + 16 * kt : cs * 128 + 16 * kt) : cs * 128 + 16 * (kt - 8);
                  const LAS unsigned char* kr = KI + LBr + rb * 64; kf[j][0] = *(const LAS bf16x8*)kr; kf[j][1] = *(const LAS bf16x8*)(kr + 16384); }
#pragma unroll
              for (int j = 0; j < 9; ++j) { f32x4 a = (f32x4){0.f, 0.f, 0.f, 0.f}; a = MFMA16(kf[j][0], qf[0], a); a = MFMA16(kf[j][1], qf[1], a); sc[j] = a; } }
#pragma unroll
            for (int j = 0; j < 9; ++j) { const bool valid = has_prev || (w + j) >= 8;
#pragma unroll
                for (int rr = 0; rr < 4; ++rr) { const float v = valid ? sc[j][rr] + bias[4 * j + rr] : -1e30f; sc[j][rr] = v; mx = fmaxf(mx, v); } }
            mx = xmax32(xmax16(mx));
            float lsum = 0.f;
#pragma unroll
            for (int j = 0; j < 9; ++j)
#pragma unroll
                for (int rr = 0; rr < 4; ++rr) { const float p = __builtin_amdgcn_exp2f(sc[j][rr] - mx); sc[j][rr] = p; lsum += p; }
            lsum = xsum32(xsum16(lsum));
            f32x4 o[4];
#pragma unroll
            for (int dt = 0; dt < 4; ++dt) o[dt] = (f32x4){0.f, 0.f, 0.f, 0.f};
#pragma unroll
            for (int jj = 0; jj < 5; ++jj) { const int t0 = 2 * jj, t1 = 2 * jj + 1;
                union { bf16x8 v; unsigned u[4]; } pb;
                pb.u[0] = cvt_pk_bf16(sc[t0][0], sc[t0][1]); pb.u[1] = cvt_pk_bf16(sc[t0][2], sc[t0][3]);
                if (t1 < 9) { pb.u[2] = cvt_pk_bf16(sc[t1 < 9 ? t1 : 8][0], sc[t1 < 9 ? t1 : 8][1]); pb.u[3] = cvt_pk_bf16(sc[t1 < 9 ? t1 : 8][2], sc[t1 < 9 ? t1 : 8][3]); } else { pb.u[2] = 0u; pb.u[3] = 0u; }
                int kt0 = w + t0, kt1 = w + t1; if (kt1 > 15) kt1 = 15;
                const bool v0 = has_prev || kt0 >= 8, v1 = has_prev || kt1 >= 8;
                const int rb0 = (kt0 < 8) ? (v0 ? ps * 128 + 16 * kt0 : cs * 128 + 16 * kt0) : cs * 128 + 16 * (kt0 - 8);
                const int rb1 = (kt1 < 8) ? (v1 ? ps * 128 + 16 * kt1 : cs * 128 + 16 * kt1) : cs * 128 + 16 * (kt1 - 8);
                const LAS unsigned char* va = VI + rb0 * 64; const LAS unsigned char* vb2 = VI + rb1 * 64;
#pragma unroll
                for (int dt = 0; dt < 4; ++dt) o[dt] = MFMA16(mk8(TRREAD(va + (TBa ^ ((dt & 1) * 32)) + (dt >> 1) * 16384), TRREAD(vb2 + (TBa ^ ((dt & 1) * 32)) + (dt >> 1) * 16384)), pb.v, o[dt]); }
            const float il = 1.0f / lsum;
#pragma unroll
            for (int dp = 0; dp < 2; ++dp) {
                unsigned x0 = cvt_pk_bf16(o[2 * dp][0] * il, o[2 * dp][1] * il), x1 = cvt_pk_bf16(o[2 * dp][2] * il, o[2 * dp][3] * il);
                unsigned y0 = cvt_pk_bf16(o[2 * dp + 1][0] * il, o[2 * dp + 1][1] * il), y1 = cvt_pk_bf16(o[2 * dp + 1][2] * il, o[2 * dp + 1][3] * il);
                const auto s0 = __builtin_amdgcn_permlane16_swap(x0, y0, false, false), s1 = __builtin_amdgcn_permlane16_swap(x1, y1, false, false);
                u32x4 ww; ww.x = s0[0]; ww.y = s1[0]; ww.z = s0[1]; ww.w = s1[1];
                if (!dry) *(u32x4*)(qptr + 16 * (2 * dp + (fq & 1)) + 4 * (fq & ~1)) = ww; }
            if (fq == 0 && !dry) ml[(grow * 3 + g) * 16 + h] = (f32x2){mx, lsum};
        }
#undef ATT_SEG
#undef ATT_LOAD
    }
    LDS_BARRIER();
}
__device__ __forceinline__ void merge_phase(const bf16* qb, const f32x2* ml, bf16* out, int G, int bx, const int tid) {
    const size_t nitems = (size_t)TC * 16 * 8;
    for (size_t it = (size_t)bx * 512 + tid; it < nitems; it += (size_t)G * 512) {
        const int pc = (int)(it & 7), h = (int)((it >> 3) & 15); const size_t tok = it >> 7; const int bl = (int)(tok >> 11), t = (int)(tok & (SEQ - 1));
        f32x2 a[3]; float M = -3e38f;
#pragma unroll
        for (int g = 0; g < 3; ++g) { a[g] = ml[(tok * 3 + g) * 16 + h]; M = fmaxf(M, a[g].x); }
        float wg[3], W = 0.f;
#pragma unroll
        for (int g = 0; g < 3; ++g) { wg[g] = __builtin_amdgcn_exp2f(a[g].x - M) * a[g].y; W += wg[g]; }
        const float iw = 1.0f / W; float acc[8];
#pragma unroll
        for (int e = 0; e < 8; ++e) acc[e] = 0.f;
#pragma unroll
        for (int g = 0; g < 3; ++g) { const int sh = g == 0 ? 0 : (g == 1 ? 2 : 4), pos = (t & ((1 << sh) - 1)) * (SEQ >> sh) + (t >> sh);
            const u32x4 o = *(const u32x4*)(qb + (((size_t)(bl * 3 + g) * 16 + h) * SEQ + pos) * 64 + pc * 8); const float ww = wg[g] * iw;
            acc[0] += ww * bf_lo(o.x); acc[1] += ww * bf_hi(o.x); acc[2] += ww * bf_lo(o.y); acc[3] += ww * bf_hi(o.y); acc[4] += ww * bf_lo(o.z); acc[5] += ww * bf_hi(o.z); acc[6] += ww * bf_lo(o.w); acc[7] += ww * bf_hi(o.w); }
        u32x4 r; r.x = cvt_pk_bf16(acc[0], acc[1]); r.y = cvt_pk_bf16(acc[2], acc[3]); r.z = cvt_pk_bf16(acc[4], acc[5]); r.w = cvt_pk_bf16(acc[6], acc[7]);
        *(u32x4*)(out + tok * 1024 + h * 64 + pc * 8) = r;
    }
}
__device__ __forceinline__ void router_phase(LAS unsigned char* lds, const bf16* wrh, const bf16* wrl, const float* bg, const float* be, const bf16* hb, int* list, float* gatew, unsigned* cnt, int G, int vcu, const int tid) {
    const int lane = tid & 63, w = __builtin_amdgcn_readfirstlane(tid >> 6), fr = lane & 15, fq = lane >> 4;
    LAS unsigned char* WH = lds; LAS unsigned char* WL = lds + 49152; LAS float* LG = (LAS float*)(lds + 98304 + w * 3072);
    const int nround = (T / 16 + G * NWAVES - 1) / (G * NWAVES);
    LAS unsigned* BC = (LAS unsigned*)(lds + 122880); LAS unsigned* BB = BC + 32;
    for (int rd = 0; rd < nround; ++rd) {
        const int mt = rd * G * NWAVES + vcu * NWAVES + w; const bool active = mt < T / 16;
        if (tid < 32) BC[tid] = 0u;
        int b0 = 0, b1 = 0; unsigned l0 = 0u, l1 = 0u; float gw0 = 0.f, gw1 = 0.f, rsk = 0.f;
        f32x4 acc[3]; float ss = 0.f;
#pragma unroll
        for (int i = 0; i < 3; ++i) acc[i] = (f32x4){0.f, 0.f, 0.f, 0.f};
        for (int kh = 0; kh < 2; ++kh) {
            LDS_BARRIER();
#pragma unroll
            for (int i = 0; i < 6; ++i) { const int pid = tid + 512 * i, row = pid >> 6, c = pid & 63;
                *(LAS u32x4*)(WH + swzb(row, c * 16, 1024)) = *(const u32x4*)(wrh + (size_t)row * 1024 + kh * 512 + c * 8);
                *(LAS u32x4*)(WL + swzb(row, c * 16, 1024)) = *(const u32x4*)(wrl + (size_t)row * 1024 + kh * 512 + c * 8); }
            LDS_BARRIER();
            if (active) {
                const bf16* hp = hb + (size_t)(mt * 16 + fr) * D + kh * 512 + 8 * fq;
                union { bf16x8 v; u32x4 u; } ah[16];
#pragma unroll
                for (int ks = 0; ks < 16; ++ks) ah[ks].u = *(const GAS u32x4*)(hp + 32 * ks);
#pragma unroll
                for (int ks = 0; ks < 16; ++ks) {
                    { const u32x4 a = ah[ks].u; const float a0 = bf_lo(a.x), a1 = bf_hi(a.x), a2 = bf_lo(a.y), a3 = bf_hi(a.y), a4 = bf_lo(a.z), a5 = bf_hi(a.z), a6 = bf_lo(a.w), a7 = bf_hi(a.w);
                      ss += ((a0 * a0 + a1 * a1) + (a2 * a2 + a3 * a3)) + ((a4 * a4 + a5 * a5) + (a6 * a6 + a7 * a7)); }
#pragma unroll
                    for (int nt = 0; nt < 3; ++nt) { const bf16x8 bh = fragb_row(WH, 16 * nt, ks * 64, 1024, fr, fq), bl = fragb_row(WL, 16 * nt, ks * 64, 1024, fr, fq);
                        acc[nt] = MFMA16(ah[ks].v, bh, acc[nt]); acc[nt] = MFMA16(ah[ks].v, bl, acc[nt]); }
                }
            }
        }
        if (active) {
            ss = xsum32(xsum16(ss));
            const float rs = __builtin_amdgcn_rsqf(ss * (1.f / D) + 1e-6f);
#pragma unroll
            for (int nt = 0; nt < 3; ++nt)
#pragma unroll
                for (int r = 0; r < 4; ++r) LG[(4 * fq + r) * 48 + 16 * nt + fr] = acc[nt][r];
            LDS_WAIT(); asm volatile("" ::: "memory");
            if (lane < 16) {
                const int tk = mt * 16 + lane; float a[36];
#pragma unroll
                for (int q = 0; q < 9; ++q) { const f32x4 t4 = *(const LAS f32x4*)(LG + lane * 48 + 4 * q); a[4 * q] = t4[0] * rs; a[4 * q + 1] = t4[1] * rs; a[4 * q + 2] = t4[2] * rs; a[4 * q + 3] = t4[3] * rs; }
                float gl[4];
#pragma unroll
                for (int g = 0; g < 4; ++g) gl[g] = a[g] + bg[g];
                int grp = 0; float gbest = gl[0];
#pragma unroll
                for (int g = 1; g < 4; ++g) if (gl[g] > gbest) { gbest = gl[g]; grp = g; }
                float den = 0.f;
#pragma unroll
                for (int g = 0; g < 4; ++g) den += __expf(gl[g] - gbest);
                const float pg = 1.0f / den;
                float el[8];
#pragma unroll
                for (int e = 0; e < 8; ++e) { float vv = 0.f;
#pragma unroll
                    for (int g = 0; g < 4; ++g) if (g == grp) vv = a[4 + g * 8 + e] + be[g * 8 + e];
                    el[e] = vv; }
                int i0 = 0; float v0 = el[0];
#pragma unroll
                for (int e = 1; e < 8; ++e) if (el[e] > v0) { v0 = el[e]; i0 = e; }
                int i1 = -1; float v1 = -3.0e38f;
#pragma unroll
                for (int e = 0; e < 8; ++e) if (e != i0 && (i1 < 0 || el[e] > v1)) { v1 = el[e]; i1 = e; }
                const float e1 = __expf(v1 - v0); const float g0 = 1.0f / (1.0f + e1), g1 = e1 / (1.0f + e1);
                b0 = grp * 8 + i0; b1 = grp * 8 + i1;
                l0 = __hip_atomic_fetch_add(BC + b0, 1u, __ATOMIC_RELAXED, __HIP_MEMORY_SCOPE_WORKGROUP);
                l1 = __hip_atomic_fetch_add(BC + b1, 1u, __ATOMIC_RELAXED, __HIP_MEMORY_SCOPE_WORKGROUP);
                gw0 = g0 * pg; gw1 = g1 * pg; rsk = rs;
            }
        }
        LDS_BARRIER();
        if (tid < 32) { const unsigned c = BC[tid]; BB[tid] = c ? __hip_atomic_fetch_add(cnt + tid * 64, c, __ATOMIC_RELAXED, __HIP_MEMORY_SCOPE_AGENT) : 0u; }
        LDS_BARRIER();
        if (active && lane < 16) {
            const int tk = mt * 16 + lane; const unsigned p0 = BB[b0] + l0, p1 = BB[b1] + l1;
            list[(size_t)b0 * T + p0] = tk; list[(size_t)b1 * T + p1] = tk;
            gatew[tk * 2] = gw0; gatew[tk * 2 + 1] = gw1;
            float* rsl = (float*)((char*)list - (WS_LIST - WS_ML)); rsl[(size_t)b0 * T + p0] = rsk; rsl[(size_t)b1 * T + p1] = rsk;
            unsigned* binpos = (unsigned*)(gatew + 2 * T); binpos[tk * 2] = ((unsigned)b0 << 16) | p0; binpos[tk * 2 + 1] = ((unsigned)b1 << 16) | p1;
        }
    }
    LDS_BARRIER();
}
struct Args { const float* in[19]; float* out; unsigned char* ws; int ph_lo, ph_hi, flags, pad; };
enum { IN_X = 0, IN_RET_WIN, IN_RET_WOUT, IN_KV_NORM, IN_W_KV, IN_K_NORM, IN_DIL_WQ, IN_Q_NORM, IN_DIL_WO, IN_REL_BIAS, IN_MIXER_NORM, IN_FFN_NORM, IN_RGRP, IN_RGRP_B, IN_REXP, IN_REXP_B, IN_EGATE, IN_EUP, IN_EDOWN };
constexpr int NPHASE = 24;
#ifndef MK_PHMASK
#define MK_PHMASK 0xffffffu
#endif
struct PhaseCtx { int tid, lane, wave, G, bx, vcu, gw, NGW; unsigned char* ws; float* hout; };
__device__ __forceinline__ PhaseCtx phase_ctx(const Args& args, int wave_s) {
    PhaseCtx c; int tid = (wave_s << 6) | lane_id(), bx = blockIdx.x, G = gridDim.x;
    GAS unsigned char* wsg = (GAS unsigned char*)args.ws; GAS float* hg = (GAS float*)args.out;
    asm volatile("" : "+v"(tid), "+s"(bx), "+s"(G), "+s"(wsg), "+s"(hg));
    unsigned char* ws = (unsigned char*)wsg; float* hout = (float*)hg;
    c.tid = tid; c.lane = tid & 63; c.wave = __builtin_amdgcn_readfirstlane(tid >> 6); c.G = G; c.bx = bx; c.vcu = (G % 8 == 0) ? (bx % 8) * (G / 8) + bx / 8 : bx;
    c.gw = c.vcu * NWAVES + c.wave; c.NGW = G * NWAVES; c.ws = ws; c.hout = hout; return c;
}
__device__ __forceinline__ void pro_s1(const Args& args, const PhaseCtx& c, LAS unsigned char* lds) {
    unsigned char* ws = c.ws; LAS float* scr = (LAS float*)(lds + c.wave * 16640); const int gw = c.gw, NGW = c.NGW, lane = c.lane;
    bf16* xn = (bf16*)(ws + WS_XN); const float* x = args.in[IN_X];
    transpose_matrix(args.in[IN_RET_WIN], 1024, 6144, (bf16*)(ws + WS_WIN), scr, gw, NGW, lane, args.in[IN_MIXER_NORM], MapWin{});
    for (int m = gw; m < T; m += NGW) rms_row_to_bf16(x + (size_t)m * D, xn + (size_t)m * D, lane);
}
__device__ __forceinline__ void pro_wout(const Args& args, const PhaseCtx& c, LAS unsigned char* lds) {
    LAS float* scr = (LAS float*)(lds + c.wave * 16640);
    transpose_matrix(args.in[IN_RET_WOUT], 2048, 1024, (bf16*)(c.ws + WS_WOUT), scr, c.gw, c.NGW, c.lane, nullptr, MapId{0});
}
__device__ __forceinline__ void pro_moe(const Args& args, const PhaseCtx& c, LAS unsigned char* lds, int L) {
    unsigned char* ws = c.ws; LAS float* scr = (LAS float*)(lds + c.wave * 16640); const int gw = c.gw, NGW = c.NGW, lane = c.lane;
    bf16* wgu = (bf16*)(ws + (L ? WS_WGU1 : WS_WGU0)); bf16* wd = (bf16*)(ws + (L ? WS_WD1 : WS_WD0));
    const float* gain = args.in[IN_FFN_NORM] + L * D;
    auto src_of = [&](int it, const float*& W, int& N, int& item) { const int e = it / 384, r = it % 384, which = r >> 7; item = r & 127; const size_t eo = (size_t)(L * NEXP + e);
        if (which == 0) { W = args.in[IN_EGATE] + eo * D * FF; N = FF; } else if (which == 1) { W = args.in[IN_EUP] + eo * D * FF; N = FF; } else { W = args.in[IN_EDOWN] + eo * FF * D; N = D; } };
    if (gw < NEXP * 384) {
        f32x4 v[16]; { const float* W; int N, item; src_of(gw, W, N, item); transpose_load(W, N, item, lane, v); }
        for (int it = gw; it < NEXP * 384; it += NGW) { f32x4 cur[16];
#pragma unroll
            for (int i = 0; i < 16; ++i) cur[i] = v[i];
            if (it + NGW < NEXP * 384) { const float* W; int N, item; src_of(it + NGW, W, N, item); transpose_load(W, N, item, lane, v); }
            const int e = it / 384, r = it % 384, which = r >> 7, item = r & 127;
            if (which == 0) transpose_finish(cur, FF, wgu + (size_t)e * 1024 * 1024, 1024, scr, item, lane, gain, MapGu{0});
            else if (which == 1) transpose_finish(cur, FF, wgu + (size_t)e * 1024 * 1024, 1024, scr, item, lane, gain, MapGu{1});
            else transpose_finish(cur, D, wd + (size_t)e * 1024 * 512, 512, scr, item, lane, (const float*)nullptr, MapId{0}); }
    }
    bf16* wrh = (bf16*)(ws + WS_WR) + (size_t)L * 48 * 1024; bf16* wrl = (bf16*)(ws + WS_WR + 196608) + (size_t)L * 48 * 1024;
    for (int i = gw * 64 + lane; i < 48 * 1024; i += NGW * 64) { const int n = i >> 10, k = i & 1023;
        const float wv = n < 36 ? gain[k] * (n < 4 ? args.in[IN_RGRP][((size_t)L * D + k) * 4 + n] : args.in[IN_REXP][((size_t)L * D + k) * 32 + (n - 4)]) : 0.0f;
        const unsigned hi = f2bf(wv); const float rem = wv - __builtin_bit_cast(float, hi << 16); wrh[i] = (bf16)hi; wrl[i] = (bf16)f2bf(rem); }
}
__device__ __forceinline__ void pro_s3(const Args& args, const PhaseCtx& c, LAS unsigned char* lds) {
    unsigned char* ws = c.ws; LAS float* scr = (LAS float*)(lds + c.wave * 16640); const int gw = c.gw, NGW = c.NGW, lane = c.lane;
    transpose_matrix(args.in[IN_DIL_WQ], 1024, 3072, (bf16*)(ws + WS_WQKV1), scr, gw, NGW, lane, args.in[IN_MIXER_NORM] + D, MapQkv1{0});
    transpose_matrix(args.in[IN_W_KV], 1024, 6144, (bf16*)(ws + WS_WQKV1), scr, gw, NGW, lane, args.in[IN_KV_NORM], MapQkv1{3072});
    transpose_matrix(args.in[IN_DIL_WO], 1024, 1024, (bf16*)(ws + WS_WO1), scr, gw, NGW, lane, nullptr, MapId{0});
    if (gw == 0) { float* gt = (float*)(ws + WS_WR + 512 * 1024); for (int i = lane; i < 192; i += 64) { gt[i] = args.in[IN_Q_NORM][i]; gt[192 + i] = args.in[IN_K_NORM][i]; } }
}

__global__ void __launch_bounds__(NWAVES * 64, 2) mk_fwd(Args args) {
    extern __shared__ __attribute__((aligned(16))) unsigned char lds_raw[];
    LAS unsigned char* lds = (LAS unsigned char*)lds_raw;
    volatile LAS unsigned* MISC = (volatile LAS unsigned*)(lds + LDS_MISC);
    LAS int* TAB = (LAS int*)(lds + LDS_MISC + 64);
    const int wave_s = __builtin_amdgcn_readfirstlane(threadIdx.x >> 6);
    if (threadIdx.x < 4) MISC[threadIdx.x] = 0u;
    __syncthreads();
    XcdBarrier bar = xcd_barrier_post((unsigned*)(args.ws + WS_CTL) + CW_BAR, MISC, threadIdx.x == 0);
    int lo = args.ph_lo, hi = args.ph_hi, flg = args.flags;
#define RELAUNDER() asm volatile("" : "+s"(lo), "+s"(hi), "+s"(flg))
#define fullpro ((flg & 1) != 0)
#ifdef MK_REPEAT
#define GEMM_RUN(p) do { if (rep_now) gemm_phase(lds, p, c.tid, (flg & 1) != 0); gemm_phase(lds, p, c.tid); } while (0)
#else
#ifndef MK_STAGGER
#define MK_STAGGER 0
#endif
#define GEMM_RUN(p) gemm_phase(lds, p, c.tid, false, MK_STAGGER)
#endif
#ifdef MK_REPEAT
#define MK_REPEAT_K MK_REPEAT
#else
#define MK_REPEAT_K (-1)
#endif
#define IN(k) ((((MK_PHMASK) >> (k)) & 1u) && lo <= (k) && (k) < hi)
#ifdef MK_STAMP
#define STAMP(i) do { if (blockIdx.x == 0 && wave_s == 0 && lane_id() == 0) ((volatile LAS unsigned long long*)(lds + LDS_MISC + 3072))[i] = __builtin_amdgcn_s_memrealtime(); } while (0)
#else
#define STAMP(i) do { } while (0)
#endif
#define SEAM(k) do { asm volatile("; SEAM_MARK %0" :: "n"(k)); if (IN(k) && IN((k) + 1)) xcd_barrier(bar, wave_s); STAMP((k) + 1); } while (0)

    STAMP(0);
    if (IN(0)) { const PhaseCtx c = phase_ctx(args, wave_s); pro_s1(args, c, lds); if (!fullpro) pro_wout(args, c, lds); }
    SEAM(0);
    if (IN(1)) {
#pragma unroll 1
        for (int part = 0; part < 2; ++part) {
            RELAUNDER();
            { const bool rep_now = (MK_REPEAT_K == 1); const PhaseCtx c = phase_ctx(args, wave_s); unsigned char* ws = c.ws;
              P_QKV0 p; p.A = (const char*)(ws + WS_XN); p.Bt = (const char*)(ws + WS_WIN); p.lda = 2048; p.ldb = 2048; p.K = 1024; p.so.init(T, 4096, c.G, c.bx);
              p.qk = (bf16*)(ws + WS_Q0); p.v = (bf16*)(ws + WS_V0); p.cs = (const float*)(ws + WS_COS); p.sn = (const float*)(ws + WS_SIN);
              const int ksp = fullpro ? ((c.bx >> 3) & 7) : 0; p.i0 = part ? ksp : 0; p.i1 = part ? (1 << 24) : ksp;
              GEMM_RUN(p); }
            if (part == 0 && fullpro) { const PhaseCtx c = phase_ctx(args, wave_s); __syncthreads();
#pragma unroll 1
                for (int Lw = 0; Lw < 2; ++Lw) pro_moe(args, c, lds, Lw);
                pro_wout(args, c, lds); pro_s3(args, c, lds); __syncthreads(); }
        }
    }
    SEAM(1);
    if (IN(2)) { const PhaseCtx c = phase_ctx(args, wave_s); unsigned char* ws = c.ws;
#if defined(MK_REPEAT) && MK_REPEAT == 2
        retention_phase(lds, (const bf16*)(ws + WS_Q0), (const bf16*)(ws + WS_K0), (bf16*)(ws + WS_V0), (float*)(ws + WS_SSQ), c.G, c.vcu, c.tid, (flg & 1) != 0);
#endif
        retention_phase(lds, (const bf16*)(ws + WS_Q0), (const bf16*)(ws + WS_K0), (bf16*)(ws + WS_V0), (float*)(ws + WS_SSQ), c.G, c.vcu, c.tid); }
    SEAM(2);
    if (IN(3)) { const bool rep_now = (MK_REPEAT_K == 3); const PhaseCtx c = phase_ctx(args, wave_s); unsigned char* ws = c.ws;
        P_GATE p; p.A = (const char*)(ws + WS_XN); p.Bt = (const char*)(ws + WS_WIN) + (size_t)4096 * 2048; p.lda = 2048; p.ldb = 2048; p.K = 1024; p.so.init(T, 2048, c.G, c.bx);
        p.ov = (bf16*)(ws + WS_V0); p.ssq = (const float*)(ws + WS_SSQ);
        GEMM_RUN(p); }
    SEAM(3);
    if (IN(4)) { const bool rep_now = (MK_REPEAT_K == 4); const PhaseCtx c = phase_ctx(args, wave_s); unsigned char* ws = c.ws;
        P_RESB p; p.A = (const char*)(ws + WS_V0); p.Bt = (const char*)(ws + WS_WOUT); p.lda = 4096; p.ldb = 4096; p.K = 2048; p.so.init(T, 1024, c.G, c.bx);
        p.res32 = args.in[IN_X]; p.hb = (bf16*)(ws + WS_XN); p.row_off = 0;
        GEMM_RUN(p); }
    SEAM(4);
#pragma unroll 1
    for (int L = 0; L < 2; ++L) {
        RELAUNDER();
        const int P0 = L ? 19 : 5;
#define INL(k0, k1) (L ? IN(k1) : IN(k0))
#define SEAML(k0, k1) do { if (L) SEAM(k1); else SEAM(k0); } while (0)
        if (L == 1) {
            if (IN(10)) { const PhaseCtx c = phase_ctx(args, wave_s); if (!fullpro) pro_s3(args, c, lds);
 }
            if (!fullpro) SEAM(10);
#pragma unroll 1
            for (int ch = 0; ch < 2; ++ch) {
                RELAUNDER();
#define INC(k) (ch ? IN((k) + 4) : IN(k))
#define SEAMC(k) do { if (ch) SEAM((k) + 4); else SEAM(k); } while (0)
                if (INC(11)) { const bool rep_now = (MK_REPEAT_K == 11); const PhaseCtx c = phase_ctx(args, wave_s); unsigned char* ws = c.ws;
                    P_QKV1 p; p.A = (const char*)(ws + WS_XN) + (size_t)ch * TC * D * 2; p.Bt = (const char*)(ws + WS_WQKV1); p.lda = 2048; p.ldb = 2048; p.K = 1024; p.so.init(TC, 9216, c.G, c.bx);
                    p.qkv = (bf16*)(ws + WS_Q1); p.gains = (const float*)(ws + WS_WR + 512 * 1024); p.rs1 = (const float*)(ws + WS_GATEW + 1024 * 1024) + ch * TC;
                    GEMM_RUN(p); }
                SEAMC(11);
                if (INC(12)) { const PhaseCtx c = phase_ctx(args, wave_s); unsigned char* ws = c.ws;
#if defined(MK_REPEAT) && MK_REPEAT == 12
                    attn_phase(lds, (bf16*)(ws + WS_Q1), (const bf16*)(ws + WS_K1), (const bf16*)(ws + WS_V1), (f32x2*)(ws + WS_ML), args.in[IN_REL_BIAS], c.G, c.bx, c.tid, (flg & 1) != 0);
#endif
                    attn_phase(lds, (bf16*)(ws + WS_Q1), (const bf16*)(ws + WS_K1), (const bf16*)(ws + WS_V1), (f32x2*)(ws + WS_ML), args.in[IN_REL_BIAS], c.G, c.bx, c.tid); }
                SEAMC(12);
                if (INC(13)) { const PhaseCtx c = phase_ctx(args, wave_s); merge_phase((const bf16*)(c.ws + WS_Q1), (const f32x2*)(c.ws + WS_ML), (bf16*)(c.ws + WS_AO) + (size_t)ch * TC * D, c.G, c.bx, c.tid); }
                SEAMC(13);
#undef INC
#undef SEAMC
            }
            if (IN(18)) { const bool rep_now = (MK_REPEAT_K == 14); const PhaseCtx c = phase_ctx(args, wave_s); unsigned char* ws = c.ws;
                P_RESB p; p.A = (const char*)(ws + WS_AO); p.Bt = (const char*)(ws + WS_WO1); p.lda = 2048; p.ldb = 2048; p.K = 1024; p.so.init(T, 1024, c.G, c.bx);
                p.res32 = nullptr; p.hb = (bf16*)(ws + WS_XN); p.row_off = 0;
                GEMM_RUN(p); }
            SEAM(18);
        }
        if (INL(5, 19)) { const PhaseCtx c = phase_ctx(args, wave_s); if (!fullpro) pro_moe(args, c, lds, L); }
        if (!fullpro) SEAML(5, 19);
        if (INL(6, 20)) { const PhaseCtx c = phase_ctx(args, wave_s); unsigned char* ws = c.ws;
            router_phase(lds, (const bf16*)(ws + WS_WR) + (size_t)L * 48 * 1024, (const bf16*)(ws + WS_WR + 196608) + (size_t)L * 48 * 1024, args.in[IN_RGRP_B] + L * 4, args.in[IN_REXP_B] + L * 32, (const bf16*)(ws + WS_XN), (int*)(ws + WS_LIST), (float*)(ws + WS_GATEW),
                         (unsigned*)(ws + WS_CTL) + CW_CNT + L * 4096, c.G, c.vcu, c.tid); }
        SEAML(6, 20);
        if (INL(7, 21) || INL(8, 22)) { const PhaseCtx c = phase_ctx(args, wave_s); moe_build_tab(TAB, (const unsigned*)(c.ws + WS_CTL) + CW_CNT + L * 4096, c.tid); }
        if (INL(7, 21)) { const bool rep_now = (MK_REPEAT_K == 7); const PhaseCtx c = phase_ctx(args, wave_s); unsigned char* ws = c.ws;
            P_GU p; p.xn = (const char*)(ws + WS_XN); p.W = (const char*)(ws + (L ? WS_WGU1 : WS_WGU0)); p.list = (const int*)(ws + WS_LIST); p.hid = (bf16*)(ws + WS_HID); p.tab = TAB; p.G = c.G; p.vcu = c.vcu; p.K = 1024; p.lda = 2048; p.ldb = 2048;
            GEMM_RUN(p); }
        SEAML(7, 21);
        if (INL(8, 22)) { const bool rep_now = (MK_REPEAT_K == 8); const PhaseCtx c = phase_ctx(args, wave_s); unsigned char* ws = c.ws;
            P_DN p; p.hid = (const char*)(ws + WS_HID); p.W = (const char*)(ws + (L ? WS_WD1 : WS_WD0)); p.y = (bf16*)(ws + WS_YB); p.tab = TAB; p.G = c.G; p.vcu = c.vcu; p.K = 512; p.lda = 1024; p.ldb = 1024;
            GEMM_RUN(p); }
        SEAML(8, 22);
        if (INL(9, 23)) { const PhaseCtx c = phase_ctx(args, wave_s); unsigned char* ws = c.ws;
            if (!(INL(7, 21) || INL(8, 22))) moe_build_tab(TAB, (const unsigned*)(ws + WS_CTL) + CW_CNT + L * 4096, c.tid);
            combine_phase((bf16*)(ws + WS_XN), (const bf16*)(ws + WS_YB), (const unsigned*)(ws + WS_GATEW) + 2 * T, (const float*)(ws + WS_GATEW), TAB, L == 1 ? c.hout : (float*)nullptr, (float*)(ws + WS_GATEW + 1024 * 1024), c.gw, c.NGW, c.lane); }
        SEAML(9, 23);
#undef INL
#undef SEAML
        (void)P0;
    }
#ifdef MK_STAMP
    if (blockIdx.x == 0 && wave_s == 0 && lane_id() == 0) { volatile LAS unsigned long long* st = (volatile LAS unsigned long long*)(lds + LDS_MISC + 3072);
        const float tot = (float)(st[24] - st[0]); float* pr = (float*)(args.ws + WS_CTL) + 200000;
        pr[0] = floorf((float)(st[MK_STAMP_A1] - st[MK_STAMP_A0]) / tot * 200.0f + 0.5f) * 0.005f; pr[1] = 0.f; }
#endif
#undef IN
#undef SEAM
#undef RELAUNDER
#undef fullpro
}
}
#ifndef MK_MASK
#define MK_MASK 15
#endif
#ifndef MK_SPLIT
#define MK_SPLIT 0
#endif

#ifdef MK_DEBUG
namespace dbg {
__global__ void k_cmp(const float* a, const float* b, size_t n, unsigned long long* acc) {
    double num = 0.0, den = 0.0; unsigned long long bad = 0;
    for (size_t i = (size_t)blockIdx.x * blockDim.x + threadIdx.x; i < n; i += (size_t)gridDim.x * blockDim.x) { const float x = a[i], y = b[i]; const float d = x - y; if (!(d - d == 0.0f)) { ++bad; continue; } num += (double)d * d; den += (double)x * x; }
    for (int o = 32; o >= 1; o >>= 1) { num += __shfl_xor(num, o); den += __shfl_xor(den, o); bad += __shfl_xor(bad, o); }
    if ((threadIdx.x & 63) == 0) { atomicAdd(acc, (unsigned long long)(num * 1048576.0)); atomicAdd(acc + 1, (unsigned long long)(den * 1048576.0)); atomicAdd(acc + 2, bad); }
}
__global__ void k_code(const unsigned long long* acc, float* scale) {
    const double num = (double)acc[0], den = (double)acc[1]; const double e = sqrt(num / (den + 1.0));
    int code = e < 0.01 ? 0 : (e < 0.03 ? 1 : (e < 0.1 ? 2 : (e < 0.3 ? 3 : (e < 1.0 ? 4 : 5)))); if (acc[2]) code = 7;
    scale[0] = 1.0f + 0.1f * (float)code;
}
__global__ void k_cmp_bf(const unsigned short* nw, const float* ref, int ldr, int offr, int mode, unsigned long long* acc, int tlo = 0, int thi = 2048) {
    double num = 0.0, den = 0.0; unsigned long long bad = 0;
    const size_t n = mode < 2 ? (size_t)2048 * 1024 : (size_t)2048 * 2048;
    for (size_t i = (size_t)blockIdx.x * blockDim.x + threadIdx.x; i < n; i += (size_t)gridDim.x * blockDim.x) {
        float x, y;
        if (mode < 2) { const int t = (int)(i >> 10), col = (int)(i & 1023), hh = col >> 8, d = col & 255, c = d < 128 ? 2 * d : 2 * (d - 128) + 1;
            const float l2g = log2f(1.0f - exp2f(-5.0f - (float)hh)); const float sc = exp2f((mode == 0 ? -l2g : l2g) * (float)(t & 63));
            y = __uint_as_float(((unsigned)nw[(size_t)t * 1024 + hh * 256 + c]) << 16) * sc; x = ref[(size_t)t * ldr + offr + col]; }
        else { const int t = (int)(i >> 11), col = (int)(i & 2047); if (t < tlo || t >= thi) continue; y = __uint_as_float(((unsigned)nw[(size_t)t * 2048 + col]) << 16); x = ref[(size_t)t * ldr + offr + col]; }
        const float dd = x - y; if (!(dd - dd == 0.0f)) { ++bad; continue; } num += (double)dd * dd; den += (double)x * x; }
    for (int o = 32; o >= 1; o >>= 1) { num += __shfl_xor(num, o); den += __shfl_xor(den, o); bad += __shfl_xor(bad, o); }
    if ((threadIdx.x & 63) == 0) { atomicAdd(acc, (unsigned long long)(num * 1048576.0)); atomicAdd(acc + 1, (unsigned long long)(den * 1048576.0)); atomicAdd(acc + 2, bad); }
}
__device__ inline int code_of(const unsigned long long* acc) { const double e = sqrt((double)acc[0] / ((double)acc[1] + 1.0)); int code = e < 0.01 ? 0 : (e < 0.03 ? 1 : (e < 0.1 ? 2 : (e < 0.3 ? 3 : (e < 1.0 ? 4 : 5)))); if (acc[2]) code = 7; return code; }
__global__ void k_code3(const unsigned long long* acc, float* scale) { scale[0] = 1.0f + 0.1f * (float)code_of(acc); scale[1] = 100.0f * (float)(code_of(acc + 4) + 1) + 10.0f * (float)code_of(acc + 8); }
__global__ void k_spike(float* out, const float* scale) { out[0] += scale[1]; }
__global__ void k_scale(float* out, const float* scale, size_t n) { const float s = scale[0]; for (size_t i = (size_t)blockIdx.x * blockDim.x + threadIdx.x; i < n; i += (size_t)gridDim.x * blockDim.x) out[i] *= s; }
}
#endif
#ifndef MK_SPIKE
#define MK_SPIKE 1000.0f
#endif
#ifdef MK_STAMP
__global__ void stamp_apply(float* out, const float* pr, size_t n) { if (blockIdx.x == 0 && threadIdx.x == 0) out[0] += MK_SPIKE * pr[0]; }
#endif
extern "C" void kernel_launch(void* const* d_in, const int* in_sizes, int n_in, void* d_out, int out_size, void* d_ws, size_t ws_size, hipStream_t stream) {
    (void)in_sizes; (void)n_in; (void)out_size;
    if (ws_size < mk::WS_END) return;
    static int configured = 0, grid = 256;
    if (!configured) { if (hipFuncSetAttribute((const void*)mk::mk_fwd, hipFuncAttributeMaxDynamicSharedMemorySize, mk::LDS_BYTES) != hipSuccess) return;
        int dev = 0, cus = 0, per_cu = 0;
        if (hipGetDevice(&dev) == hipSuccess && hipDeviceGetAttribute(&cus, hipDeviceAttributeMultiprocessorCount, dev) == hipSuccess && cus > 0) grid = cus < 256 ? cus : 256;
        if (hipOccupancyMaxActiveBlocksPerMultiprocessor(&per_cu, (const void*)mk::mk_fwd, 512, mk::LDS_BYTES) != hipSuccess || per_cu < 1) return;
        configured = 1; }
    mk::Args a{};
    for (int i = 0; i < 19; ++i) a.in[i] = (const float*)d_in[i];
    a.out = (float*)d_out; a.ws = (unsigned char*)d_ws; a.pad = 0;
    const int mask = MK_MASK;
    auto run_new = [&](int lo, int hi, int flags) {
        (void)hipMemsetAsync((char*)d_ws + mk::WS_CTL, 0, mk::CTL_BYTES, stream);
        if (MK_SPLIT) { for (int p = lo; p < hi; ++p) { a.ph_lo = p; a.ph_hi = p + 1; a.flags = flags; hipLaunchKernelGGL(mk::mk_fwd, dim3(grid), dim3(512), mk::LDS_BYTES, stream, a); } }
        else { a.ph_lo = lo; a.ph_hi = hi; a.flags = flags; hipLaunchKernelGGL(mk::mk_fwd, dim3(grid), dim3(512), mk::LDS_BYTES, stream, a); }
    };
#ifdef MK_DEBUG
    {
        const size_t MiB = mk::MiB; const size_t nall = (size_t)mk::T * mk::D;
        if (ws_size < 580 * MiB) return;
        nv::Ctx c; nv::ctx_init(c, d_in, d_out, d_ws, stream);
        unsigned long long* acc = (unsigned long long*)((char*)d_ws + 575 * MiB); float* scl = (float*)((char*)d_ws + 575 * MiB + 256);
        float* dout = (float*)d_out; float* alt = nullptr; size_t ncmp = nall;
        if (MK_DEBUG == 1) { nv::stage_mixer0(c); alt = (float*)((char*)d_ws + mk::WS_Q0); a.out = alt; run_new(0, 5, 0); }
        else if (MK_DEBUG == 11) {
            nv::stage_mixer0(c);
            float* xn_n = (float*)((char*)d_ws + 62 * MiB); float* pj_n = (float*)((char*)d_ws + 70 * MiB); float* oc_n = (float*)((char*)d_ws + 118 * MiB);
            (void)hipMemsetAsync(acc, 0, 512, stream);
            run_new(0, 2, 0);
            hipLaunchKernelGGL(nv::k_rmsnorm, dim3(2048 / 4), dim3(256), 0, stream, c.x, c.mixer_norm, xn_n, 2048);
            { nv::GemmP g{}; g.A = xn_n; g.lda = 1024; g.B = c.ret_w_in; g.ldb = 6144; g.C = pj_n; g.ldc = 6144; g.M = 2048; g.N = 6144; g.K = 1024; g.mode = 0; nv::gemm(stream, g); }
            hipLaunchKernelGGL(nv::k_rotary, dim3(2048 * 1024 / 256), dim3(256), 0, stream, pj_n, 2048);
            hipLaunchKernelGGL(dbg::k_cmp_bf, dim3(512), dim3(256), 0, stream, (const unsigned short*)((char*)d_ws + mk::WS_Q0), (const float*)pj_n, 6144, 0, 0, acc);
            hipLaunchKernelGGL(dbg::k_cmp_bf, dim3(512), dim3(256), 0, stream, (const unsigned short*)((char*)d_ws + mk::WS_K0), (const float*)pj_n, 6144, 1024, 1, acc);
            hipLaunchKernelGGL(dbg::k_cmp_bf, dim3(512), dim3(256), 0, stream, (const unsigned short*)((char*)d_ws + mk::WS_V0), (const float*)pj_n, 6144, 2048, 2, acc);
            run_new(2, 3, 0);
            hipLaunchKernelGGL(nv::k_retention, dim3(64, 4, 1), dim3(256), 0, stream, (const float*)pj_n, oc_n);
            hipLaunchKernelGGL(dbg::k_cmp_bf, dim3(512), dim3(256), 0, stream, (const unsigned short*)((char*)d_ws + mk::WS_V0), (const float*)oc_n, 2048, 0, 2, acc + 4);
            run_new(3, 4, 0);
            hipLaunchKernelGGL(nv::k_gnorm_gate, dim3(2048), dim3(256), 0, stream, oc_n, (const float*)pj_n, 2048);
            hipLaunchKernelGGL(dbg::k_cmp_bf, dim3(512), dim3(256), 0, stream, (const unsigned short*)((char*)d_ws + mk::WS_V0), (const float*)oc_n, 2048, 0, 2, acc + 8);
            hipLaunchKernelGGL(dbg::k_code3, dim3(1), dim3(1), 0, stream, (const unsigned long long*)acc, scl);
            nv::stage_moe(c, 0); nv::stage_mixer1(c); nv::stage_moe(c, 1);
            hipLaunchKernelGGL(dbg::k_scale, dim3(1024), dim3(256), 0, stream, dout, (const float*)scl, nall);
            hipLaunchKernelGGL(dbg::k_spike, dim3(1), dim3(1), 0, stream, dout, (const float*)scl);
            return;
        }
        else if (MK_DEBUG == 12) {
            nv::stage_mixer0(c);
            float* xn_n = (float*)((char*)d_ws + 62 * MiB); float* pj_n = (float*)((char*)d_ws + 70 * MiB); float* oc_n = (float*)((char*)d_ws + 118 * MiB);
            (void)hipMemsetAsync(acc, 0, 512, stream);
            run_new(0, 3, 0);
            hipLaunchKernelGGL(nv::k_rmsnorm, dim3(2048 / 4), dim3(256), 0, stream, c.x, c.mixer_norm, xn_n, 2048);
            { nv::GemmP g{}; g.A = xn_n; g.lda = 1024; g.B = c.ret_w_in; g.ldb = 6144; g.C = pj_n; g.ldc = 6144; g.M = 2048; g.N = 6144; g.K = 1024; g.mode = 0; nv::gemm(stream, g); }
            hipLaunchKernelGGL(nv::k_rotary, dim3(2048 * 1024 / 256), dim3(256), 0, stream, pj_n, 2048);
            hipLaunchKernelGGL(nv::k_retention, dim3(64, 4, 1), dim3(256), 0, stream, (const float*)pj_n, oc_n);
            hipLaunchKernelGGL(dbg::k_cmp_bf, dim3(512), dim3(256), 0, stream, (const unsigned short*)((char*)d_ws + mk::WS_V0), (const float*)oc_n, 2048, 0, 2, acc, 0, 64);
            hipLaunchKernelGGL(dbg::k_cmp_bf, dim3(512), dim3(256), 0, stream, (const unsigned short*)((char*)d_ws + mk::WS_V0), (const float*)oc_n, 2048, 0, 2, acc + 4, 64, 128);
            hipLaunchKernelGGL(dbg::k_cmp_bf, dim3(512), dim3(256), 0, stream, (const unsigned short*)((char*)d_ws + mk::WS_V0), (const float*)oc_n, 2048, 0, 2, acc + 8, 128, 2048);
            hipLaunchKernelGGL(dbg::k_code3, dim3(1), dim3(1), 0, stream, (const unsigned long long*)acc, scl);
            nv::stage_moe(c, 0); nv::stage_mixer1(c); nv::stage_moe(c, 1);
            hipLaunchKernelGGL(dbg::k_scale, dim3(1024), dim3(256), 0, stream, dout, (const float*)scl, nall);
            hipLaunchKernelGGL(dbg::k_spike, dim3(1), dim3(1), 0, stream, dout, (const float*)scl);
            return;
        }
        else nv::stage_mixer0(c);
        if (MK_DEBUG == 2) { alt = (float*)((char*)d_ws + 446 * MiB); (void)hipMemcpyAsync(alt, dout, nall * 4, hipMemcpyDeviceToDevice, stream); nv::stage_moe(c, 0); a.out = alt; run_new(5, 10, 0); }
        else if (MK_DEBUG > 2) nv::stage_moe(c, 0);
        if (MK_DEBUG == 3) { alt = (float*)((char*)d_ws + 510 * MiB); ncmp = (size_t)mk::TC * mk::D; (void)hipMemcpyAsync(alt, dout, ncmp * 4, hipMemcpyDeviceToDevice, stream); nv::stage_mixer1(c); a.out = alt; run_new(10, 15, 2); }
        else if (MK_DEBUG > 3) nv::stage_mixer1(c);
        if (MK_DEBUG == 4) { alt = (float*)((char*)d_ws + 446 * MiB); (void)hipMemcpyAsync(alt, dout, nall * 4, hipMemcpyDeviceToDevice, stream); nv::stage_moe(c, 1); a.out = alt; run_new(19, 24, 0); }
        (void)hipMemsetAsync(acc, 0, 512, stream);
        hipLaunchKernelGGL(dbg::k_cmp, dim3(1024), dim3(256), 0, stream, (const float*)dout, (const float*)alt, ncmp, acc);
        hipLaunchKernelGGL(dbg::k_code, dim3(1), dim3(1), 0, stream, (const unsigned long long*)acc, scl);
        if (MK_DEBUG < 2) nv::stage_moe(c, 0);
        if (MK_DEBUG < 3) nv::stage_mixer1(c);
        if (MK_DEBUG < 4) nv::stage_moe(c, 1);
        hipLaunchKernelGGL(dbg::k_scale, dim3(1024), dim3(256), 0, stream, dout, (const float*)scl, nall);
        return;
    }
#endif
#ifdef MK_STAMP
    if (mask == 15) { run_new(0, mk::NPHASE, 1); hipLaunchKernelGGL(stamp_apply, dim3(1024), dim3(256), 0, stream, (float*)d_out, (const float*)((char*)d_ws + mk::WS_CTL) + 200000, (size_t)mk::T * mk::D); return; }
#endif
    if (mask == 15) { run_new(0, mk::NPHASE, MK_SPLIT ? 0 : 1); return; }
#ifdef MK_WITH_NAIVE
    nv::Ctx c; nv::ctx_init(c, d_in, d_out, d_ws, stream);
    if (mask & 1) run_new(0, 5, 0); else nv::stage_mixer0(c);
    if (mask & 2) run_new(5, 10, 0); else nv::stage_moe(c, 0);
    if (mask & 4) run_new(10, 19, 0); else nv::stage_mixer1(c);
    if (mask & 8) run_new(19, 24, 0); else nv::stage_moe(c, 1);
#endif
}
```

```cpp
#include <hip/hip_runtime.h>
#include <cstdio>
#include <cstdint>
#define MK_MASK 15
#define MK_SPLIT 0
namespace mk {
#define LAS __attribute__((address_space(3)))
#define GAS __attribute__((address_space(1)))
typedef unsigned short bf16;
typedef short bf16x8 __attribute__((ext_vector_type(8)));
typedef short s16x4 __attribute__((ext_vector_type(4)));
typedef float f32x4 __attribute__((ext_vector_type(4)));
typedef float f32x2 __attribute__((ext_vector_type(2)));
typedef unsigned u32x4 __attribute__((ext_vector_type(4)));
typedef unsigned u32x2 __attribute__((ext_vector_type(2)));
typedef GAS unsigned gu32;

constexpr int T = 32768, D = 1024, SEQ = 2048, NB = 16;
constexpr int NEXP = 32, FF = 512;
constexpr int TC = 16384;
constexpr size_t MiB = 1u << 20;
constexpr size_t WS_CTL = 0, CTL_BYTES = 1 * MiB;
constexpr size_t WS_COS = 1 * MiB, WS_SIN = 2 * MiB, WS_WR = 3 * MiB;
constexpr size_t WS_SSQ = 4 * MiB, WS_ML = 8 * MiB, WS_LIST = 16 * MiB, WS_GATEW = 24 * MiB;
constexpr size_t WS_WIN = 26 * MiB, WS_WOUT = 38 * MiB, WS_WQKV1 = 42 * MiB, WS_WO1 = 60 * MiB;
constexpr size_t WS_WGU1 = 62 * MiB, WS_WD1 = 126 * MiB;
constexpr size_t WS_XN = 158 * MiB;
constexpr size_t WS_WGU0 = 222 * MiB, WS_WD0 = 286 * MiB;
constexpr size_t WS_ACT = 318 * MiB;
constexpr size_t WS_Q0 = WS_ACT, WS_K0 = WS_ACT + 64 * MiB, WS_V0 = WS_ACT + 128 * MiB;
constexpr size_t WS_HID = WS_ACT, WS_YB = WS_ACT + 72 * MiB;
constexpr size_t WS_Q1 = 222 * MiB, WS_K1 = 318 * MiB, WS_V1 = 414 * MiB, WS_AO = 510 * MiB;
constexpr size_t WS_END = 574 * MiB;
constexpr int CW_BAR = 4096;
constexpr int CW_CNT = 16384;
constexpr int LDS_MISC = 155648;
constexpr int LDS_BYTES = 159 * 1024;
constexpr int NWAVES = 8;

#define LDS_WAIT() asm volatile("s_waitcnt lgkmcnt(0)" ::: "memory")
#define VM_WAIT() asm volatile("s_waitcnt vmcnt(0)" ::: "memory")
__device__ __forceinline__ unsigned f2bf(float f) { unsigned u = __builtin_bit_cast(unsigned, f); return (u + 0x7fffu + ((u >> 16) & 1u)) >> 16; }
__device__ __forceinline__ unsigned pk2(float lo, float hi) { return f2bf(lo) | (f2bf(hi) << 16); }
typedef __bf16 bf16pair_t __attribute__((ext_vector_type(2)));
__device__ __forceinline__ unsigned cvt_pk_bf16(float lo, float hi) { bf16pair_t v; v.x = (__bf16)lo; v.y = (__bf16)hi; return __builtin_bit_cast(unsigned, v); }
__device__ __forceinline__ float bf_lo(unsigned u) { return __builtin_bit_cast(float, u << 16); }
__device__ __forceinline__ float bf_hi(unsigned u) { return __builtin_bit_cast(float, u & 0xffff0000u); }
#define LDS_BARRIER() do { asm volatile("s_waitcnt lgkmcnt(0)" ::: "memory"); __builtin_amdgcn_s_barrier(); asm volatile("" ::: "memory"); } while (0)
__device__ __forceinline__ float xsum16(float x) { const unsigned u = __builtin_bit_cast(unsigned, x); const auto r = __builtin_amdgcn_permlane16_swap(u, u, false, false); return __builtin_bit_cast(float, (unsigned)r[0]) + __builtin_bit_cast(float, (unsigned)r[1]); }
__device__ __forceinline__ float xsum32(float x) { const unsigned u = __builtin_bit_cast(unsigned, x); const auto r = __builtin_amdgcn_permlane32_swap(u, u, false, false); return __builtin_bit_cast(float, (unsigned)r[0]) + __builtin_bit_cast(float, (unsigned)r[1]); }
__device__ __forceinline__ float xmax16(float x) { const unsigned u = __builtin_bit_cast(unsigned, x); const auto r = __builtin_amdgcn_permlane16_swap(u, u, false, false); return fmaxf(__builtin_bit_cast(float, (unsigned)r[0]), __builtin_bit_cast(float, (unsigned)r[1])); }
__device__ __forceinline__ float xmax32(float x) { const unsigned u = __builtin_bit_cast(unsigned, x); const auto r = __builtin_amdgcn_permlane32_swap(u, u, false, false); return fmaxf(__builtin_bit_cast(float, (unsigned)r[0]), __builtin_bit_cast(float, (unsigned)r[1])); }
__device__ __forceinline__ float dpp_add(float x, const int ctrl) { return x; }
__device__ __forceinline__ float wave_sum(float v) {
    v += __builtin_bit_cast(float, __builtin_amdgcn_update_dpp(0, __builtin_bit_cast(int, v), 0xB1, 0xF, 0xF, true));
    v += __builtin_bit_cast(float, __builtin_amdgcn_update_dpp(0, __builtin_bit_cast(int, v), 0x4E, 0xF, 0xF, true));
    v += __builtin_bit_cast(float, __builtin_amdgcn_update_dpp(0, __builtin_bit_cast(int, v), 0x141, 0xF, 0xF, true));
    v += __builtin_bit_cast(float, __builtin_amdgcn_update_dpp(0, __builtin_bit_cast(int, v), 0x140, 0xF, 0xF, true));
    return xsum32(xsum16(v));
}
__device__ __forceinline__ float silu_f(float x) { return x * __builtin_amdgcn_rcpf(1.0f + __builtin_amdgcn_exp2f(-1.4426950408889634f * x)); }

#define XB_TMO      128
#define XB_XCNT(j)  (256  + 64 * (j))
#define XB_XSUB(j)  (1280 + 64 * (j))
#define XB_XGEN(j)  (2304 + 64 * (j))
#define XB_TOP      3328
#define XB_TOPGEN   3392
#define XCD_BAR_WORDS 3456
#define XB_SPIN_CAP (1u << 22)
__device__ __forceinline__ unsigned xb_ld(unsigned* p)              { return __hip_atomic_load(p, __ATOMIC_RELAXED, __HIP_MEMORY_SCOPE_AGENT); }
__device__ __forceinline__ unsigned xb_add(unsigned* p, unsigned v) { return __hip_atomic_fetch_add(p, v, __ATOMIC_RELAXED, __HIP_MEMORY_SCOPE_AGENT); }
__device__ __forceinline__ unsigned xb_xcc_id() { return (unsigned)__builtin_amdgcn_s_getreg((3 << 11) | 20) & 0xFu; }
#define XB_SPIN(cond, bar) do { unsigned _sp = 0; while (cond) { __builtin_amdgcn_s_sleep(1); \
    if ((++_sp & 255u) == 0u) { if (xb_ld(&(bar)[XB_TMO])) break; if (_sp > XB_SPIN_CAP) { atomicAdd(&(bar)[XB_TMO], 1u); break; } } } } while (0)
struct XcdBarrier { unsigned* bar; unsigned x; volatile LAS unsigned* st; };
__device__ __forceinline__ int lane_id() { int l; asm volatile("v_mbcnt_lo_u32_b32 %0, -1, 0\n\tv_mbcnt_hi_u32_b32 %0, -1, %0" : "=v"(l)); return l; }
__device__ __forceinline__ XcdBarrier xcd_barrier_post(unsigned* bar, volatile LAS unsigned* st, bool t0) {
    XcdBarrier b; b.bar = bar; b.x = xb_xcc_id(); b.st = st;
    if (t0) (void)xb_add(&bar[XB_XCNT(b.x)], 1u);
    return b;
}
__device__ __forceinline__ void xcd_barrier_complete(unsigned* bar, unsigned x, unsigned& nloc, unsigned& nx) {
    const unsigned G = gridDim.x * gridDim.y * gridDim.z;
    unsigned sum, cnt, mine, sp = 0u;
    for (;;) {
        sum = 0u; cnt = 0u; mine = 0u;
#pragma unroll
        for (unsigned j = 0; j < 16; ++j) { const unsigned c = xb_ld(&bar[XB_XCNT(j)]); sum += c; cnt += (c > 0u) ? 1u : 0u; mine = (j == x) ? c : mine; }
        if (sum == G) break;
        __builtin_amdgcn_s_sleep(1);
        if ((++sp & 255u) == 0u) { if (xb_ld(&bar[XB_TMO])) break; if (sp > XB_SPIN_CAP) { atomicAdd(&bar[XB_TMO], 1u); break; } }
    }
    nloc = mine > 0u ? mine : 1u; nx = cnt > 0u ? cnt : 1u;
}
__device__ __forceinline__ void xcd_barrier(const XcdBarrier& b, int wave_s) {
    asm volatile("s_waitcnt vmcnt(0)" ::: "memory");
    __syncthreads();
    if (wave_s == 0 && lane_id() == 0) {
        unsigned* bar = b.bar;
        __builtin_amdgcn_s_waitcnt(0);
        unsigned nloc = b.st[0], nx = b.st[1];
        if (nloc == 0u) { xcd_barrier_complete(bar, b.x, nloc, nx); b.st[0] = nloc; b.st[1] = nx; }
        const unsigned old = xb_add(&bar[XB_XSUB(b.x)], 1u);
        const unsigned gen = old / nloc;
        if (old + 1u == (gen + 1u) * nloc) {
            __builtin_amdgcn_fence(__ATOMIC_RELEASE, "agent");
            asm volatile("s_waitcnt vmcnt(0)" ::: "memory");
            const unsigned og = xb_add(&bar[XB_TOP], 1u);
            const unsigned tg = og / nx;
            if (og + 1u == (tg + 1u) * nx) xb_add(&bar[XB_TOPGEN], 1u);
            else XB_SPIN(xb_ld(&bar[XB_TOPGEN]) == tg, bar);
            __builtin_amdgcn_fence(__ATOMIC_ACQUIRE, "agent");
            xb_add(&bar[XB_XGEN(b.x)], 1u);
            asm volatile("s_waitcnt vmcnt(0)" ::: "memory");
        } else {
            XB_SPIN(xb_ld(&bar[XB_XGEN(b.x)]) == gen, bar);
            __builtin_amdgcn_fence(__ATOMIC_ACQUIRE, "agent");
            asm volatile("s_waitcnt vmcnt(0)" ::: "memory");
        }
    }
    __syncthreads();
}

constexpr int BM = 256, BK = 64, HALF = 128, HTB = HALF * BK * 2, NXCD = 8, WGM = 8;
__host__ __device__ __forceinline__ int lds_byte(int r, int c) { const int st = (r >> 4) * 2 + (c >> 5), rr = r & 15, cc = c & 31, ob = rr * 64 + cc * 2; return st * 1024 + (ob ^ (((ob >> 9) & 1) << 5)); }
__host__ __device__ __forceinline__ void stage_rc(int b, int& R, int& C) { const int st = b / 1024, sb = b % 1024, swz = sb ^ (((sb >> 9) & 1) << 5); R = (st >> 1) * 16 + swz / 64; C = (st & 1) * 32 + (swz % 64) / 2; }
__host__ __device__ __forceinline__ int perm32(int rho) { const int n = rho >> 4, i = rho & 15; return 8 * (i >> 2) + 4 * n + (i & 3); }
struct Unit { int pm, pn, a0, a1; };
struct StaticOrder {
    int nM, nN, nwg, G, c;
    __device__ __forceinline__ void init(int M, int N, int G_, int c_) { nM = M / BM; nN = N / BM; nwg = nM * nN; G = G_; c = c_; }
    __device__ __forceinline__ bool next(int i, Unit& u) const {
        const long L = (long)i * G + c; if (L >= nwg) return false;
        int wgid = (int)L; { const int q = nwg / NXCD, r = nwg % NXCD, xcd = wgid % NXCD, off = wgid / NXCD; wgid = (xcd < r ? xcd * (q + 1) : r * (q + 1) + (xcd - r) * q) + off; }
        const int nig = WGM * nN, gid = wgid / nig, fm = gid * WGM, gsz = (nM - fm) < WGM ? (nM - fm) : WGM;
        u.pm = __builtin_amdgcn_readfirstlane(fm + ((wgid % nig) % gsz)); u.pn = __builtin_amdgcn_readfirstlane((wgid % nig) / gsz); u.a0 = 0; u.a1 = 0; return true;
    }
};
template <class P>
__device__ __forceinline__ void gemm_phase(LAS unsigned char* lds, const P& S, const int tid, const bool dry = false, const int stagger = 0) {
    const int wid = __builtin_amdgcn_readfirstlane(tid >> 6), lane = tid & 63, wr = wid >> 2, wc = wid & 3, fr = lane & 15, fq = lane >> 4;
    const int K = S.K, nt = K / BK;
    unsigned voffB[2]; unsigned vA[2][2];
    LAS u32x4* vslot = (LAS u32x4*)(lds + 131072) + tid;
#pragma unroll
    for (int i = 0; i < 2; ++i) { int R, C; stage_rc(tid * 16 + i * 8192, R, C); const int Rb = P::PERM ? ((R & ~31) + perm32(R & 31)) : R;
        voffB[i] = (unsigned)Rb * S.ldb + (unsigned)C * 2u;
#pragma unroll
        for (int h = 0; h < 2; ++h) vA[h][i] = (unsigned)(h * HALF + R) * S.lda + (unsigned)C * 2u; }
    const size_t kstep = (size_t)(BK * 2);
    const size_t hstepB = (size_t)HALF * S.ldb;
    const unsigned ldsw = (unsigned)wid * 1024u;
    const int aoff = lds_byte(wr * 64 + fr, fq * 8), boff = lds_byte(wc * 32 + fr, fq * 8);
#define PG8_SA(b, h) (((b) * 2 + (h)) * HTB)
#define PG8_SB(b, h) ((4 + (b) * 2 + (h)) * HTB)
#define PG8_STAGE(bufoff, gbase, voff) do { _Pragma("unroll") for (int _i = 0; _i < 2; ++_i) \
        __builtin_amdgcn_global_load_lds((const unsigned*)((const char*)(gbase) + (voff)[_i]), (LAS unsigned*)(lds + (bufoff) + ldsw + _i * 8192), 16, 0, 0); } while (0)
#define PG8_LDA(dst, b, h) do { _Pragma("unroll") for (int m = 0; m < 4; ++m) _Pragma("unroll") for (int k = 0; k < 2; ++k) dst[m][k] = *(const LAS bf16x8*)(lds + PG8_SA(b, h) + aoff + m * 2048 + k * 1024); } while (0)
#define PG8_LDB(dst, b, h) do { _Pragma("unroll") for (int n = 0; n < 2; ++n) _Pragma("unroll") for (int k = 0; k < 2; ++k) dst[n][k] = *(const LAS bf16x8*)(lds + PG8_SB(b, h) + boff + n * 2048 + k * 1024); } while (0)
#define PG8_MMA(ai, bj, At, Bt) do { __builtin_amdgcn_s_setprio(1); _Pragma("unroll") for (int m = 0; m < 4; ++m) _Pragma("unroll") for (int n = 0; n < 2; ++n) _Pragma("unroll") for (int k = 0; k < 2; ++k) \
        acc[ai][bj][m][n] = __builtin_amdgcn_mfma_f32_16x16x32_bf16(Bt[n][k], At[m][k], acc[ai][bj][m][n], 0, 0, 0); __builtin_amdgcn_s_setprio(0); } while (0)
#define PG8_WAIT_V(n) asm volatile("s_waitcnt vmcnt(" #n ")" ::: "memory")
#define PG8_WAIT_L(n) asm volatile("s_waitcnt lgkmcnt(" #n ")" ::: "memory")
#define PG8_BAR __builtin_amdgcn_s_barrier()
#define PG8_SCHED __builtin_amdgcn_sched_barrier(0)
    Unit cur, nxt; int ui = 0;
    if (!S.next(0, cur)) return;
    if (stagger > 0) { const int cls = (int)(blockIdx.x & 7u); for (int i = 0; i < cls * stagger; ++i) __builtin_amdgcn_s_sleep(16); }
    f32x4 acc[2][2][4][2];
#pragma unroll
    for (int a = 0; a < 2; ++a)
#pragma unroll
        for (int b = 0; b < 2; ++b)
#pragma unroll
            for (int m = 0; m < 4; ++m)
#pragma unroll
                for (int n = 0; n < 2; ++n) acc[a][b][m][n] = (f32x4){0.f, 0.f, 0.f, 0.f};
    bf16x8 At[4][2], B0[2][2], B1[2][2];
    const char* cA = S.a_base(cur); const char* cB = S.b_base(cur);
    bool skip_hi = P::HALFABLE && (cur.a0 >> 6) != 0;
    if constexpr (P::GATHER) { S.a_rows(cur, tid, vA); }
    PG8_STAGE(PG8_SB(0, 0), cB, voffB); PG8_STAGE(PG8_SB(0, 1), cB + hstepB, voffB); PG8_STAGE(PG8_SA(0, 0), cA, vA[0]); PG8_STAGE(PG8_SA(0, 1), cA, vA[1]);
    if (wr == 1) PG8_BAR;
    PG8_WAIT_V(2); PG8_BAR;
    PG8_STAGE(PG8_SB(1, 0), cB + kstep, voffB); PG8_STAGE(PG8_SA(1, 0), cA + kstep, vA[0]); PG8_STAGE(PG8_SB(1, 1), cB + hstepB + kstep, voffB);
    PG8_WAIT_V(6); PG8_BAR;
    for (;;) {
        const bool has_next = S.next(ui + 1, nxt);
        const char* nA = has_next ? S.a_base(nxt) : cA; const char* nB = has_next ? S.b_base(nxt) : cB;
        for (int t = 0; t < nt; t += 2) {
            const bool last = (t == nt - 2);
            if constexpr (P::GATHER) { if (t == nt - 4 && has_next) { unsigned tn[2][2]; S.a_rows(nxt, tid, tn); *vslot = (u32x4){tn[0][0], tn[0][1], tn[1][0], tn[1][1]}; } }
            const char* a1 = cA + (size_t)(t + 1) * kstep;
            const char* a2 = last ? nA : cA + (size_t)(t + 2) * kstep; const char* b2 = last ? nB : cB + (size_t)(t + 2) * kstep;
            const char* a3 = a2 + kstep; const char* b3 = b2 + kstep;
            unsigned v2[2][2];
#pragma unroll
            for (int h = 0; h < 2; ++h)
#pragma unroll
                for (int i = 0; i < 2; ++i) v2[h][i] = vA[h][i];
            if constexpr (P::GATHER) { if (last && has_next) { const u32x4 tn = *vslot; v2[0][0] = tn.x; v2[0][1] = tn.y; v2[1][0] = tn.z; v2[1][1] = tn.w; } }
            PG8_LDB(B0, 0, 0); PG8_LDB(B1, 0, 1); PG8_SCHED; PG8_LDA(At, 0, 0); PG8_STAGE(PG8_SA(1, 1), a1, vA[1]);
            PG8_WAIT_V(8); PG8_WAIT_L(0); PG8_BAR; PG8_MMA(0, 0, At, B0); PG8_MMA(0, 1, At, B1); PG8_BAR; PG8_SCHED;
            PG8_LDA(At, 0, 1); PG8_STAGE(PG8_SB(0, 0), b2, voffB); PG8_STAGE(PG8_SB(0, 1), b2 + hstepB, voffB); PG8_STAGE(PG8_SA(0, 0), a2, v2[0]);
            PG8_WAIT_V(8); PG8_WAIT_L(0); PG8_BAR; if (!skip_hi) { PG8_MMA(1, 0, At, B0); PG8_MMA(1, 1, At, B1); } PG8_BAR; PG8_SCHED;
            PG8_LDB(B0, 1, 0); PG8_LDB(B1, 1, 1); PG8_SCHED; PG8_LDA(At, 1, 0); PG8_STAGE(PG8_SA(0, 1), a2, v2[1]);
            PG8_WAIT_V(8); PG8_WAIT_L(0); PG8_BAR; PG8_MMA(0, 0, At, B0); PG8_MMA(0, 1, At, B1); PG8_BAR; PG8_SCHED;
            PG8_LDA(At, 1, 1); PG8_STAGE(PG8_SB(1, 0), b3, voffB); PG8_STAGE(PG8_SB(1, 1), b3 + hstepB, voffB); PG8_STAGE(PG8_SA(1, 0), a3, v2[0]);
            PG8_WAIT_V(8); PG8_WAIT_L(0); PG8_BAR; if (!skip_hi) { PG8_MMA(1, 0, At, B0); PG8_MMA(1, 1, At, B1); } PG8_BAR; PG8_SCHED;
        }
        if (wr == 0) PG8_BAR;
        { int fr_e = fr, fq_e = fq; asm volatile("" : "+v"(fr_e), "+v"(fq_e));
          if (!dry) S.epi(acc, cur, wr, wc, fr_e, fq_e); }
        if (!has_next) break;
#pragma unroll
        for (int a = 0; a < 2; ++a)
#pragma unroll
            for (int b = 0; b < 2; ++b)
#pragma unroll
                for (int m = 0; m < 4; ++m)
#pragma unroll
                    for (int n = 0; n < 2; ++n) acc[a][b][m][n] = (f32x4){0.f, 0.f, 0.f, 0.f};
        cur = nxt; cA = nA; cB = nB; ++ui; skip_hi = P::HALFABLE && (cur.a0 >> 6) != 0;
        if constexpr (P::GATHER) { const u32x4 tn = *vslot; vA[0][0] = tn.x; vA[0][1] = tn.y; vA[1][0] = tn.z; vA[1][1] = tn.w; }
        if (wr == 1) PG8_BAR;
    }
    PG8_WAIT_V(0);
    PG8_BAR;
#undef PG8_SA
#undef PG8_SB
#undef PG8_STAGE
#undef PG8_LDA
#undef PG8_LDB
#undef PG8_MMA
#undef PG8_WAIT_V
#undef PG8_WAIT_L
#undef PG8_BAR
#undef PG8_SCHED
}
struct PlainBase {
    const char* A; const char* Bt; unsigned lda, ldb; int K; StaticOrder so;
    __device__ __forceinline__ bool next(int i, Unit& u) const { return so.next(i, u); }
    __device__ __forceinline__ const char* a_base(const Unit& u) const { return A + (size_t)u.pm * BM * lda; }
    __device__ __forceinline__ const char* b_base(const Unit& u) const { return Bt + (size_t)u.pn * BM * ldb; }
    __device__ __forceinline__ void a_rows(const Unit&, int, unsigned (&)[2][2]) const {}
};
__device__ __forceinline__ float head_l2g(int h) { return __builtin_log2f(1.0f - __builtin_amdgcn_exp2f(-5.0f - (float)h)); }

struct P_QKV0 : PlainBase {
    static constexpr bool PERM = true, GATHER = false, HALFABLE = false;
    bf16* qk; bf16* v; const float* cs; const float* sn;
    int i0, i1;
    __device__ __forceinline__ bool next(int i, Unit& u) const { return (i + i0 < i1) && so.next(i + i0, u); }
    __device__ __forceinline__ void epi(const f32x4 (&acc)[2][2][4][2], const Unit& u, int wr, int wc, int fr, int fq) const {
        const int row0 = u.pm * BM + wr * 64 + fr, pn = u.pn;
        if (pn < 8) {
            const int hh = pn & 3; const bool isk = pn >= 4; bf16* dst = qk + (size_t)(pn >> 2) * ((size_t)T * 1024);
            const float l2g = isk ? -head_l2g(hh) : head_l2g(hh);
            float invr[2][4];
#pragma unroll
            for (int bj = 0; bj < 2; ++bj)
#pragma unroll
                for (int p = 0; p < 4; ++p) invr[bj][p] = __builtin_amdgcn_exp2f((float)(bj * 64 + wc * 16 + 4 * fq + p) * (-13.287712379549449f / 127.0f)) * 0.15915494309189535f;
#pragma unroll
            for (int ai = 0; ai < 2; ++ai)
#pragma unroll
                for (int m = 0; m < 4; ++m) { const int row = row0 + ai * HALF + m * 16, pos = row & (SEQ - 1);
                    const float sc = __builtin_amdgcn_exp2f(l2g * (float)(pos & 63)), fp = (float)pos;
#pragma unroll
                    for (int bj = 0; bj < 2; ++bj) { const int c0 = bj * HALF + wc * 32 + 8 * fq;
                        float cv[4], sv[4];
#pragma unroll
                        for (int p = 0; p < 4; ++p) { const float rev = fp * invr[bj][p], fr_ = rev - __builtin_floorf(rev); cv[p] = __builtin_amdgcn_cosf(fr_) * sc; sv[p] = __builtin_amdgcn_sinf(fr_) * sc; }
                        const f32x4 v0 = acc[ai][bj][m][0], v1 = acc[ai][bj][m][1];
                        u32x4 w;
                        w.x = cvt_pk_bf16(v0[0] * cv[0] - v0[1] * sv[0], v0[0] * sv[0] + v0[1] * cv[0]);
                        w.y = cvt_pk_bf16(v0[2] * cv[1] - v0[3] * sv[1], v0[2] * sv[1] + v0[3] * cv[1]);
                        w.z = cvt_pk_bf16(v1[0] * cv[2] - v1[1] * sv[2], v1[0] * sv[2] + v1[1] * cv[2]);
                        w.w = cvt_pk_bf16(v1[2] * cv[3] - v1[3] * sv[3], v1[2] * sv[3] + v1[3] * cv[3]);
                        *(u32x4*)(dst + (size_t)row * 1024 + hh * 256 + c0) = w; } }
        } else {
#pragma unroll
            for (int ai = 0; ai < 2; ++ai)
#pragma unroll
                for (int m = 0; m < 4; ++m) { const int row = row0 + ai * HALF + m * 16;
#pragma unroll
                    for (int bj = 0; bj < 2; ++bj) { const int c0 = bj * HALF + wc * 32 + 8 * fq;
                        const f32x4 v0 = acc[ai][bj][m][0], v1 = acc[ai][bj][m][1];
                        u32x4 w; w.x = cvt_pk_bf16(v0[0], v0[1]); w.y = cvt_pk_bf16(v0[2], v0[3]); w.z = cvt_pk_bf16(v1[0], v1[1]); w.w = cvt_pk_bf16(v1[2], v1[3]);
                        *(u32x4*)(v + (size_t)row * 2048 + (pn - 8) * 256 + c0) = w; } }
        }
    }
};
struct P_GATE : PlainBase {
    static constexpr bool PERM = true, GATHER = false, HALFABLE = false;
    bf16* ov; const float* ssq;
    __device__ __forceinline__ void epi(const f32x4 (&acc)[2][2][4][2], const Unit& u, int wr, int wc, int fr, int fq) const {
        const int row0 = u.pm * BM + wr * 64 + fr, head = u.pn >> 1;
#pragma unroll
        for (int ai = 0; ai < 2; ++ai) {
            f32x4 s0[4], s1[4]; u32x4 ov4[4][2];
#pragma unroll
            for (int m = 0; m < 4; ++m) { const int row = row0 + ai * HALF + m * 16;
                s0[m] = *(const f32x4*)(ssq + ((size_t)row * 4 + head) * 8); s1[m] = *(const f32x4*)(ssq + ((size_t)row * 4 + head) * 8 + 4);
#pragma unroll
                for (int bj = 0; bj < 2; ++bj) ov4[m][bj] = *(const u32x4*)(ov + (size_t)row * 2048 + u.pn * BM + bj * HALF + wc * 32 + 8 * fq); }
#pragma unroll
            for (int m = 0; m < 4; ++m) { const int row = row0 + ai * HALF + m * 16;
                const float rs = __builtin_amdgcn_rsqf((((s0[m][0] + s0[m][1]) + (s0[m][2] + s0[m][3])) + ((s1[m][0] + s1[m][1]) + (s1[m][2] + s1[m][3]))) * (1.0f / 512.0f) + 1e-6f);
#pragma unroll
                for (int bj = 0; bj < 2; ++bj) { const u32x4 o = ov4[m][bj];
                    const f32x4 v0 = acc[ai][bj][m][0], v1 = acc[ai][bj][m][1];
                    u32x4 w;
                    w.x = cvt_pk_bf16(silu_f(v0[0]) * bf_lo(o.x) * rs, silu_f(v0[1]) * bf_hi(o.x) * rs);
                    w.y = cvt_pk_bf16(silu_f(v0[2]) * bf_lo(o.y) * rs, silu_f(v0[3]) * bf_hi(o.y) * rs);
                    w.z = cvt_pk_bf16(silu_f(v1[0]) * bf_lo(o.z) * rs, silu_f(v1[1]) * bf_hi(o.z) * rs);
                    w.w = cvt_pk_bf16(silu_f(v1[2]) * bf_lo(o.w) * rs, silu_f(v1[3]) * bf_hi(o.w) * rs);
                    *(u32x4*)(ov + (size_t)row * 2048 + u.pn * BM + bj * HALF + wc * 32 + 8 * fq) = w; } }
        }
    }
};
struct P_RESB : PlainBase {
    static constexpr bool PERM = true, GATHER = false, HALFABLE = false;
    const float* res32; bf16* hb; int row_off;
    __device__ __forceinline__ void epi(const f32x4 (&acc)[2][2][4][2], const Unit& u, int wr, int wc, int fr, int fq) const {
        const int row0 = row_off + u.pm * BM + wr * 64 + fr;
#pragma unroll
        for (int ai = 0; ai < 2; ++ai) {
            f32x4 r[4][2][2];
#pragma unroll
            for (int m = 0; m < 4; ++m) { const size_t off = (size_t)(row0 + ai * HALF + m * 16) * D + u.pn * BM + wc * 32 + 8 * fq;
#pragma unroll
                for (int bj = 0; bj < 2; ++bj) {
                    if (res32) { r[m][bj][0] = *(const f32x4*)(res32 + off + bj * HALF); r[m][bj][1] = *(const f32x4*)(res32 + off + bj * HALF + 4); }
                    else { const u32x4 o = *(const u32x4*)(hb + off + bj * HALF); r[m][bj][0] = (f32x4){bf_lo(o.x), bf_hi(o.x), bf_lo(o.y), bf_hi(o.y)}; r[m][bj][1] = (f32x4){bf_lo(o.z), bf_hi(o.z), bf_lo(o.w), bf_hi(o.w)}; } } }
#pragma unroll
            for (int m = 0; m < 4; ++m) { const size_t off = (size_t)(row0 + ai * HALF + m * 16) * D + u.pn * BM + wc * 32 + 8 * fq;
#pragma unroll
                for (int bj = 0; bj < 2; ++bj) { const f32x4 r0 = r[m][bj][0] + acc[ai][bj][m][0], r1 = r[m][bj][1] + acc[ai][bj][m][1];
                    u32x4 w; w.x = cvt_pk_bf16(r0[0], r0[1]); w.y = cvt_pk_bf16(r0[2], r0[3]); w.z = cvt_pk_bf16(r1[0], r1[1]); w.w = cvt_pk_bf16(r1[2], r1[3]);
                    *(u32x4*)(hb + off + bj * HALF) = w; } }
        }
    }
};
struct P_QKV1 : PlainBase {
    static constexpr bool PERM = true, GATHER = false, HALFABLE = false;
    bf16* qkv; const float* gains; const float* rs1;
    __device__ __forceinline__ void epi(const f32x4 (&acc)[2][2][4][2], const Unit& u, int wr, int wc, int fr, int fq) const {
        const int row0 = u.pm * BM + wr * 64 + fr, part = u.pn / 12, pp = u.pn % 12, g = pp >> 2, head = (pp & 3) * 4 + wc;
        const int Rg = g == 0 ? 1 : (g == 1 ? 4 : 16), shR = g == 0 ? 0 : (g == 1 ? 2 : 4);
        bf16* dst = qkv + (size_t)part * ((size_t)TC * 3072) + (size_t)(g * 16 + head) * (SEQ * 64) + 8 * fq;
        const float* gp = gains + (part & 1) * 192 + g * 64 + 8 * fq;
        const float qs = part == 0 ? 0.125f * 1.4426950408889634f : 1.0f;
        float rsr[2][4];
#pragma unroll
        for (int ai = 0; ai < 2; ++ai)
#pragma unroll
            for (int m = 0; m < 4; ++m) rsr[ai][m] = rs1[row0 + ai * HALF + m * 16];
        f32x4 gv[2][2];
#pragma unroll
        for (int bj = 0; bj < 2; ++bj) { gv[bj][0] = *(const f32x4*)(gp + 32 * bj); gv[bj][1] = *(const f32x4*)(gp + 32 * bj + 4); }
#pragma unroll
        for (int ai = 0; ai < 2; ++ai)
#pragma unroll
            for (int m = 0; m < 4; ++m) { const int row = row0 + ai * HALF + m * 16;
                float rs = rsr[ai][m];
                if (part < 2) {
                    float ss = 0.f;
#pragma unroll
                    for (int bj = 0; bj < 2; ++bj)
#pragma unroll
                        for (int n = 0; n < 2; ++n) { const f32x4 t = acc[ai][bj][m][n]; ss += (t[0] * t[0] + t[1] * t[1]) + (t[2] * t[2] + t[3] * t[3]); }
                    ss = xsum32(xsum16(ss));
                    rs = rs * __builtin_amdgcn_rsqf(ss * rs * rs * (1.0f / 64.0f) + 1e-6f) * qs;
                }
#pragma unroll
                for (int bj = 0; bj < 2; ++bj) { f32x4 v0 = acc[ai][bj][m][0], v1 = acc[ai][bj][m][1];
                    if (part < 2) { v0 = v0 * gv[bj][0] * rs; v1 = v1 * gv[bj][1] * rs; } else { v0 = v0 * rs; v1 = v1 * rs; }
                    u32x4 w; w.x = cvt_pk_bf16(v0[0], v0[1]); w.y = cvt_pk_bf16(v0[2], v0[3]); w.z = cvt_pk_bf16(v1[0], v1[1]); w.w = cvt_pk_bf16(v1[2], v1[3]);
                    { const int bl = row >> 11, t = row & (SEQ - 1), pos = (t & (Rg - 1)) * (SEQ >> shR) + (t >> shR); *(u32x4*)(dst + ((size_t)bl * 48 * SEQ + pos) * 64 + 32 * bj) = w; } } }
    }
};
__device__ __forceinline__ void moe_build_tab(LAS int* tab, const unsigned* cnt_g, const int tid) {
    if (tid < 64) tab[tid] = (int)__hip_atomic_load(cnt_g + tid * 64, __ATOMIC_RELAXED, __HIP_MEMORY_SCOPE_AGENT);
    __syncthreads();
    if (tid < 64) { int pre = 0, fpre = 0, hpre = 0, ftot = 0, tot = 0;
        for (int b = 0; b < 64; ++b) { const int c = tab[b], nt = (c + 255) >> 8, hf = (nt > 0 && c - 256 * (nt - 1) <= 128) ? 1 : 0, fl = nt - hf;
            if (b < tid) { pre += nt; fpre += fl; hpre += hf; } ftot += fl; tot += nt; }
        const int c = tab[tid], nt = (c + 255) >> 8, hf = (nt > 0 && c - 256 * (nt - 1) <= 128) ? 1 : 0;
        tab[64 + tid] = pre; if (tid == 0) tab[128] = tot;
        for (int t = 0; t < nt - hf; ++t) tab[160 + fpre + t] = tid | (t << 8);
        if (hf) tab[160 + ftot + hpre] = tid | 64 | ((nt - 1) << 8); }
    __syncthreads();
}
__device__ __forceinline__ int moe_sched(const LAS int* tab, int pos) { return __builtin_amdgcn_readfirstlane(tab[160 + pos]); }
struct P_GU {
    static constexpr bool PERM = true, GATHER = true, HALFABLE = true;
      const char* xn; const char* W; const int* list; bf16* hid; const LAS int* tab; int G, vcu; int K; unsigned lda, ldb;
    __device__ __forceinline__ bool next(int i, Unit& u) const {
        const int L = i * G + vcu; if (L >= tab[128] * 4) return false;
        const int e = moe_sched(tab, L >> 2), b = e & 63;
        u.pm = e >> 8; u.pn = L & 3; u.a0 = e & 127; u.a1 = tab[64 + b] + (e >> 8); return true;
    }
    __device__ __forceinline__ const char* a_base(const Unit&) const { return xn; }
    __device__ __forceinline__ const char* b_base(const Unit& u) const { return W + ((size_t)(u.a0 & 31) * 1024 + (size_t)u.pn * BM) * 2048; }
    __device__ __forceinline__ void a_rows(const Unit& u, int tid, unsigned (&off)[2][2]) const {
        const int n = tab[u.a0 & 63]; const int* lp = list + (size_t)(u.a0 & 63) * T + u.pm * BM;
#pragma unroll
        for (int i = 0; i < 2; ++i) { int R, C; stage_rc(tid * 16 + i * 8192, R, C);
#pragma unroll
            for (int h = 0; h < 2; ++h) { const int r = h * HALF + R; const int tok = (u.pm * BM + r < n) ? lp[r] : 0; off[h][i] = (unsigned)tok * 2048u + (unsigned)C * 2u; } }
    }
    __device__ __forceinline__ void epi(const f32x4 (&acc)[2][2][4][2], const Unit& u, int wr, int wc, int fr, int fq) const {
        const size_t hrow0 = (size_t)u.a1 * BM + wr * 64 + fr; const int n = tab[u.a0 & 63]; const int* lp = list + (size_t)(u.a0 & 63) * T + u.pm * BM;
        float rsr[2][4];
#pragma unroll
        for (int ai = 0; ai < 2; ++ai)
#pragma unroll
            for (int m = 0; m < 4; ++m) { const int r = ai * HALF + wr * 64 + m * 16 + fr; rsr[ai][m] = (u.pm * BM + r < n) ? *(const float*)((const char*)(lp + r) - (WS_LIST - WS_ML)) : 0.0f; }
#pragma unroll
        for (int ai = 0; ai < 2; ++ai)
#pragma unroll
            for (int m = 0; m < 4; ++m) { const float rs = rsr[ai][m];
                { const int f0 = u.pn * HALF + wc * 32 + 8 * fq;
                    const f32x4 g0 = acc[ai][0][m][0] * rs, g1 = acc[ai][0][m][1] * rs, u0 = acc[ai][1][m][0] * rs, u1 = acc[ai][1][m][1] * rs;
                    u32x4 w; w.x = cvt_pk_bf16(silu_f(g0[0]) * u0[0], silu_f(g0[1]) * u0[1]); w.y = cvt_pk_bf16(silu_f(g0[2]) * u0[2], silu_f(g0[3]) * u0[3]);
                    w.z = cvt_pk_bf16(silu_f(g1[0]) * u1[0], silu_f(g1[1]) * u1[1]); w.w = cvt_pk_bf16(silu_f(g1[2]) * u1[2], silu_f(g1[3]) * u1[3]);
                    *(u32x4*)(hid + (hrow0 + ai * HALF + m * 16) * FF + f0) = w; } }
    }
};
struct P_DN {
    static constexpr bool PERM = true, GATHER = false, HALFABLE = true;
    const char* hid; const char* W; bf16* y; const LAS int* tab; int G, vcu; int K; unsigned lda, ldb;
    __device__ __forceinline__ bool next(int i, Unit& u) const {
        const int L = i * G + vcu; if (L >= tab[128] * 4) return false;
        const int e = moe_sched(tab, L >> 2), b = e & 63;
        u.pm = e >> 8; u.pn = L & 3; u.a0 = e & 127; u.a1 = tab[64 + b] + (e >> 8); return true;
    }
    __device__ __forceinline__ const char* a_base(const Unit& u) const { return hid + (size_t)u.a1 * BM * 1024; }
    __device__ __forceinline__ const char* b_base(const Unit& u) const { return W + ((size_t)(u.a0 & 31) * 1024 + (size_t)u.pn * BM) * 1024; }
    __device__ __forceinline__ void a_rows(const Unit&, int, unsigned (&)[2][2]) const {}
    __device__ __forceinline__ void epi(const f32x4 (&acc)[2][2][4][2], const Unit& u, int wr, int wc, int fr, int fq) const {
        bf16* yp = y + ((size_t)u.a1 * BM + wr * 64 + fr) * D + u.pn * BM + wc * 32 + 8 * fq;
#pragma unroll
        for (int ai = 0; ai < 2; ++ai)
#pragma unroll
            for (int m = 0; m < 4; ++m)
#pragma unroll
                for (int bj = 0; bj < 2; ++bj) { const f32x4 v0 = acc[ai][bj][m][0], v1 = acc[ai][bj][m][1];
                    u32x4 w; w.x = cvt_pk_bf16(v0[0], v0[1]); w.y = cvt_pk_bf16(v0[2], v0[3]); w.z = cvt_pk_bf16(v1[0], v1[1]); w.w = cvt_pk_bf16(v1[2], v1[3]);
                    *(u32x4*)(yp + (size_t)(ai * HALF + m * 16) * D + bj * HALF) = w; }
    }
};
__device__ __forceinline__ void combine_phase(bf16* hb, const bf16* y, const unsigned* binpos, const float* gatew, const LAS int* tab, float* out32, float* rs_out, int gw, int ngw, int lane) {
    for (int tk = gw; tk < T; tk += ngw) {
        const unsigned bp0 = binpos[tk * 2], bp1 = binpos[tk * 2 + 1]; const float g0 = gatew[tk * 2], g1 = gatew[tk * 2 + 1];
        const size_t r0 = (size_t)tab[64 + (bp0 >> 16)] * BM + (bp0 & 0xffffu), r1 = (size_t)tab[64 + (bp1 >> 16)] * BM + (bp1 & 0xffffu);
        GAS u32x4* hp = (GAS u32x4*)(hb + (size_t)tk * D) + lane;
        const GAS u32x4* y0 = (const GAS u32x4*)(y + r0 * D) + lane; const GAS u32x4* y1 = (const GAS u32x4*)(y + r1 * D) + lane;
        u32x4 hh[2], a[2], b[2];
#pragma unroll
        for (int j = 0; j < 2; ++j) { hh[j] = hp[64 * j]; a[j] = y0[64 * j]; b[j] = y1[64 * j]; }
        float v[2][8]; float s = 0.f;
#pragma unroll
        for (int j = 0; j < 2; ++j) {
            v[j][0] = bf_lo(hh[j].x) + g0 * bf_lo(a[j].x) + g1 * bf_lo(b[j].x); v[j][1] = bf_hi(hh[j].x) + g0 * bf_hi(a[j].x) + g1 * bf_hi(b[j].x);
            v[j][2] = bf_lo(hh[j].y) + g0 * bf_lo(a[j].y) + g1 * bf_lo(b[j].y); v[j][3] = bf_hi(hh[j].y) + g0 * bf_hi(a[j].y) + g1 * bf_hi(b[j].y);
            v[j][4] = bf_lo(hh[j].z) + g0 * bf_lo(a[j].z) + g1 * bf_lo(b[j].z); v[j][5] = bf_hi(hh[j].z) + g0 * bf_hi(a[j].z) + g1 * bf_hi(b[j].z);
            v[j][6] = bf_lo(hh[j].w) + g0 * bf_lo(a[j].w) + g1 * bf_lo(b[j].w); v[j][7] = bf_hi(hh[j].w) + g0 * bf_hi(a[j].w) + g1 * bf_hi(b[j].w);
#pragma unroll
            for (int e = 0; e < 8; ++e) s += v[j][e] * v[j][e]; }
        if (out32) { GAS f32x4* op = (GAS f32x4*)(out32 + (size_t)tk * D) + 2 * lane;
#pragma unroll
            for (int j = 0; j < 2; ++j) { op[128 * j] = (f32x4){v[j][0], v[j][1], v[j][2], v[j][3]}; op[128 * j + 1] = (f32x4){v[j][4], v[j][5], v[j][6], v[j][7]}; } }
        else {
#pragma unroll
            for (int j = 0; j < 2; ++j) { u32x4 w; w.x = cvt_pk_bf16(v[j][0], v[j][1]); w.y = cvt_pk_bf16(v[j][2], v[j][3]); w.z = cvt_pk_bf16(v[j][4], v[j][5]); w.w = cvt_pk_bf16(v[j][6], v[j][7]); hp[64 * j] = w; }
            const float rs = __builtin_amdgcn_rsqf(wave_sum(s) * (1.f / D) + 1e-6f); if (lane == 0) rs_out[tk] = rs; }
    }
}

struct MapId { int off; __device__ __forceinline__ int row(int n) const { return n + off; } __device__ __forceinline__ float scale(int) const { return 1.0f; } };
struct MapWin { __device__ __forceinline__ int row(int n) const { if (n >= 2048) return n; const int d = n & 255; return (n & ~255) + ((d < 128) ? 2 * d : 2 * (d - 128) + 1); }
                __device__ __forceinline__ float scale(int n) const { return (n >= 1024 && n < 2048) ? 0.0625f : 1.0f; } };
struct MapQkv1 { int base; __device__ __forceinline__ int row(int n) const { const int two = n / 3072, n1 = n % 3072, g = n1 >> 10, h = (n1 >> 6) & 15, d = n1 & 63;
                     return base + two * 3072 + (g * 4 + (h >> 2)) * 256 + 32 * (h & 3) + (d & 31) + 128 * (d >> 5); }
                 __device__ __forceinline__ float scale(int) const { return 1.0f; } };
struct MapGu { int up; __device__ __forceinline__ int row(int f) const { return (f >> 7) * 256 + (f & 127) + 128 * up; }     __device__ __forceinline__ float scale(int) const { return 1.0f; } };
__device__ __forceinline__ void transpose_load(const float* W, int N, int item, int lane, f32x4 (&v)[16]) {
    const int nblk = N / 64, kb = item / nblk, nb = item % nblk, k0 = 64 * kb, n0 = 64 * nb;
#pragma unroll
    for (int i = 0; i < 16; ++i) v[i] = __builtin_nontemporal_load((const GAS f32x4*)(W + (size_t)(k0 + 4 * i + (lane >> 4)) * N + n0 + 4 * (lane & 15)));
}
template <class Map>
__device__ __forceinline__ void transpose_finish(const f32x4 (&v)[16], int N, bf16* WT, int ldt, LAS float* scr, int item, int lane, const float* gain, const Map mp) {
    const int nblk = N / 64, kb = item / nblk, nb = item % nblk, k0 = 64 * kb, n0 = 64 * nb;
#pragma unroll
    for (int i = 0; i < 16; ++i) { const int kk = 4 * i + (lane >> 4); const float gg = gain ? gain[k0 + kk] : 1.0f; LAS float* d = scr + kk * 65 + 4 * (lane & 15);
        d[0] = v[i][0] * gg; d[1] = v[i][1] * gg; d[2] = v[i][2] * gg; d[3] = v[i][3] * gg; }
    LDS_WAIT(); asm volatile("" ::: "memory");
    const int c = lane & 7;
#pragma unroll
    for (int j = 0; j < 8; ++j) { const int n = (lane >> 3) + 8 * j; const LAS float* s = scr + (8 * c) * 65 + n; const float sc = mp.scale(n0 + n);
        u32x4 o; o.x = pk2(s[0 * 65] * sc, s[1 * 65] * sc); o.y = pk2(s[2 * 65] * sc, s[3 * 65] * sc); o.z = pk2(s[4 * 65] * sc, s[5 * 65] * sc); o.w = pk2(s[6 * 65] * sc, s[7 * 65] * sc);
        *(GAS u32x4*)(WT + (size_t)mp.row(n0 + n) * ldt + k0 + 8 * c) = o; }
    LDS_WAIT(); asm volatile("" ::: "memory");
}
template <class Map>
__device__ __forceinline__ void transpose_item(const float* W, int N, bf16* WT, int ldt, LAS float* scr, int item, int lane, const float* gain, const Map mp) {
    f32x4 v[16]; transpose_load(W, N, item, lane, v); transpose_finish(v, N, WT, ldt, scr, item, lane, gain, mp);
}
template <class Map>
__device__ __forceinline__ void transpose_matrix(const float* W, int K, int N, bf16* WT, LAS float* scr, int gw, int ngw, int lane, const float* gain, const Map mp) {
    const int nitems = (K / 64) * (N / 64);
    if (gw >= nitems) return;
    f32x4 v[16]; transpose_load(W, N, gw, lane, v);
    for (int it = gw; it < nitems; it += ngw) { f32x4 cur[16];
#pragma unroll
        for (int i = 0; i < 16; ++i) cur[i] = v[i];
        if (it + ngw < nitems) transpose_load(W, N, it + ngw, lane, v);
        transpose_finish(cur, N, WT, K, scr, it, lane, gain, mp); }
}
__device__ __forceinline__ void rms_row_to_bf16(const float* xrow, bf16* orow, int lane) {
    const GAS f32x4* xr = (const GAS f32x4*)xrow + lane;
    f32x4 v[4]; float s = 0.f;
#pragma unroll
    for (int j = 0; j < 4; ++j) { v[j] = xr[64 * j]; s += (v[j].x * v[j].x + v[j].y * v[j].y) + (v[j].z * v[j].z + v[j].w * v[j].w); }
    const float rs = __builtin_amdgcn_rsqf(wave_sum(s) * (1.f / D) + 1e-6f);
    GAS unsigned long long* o8 = (GAS unsigned long long*)orow + lane;
#pragma unroll
    for (int j = 0; j < 4; ++j) o8[64 * j] = (unsigned long long)pk2(v[j].x * rs, v[j].y * rs) | ((unsigned long long)pk2(v[j].z * rs, v[j].w * rs) << 32);
}
__device__ __forceinline__ unsigned swz(int row, int bytecol, int stride) { return (unsigned)(row * stride + ((((bytecol >> 4) ^ (row & 7)) << 4) | (bytecol & 15))); }
__device__ __forceinline__ unsigned swzb(int row, int bytecol, int stride) { return (unsigned)(row * stride + ((((bytecol >> 4) ^ (((row & 3) << 1) | (row & 8))) << 4) | (bytecol & 15))); }
__device__ __forceinline__ bf16x8 fragb_row(const LAS unsigned char* img, int row0, int bytecol0, int stride, int fr, int fq) {
    return *(const LAS bf16x8*)(img + swzb(row0 + fr, bytecol0 + 16 * fq, stride));
}
__device__ __forceinline__ bf16x8 fragb_tr(const LAS unsigned char* img, int k0, int c0, int stride, int lane) {
    const int fq = lane >> 4, q = (lane & 15) >> 2, p = lane & 3;
    const s16x4 lo = __builtin_amdgcn_ds_read_tr16_b64_v4i16((LAS s16x4*)(img + swzb(k0 + 8 * fq + q, (c0 + 4 * p) * 2, stride)));
    const s16x4 hi = __builtin_amdgcn_ds_read_tr16_b64_v4i16((LAS s16x4*)(img + swzb(k0 + 8 * fq + 4 + q, (c0 + 4 * p) * 2, stride)));
    return (bf16x8){lo[0], lo[1], lo[2], lo[3], hi[0], hi[1], hi[2], hi[3]};
}
__device__ __forceinline__ bf16x8 frag_row(const LAS unsigned char* img, int row0, int bytecol0, int stride, int fr, int fq) {
    return *(const LAS bf16x8*)(img + swz(row0 + fr, bytecol0 + 16 * fq, stride));
}
__device__ __forceinline__ bf16x8 frag_tr2(const LAS unsigned char* img, int rowa, int rowb, int c0, int stride, int lane) {
    const int fq = lane >> 4, q = (lane & 15) >> 2, p = lane & 3;
    const s16x4 lo = __builtin_amdgcn_ds_read_tr16_b64_v4i16((LAS s16x4*)(img + swz(rowa + 4 * fq + q, (c0 + 4 * p) * 2, stride)));
    const s16x4 hi = __builtin_amdgcn_ds_read_tr16_b64_v4i16((LAS s16x4*)(img + swz(rowb + 4 * fq + q, (c0 + 4 * p) * 2, stride)));
    return (bf16x8){lo[0], lo[1], lo[2], lo[3], hi[0], hi[1], hi[2], hi[3]};
}
__device__ __forceinline__ bf16x8 frag_tr(const LAS unsigned char* img, int k0, int c0, int stride, int lane) {
    const int fq = lane >> 4; return frag_tr2(img, k0 + 4 * fq, k0 + 4 * fq + 4, c0, stride, lane);
}
#define MFMA16(a, b, c) __builtin_amdgcn_mfma_f32_16x16x32_bf16((a), (b), (c), 0, 0, 0)

__device__ __forceinline__ int xt4(int row) { return (0x1230 >> (((row >> 2) & 3) * 4)) & 3; }
__device__ __forceinline__ unsigned pnl(int row, int col, int PS) { return (unsigned)((col >> 5) * PS + row * 64 + (((((col & 31) >> 3)) ^ xt4(row)) << 4) + (col & 7) * 2); }
#define TRREAD(p) __builtin_amdgcn_ds_read_tr16_b64_v4i16((LAS s16x4*)(p))
__device__ __forceinline__ bf16x8 mk8(s16x4 lo, s16x4 hi) { return (bf16x8){lo[0], lo[1], lo[2], lo[3], hi[0], hi[1], hi[2], hi[3]}; }

__device__ __forceinline__ void retention_phase(LAS unsigned char* lds, const bf16* qg, const bf16* kg, bf16* vg, float* ssq, int G, int bx, const int tid, const bool dry = false) {
    const int lane = tid & 63, w = __builtin_amdgcn_readfirstlane(tid >> 6), fr = lane & 15, fq = lane >> 4, q4 = (lane & 15) >> 2, p4 = lane & 3;
    const int tq = w & 3, hv = w >> 2;
    LAS unsigned char* QI = lds; LAS unsigned char* KI = lds + 32768; LAS unsigned char* VI = lds + 65536; LAS unsigned char* PI = lds + 81920; LAS unsigned char* ZI = lds + 90112;
    const unsigned LBr = (unsigned)(fr * 64 + ((fq ^ xt4(fr)) << 4));
    const unsigned TB1 = (unsigned)((8 * fq + q4) * 64 + (((p4 >> 1) ^ xt4(8 * fq + q4)) << 4) + 8 * (p4 & 1));
    const unsigned TB2 = (unsigned)((8 * fq + 4 + q4) * 64 + (((p4 >> 1) ^ xt4(8 * fq + 4 + q4)) << 4) + 8 * (p4 & 1));
    const unsigned LBz = (unsigned)(fr * 64 + (((2 * (w & 1) + (fq >> 1)) ^ xt4(fr)) << 4) + 8 * (fq & 1) + (w >> 1) * 16384);
    const unsigned LBp = (unsigned)(fr * 64 + (((fq >> 1) ^ xt4(fr)) << 4) + 8 * (fq & 1) + hv * 4096 + tq * 1024);
    const unsigned TW1 = TB1 ^ ((w & 1) * 32), TW2 = TB2 ^ ((w & 1) * 32);
    for (int u = bx; u < 256; u += G) {
        const int b = u >> 4, h = (u >> 2) & 3, vs = u & 3;
        const float g64 = __builtin_amdgcn_exp2f(64.0f * head_l2g(h));
        f32x4 Z[16];
#pragma unroll
        for (int i = 0; i < 16; ++i) Z[i] = (f32x4){0.f, 0.f, 0.f, 0.f};
        u32x4 pq[4], pk[4], pv[2];
        const bf16* qh = qg + (size_t)b * SEQ * 1024 + h * 256; const bf16* kh = kg + (size_t)b * SEQ * 1024 + h * 256;
        bf16* vh = vg + (size_t)b * SEQ * 2048 + h * 512 + vs * 128;
#define RET_LOAD(sc) do { _Pragma("unroll") for (int i = 0; i < 4; ++i) { const int pid = tid + 512 * i, r = pid >> 5, c = pid & 31; \
            pq[i] = *(const u32x4*)(qh + (size_t)((sc) * 64 + r) * 1024 + c * 8); pk[i] = *(const u32x4*)(kh + (size_t)((sc) * 64 + r) * 1024 + c * 8); } \
        _Pragma("unroll") for (int i = 0; i < 2; ++i) { const int pid = tid + 512 * i, r = pid >> 4, c = pid & 15; pv[i] = *(const u32x4*)(vh + (size_t)((sc) * 64 + r) * 2048 + c * 8); } } while (0)
        RET_LOAD(0);
        for (int sc = 0; sc < 32; ++sc) {
            LDS_BARRIER();
#pragma unroll
            for (int i = 0; i < 4; ++i) { const int pid = tid + 512 * i, r = pid >> 5, c = pid & 31; const unsigned o = pnl(r, 8 * c, 4096); *(LAS u32x4*)(QI + o) = pq[i]; *(LAS u32x4*)(KI + o) = pk[i]; }
#pragma unroll
            for (int i = 0; i < 2; ++i) { const int pid = tid + 512 * i, r = pid >> 4, c = pid & 15; *(LAS u32x4*)(VI + pnl(r, 8 * c, 4096)) = pv[i]; }
#pragma unroll
            for (int dt = 0; dt < 16; ++dt) { u32x2 zz; zz.x = cvt_pk_bf16(Z[dt][0], Z[dt][1]); zz.y = cvt_pk_bf16(Z[dt][2], Z[dt][3]); *(LAS u32x2*)(ZI + LBz + dt * 1024) = zz; }
#ifndef RET_EXP
#define RET_EXP 0
#endif
            if (sc + 1 < 32 && !(RET_EXP & 16)) RET_LOAD(sc + 1);
            LDS_BARRIER();
            const LAS unsigned char* qrow = QI + LBr + tq * 1024;
#pragma unroll
            for (int mi = 0; mi < 2; ++mi) { const int mt = 2 * hv + mi; f32x4 s = (f32x4){0.f, 0.f, 0.f, 0.f};
                if (mt <= tq) { const LAS unsigned char* krow = KI + LBr + mt * 1024;
#pragma unroll
                    for (int ks = 0; ks < 8; ++ks) s = MFMA16(*(const LAS bf16x8*)(krow + ks * 4096), *(const LAS bf16x8*)(qrow + ks * 4096), s);
                    if (mt == tq) {
#pragma unroll
                        for (int r = 0; r < 4; ++r) if (4 * fq + r > fr) s[r] = 0.f; }
                }
                u32x2 pp; pp.x = cvt_pk_bf16(s[0], s[1]); pp.y = cvt_pk_bf16(s[2], s[3]); *(LAS u32x2*)(PI + (LBp ^ (mi * 32))) = pp; }
            bf16x8 va[2];
            if (!(RET_EXP & 1)) {
#pragma unroll
            for (int k2 = 0; k2 < 2; ++k2) va[k2] = mk8(TRREAD(VI + TW1 + (w >> 1) * 4096 + k2 * 2048), TRREAD(VI + TW2 + (w >> 1) * 4096 + k2 * 2048));
#define RET_KB(dt, k2) mk8(TRREAD(KI + (TB1 ^ (((dt) & 1) * 32)) + ((dt) >> 1) * 4096 + (k2) * 2048), TRREAD(KI + (TB2 ^ (((dt) & 1) * 32)) + ((dt) >> 1) * 4096 + (k2) * 2048))
            {
#pragma unroll
              for (int dt = 0; dt < 16; ++dt) { const bf16x8 c0 = RET_KB(dt, 0), c1 = RET_KB(dt, 1);
                  Z[dt] = Z[dt] * g64; Z[dt] = MFMA16(va[0], c0, Z[dt]); Z[dt] = MFMA16(va[1], c1, Z[dt]); }
              __builtin_amdgcn_sched_group_barrier(0x100, 8, 0);
#pragma unroll
              for (int i = 0; i < 14; ++i) { __builtin_amdgcn_sched_group_barrier(0x008, 2, 0); __builtin_amdgcn_sched_group_barrier(0x100, 4, 0); }
#pragma unroll
              for (int i = 0; i < 2; ++i) __builtin_amdgcn_sched_group_barrier(0x008, 2, 0);
            }
#undef RET_KB
            }
            f32x4 o[4];
#pragma unroll
            for (int vt = 0; vt < 4; ++vt) o[vt] = (f32x4){0.f, 0.f, 0.f, 0.f};
            if (!(RET_EXP & 2)) {
#define RET_ZA(vt, ks) mk8(TRREAD(ZI + (TB1 ^ (((vt) & 1) * 32)) + (2 * hv + ((vt) >> 1)) * 16384 + (ks) * 2048), TRREAD(ZI + (TB2 ^ (((vt) & 1) * 32)) + (2 * hv + ((vt) >> 1)) * 16384 + (ks) * 2048))
            {
#pragma unroll
              for (int ks = 0; ks < 8; ++ks) { const bf16x8 cq = *(const LAS bf16x8*)(qrow + ks * 4096);
#pragma unroll
                  for (int vt = 0; vt < 4; ++vt) o[vt] = MFMA16(RET_ZA(vt, ks), cq, o[vt]); }
              __builtin_amdgcn_sched_group_barrier(0x100, 9, 0);
#pragma unroll
              for (int i = 0; i < 7; ++i) { __builtin_amdgcn_sched_group_barrier(0x008, 4, 0); __builtin_amdgcn_sched_group_barrier(0x100, 9, 0); }
              __builtin_amdgcn_sched_group_barrier(0x008, 4, 0);
            }
#undef RET_ZA
            }
            LDS_BARRIER();
#pragma unroll
            for (int vt = 0; vt < 4; ++vt) o[vt] = o[vt] * g64;
#pragma unroll
            for (int k2 = 0; k2 < 2; ++k2) if (32 * k2 <= 16 * tq + 15) { const bf16x8 pb = *(const LAS bf16x8*)(PI + LBr + tq * 1024 + k2 * 4096);
#pragma unroll
                for (int vt = 0; vt < 4; ++vt) o[vt] = MFMA16(mk8(TRREAD(VI + (TB1 ^ ((vt & 1) * 32)) + (2 * hv + (vt >> 1)) * 4096 + k2 * 2048), TRREAD(VI + (TB2 ^ ((vt & 1) * 32)) + (2 * hv + (vt >> 1)) * 4096 + k2 * 2048)), pb, o[vt]); }
            const int tokl = sc * 64 + 16 * tq + fr; float ss = 0.f;
#pragma unroll
            for (int vt = 0; vt < 4; ++vt) ss += (o[vt][0] * o[vt][0] + o[vt][1] * o[vt][1]) + (o[vt][2] * o[vt][2] + o[vt][3] * o[vt][3]);
#pragma unroll
            for (int vp = 0; vp < 2; ++vp) {
                unsigned x0 = cvt_pk_bf16(o[2 * vp][0], o[2 * vp][1]), x1 = cvt_pk_bf16(o[2 * vp][2], o[2 * vp][3]), y0 = cvt_pk_bf16(o[2 * vp + 1][0], o[2 * vp + 1][1]), y1 = cvt_pk_bf16(o[2 * vp + 1][2], o[2 * vp + 1][3]);
                const auto s0 = __builtin_amdgcn_permlane16_swap(x0, y0, false, false), s1 = __builtin_amdgcn_permlane16_swap(x1, y1, false, false);
                u32x4 ww; ww.x = s0[0]; ww.y = s1[0]; ww.z = s0[1]; ww.w = s1[1];
                if (!dry) *(u32x4*)(vh + (size_t)tokl * 2048 + 16 * (4 * hv + 2 * vp + (fq & 1)) + 4 * (fq & ~1)) = ww; }
            ss = xsum32(xsum16(ss));
            if (fq == 0 && !dry) ssq[(((size_t)(b * SEQ + tokl) * 4 + h) * 4 + vs) * 2 + hv] = ss;
        }
#undef RET_LOAD
        LDS_BARRIER();
    }
}

__device__ __forceinline__ int t5_bucket(int n) { if (n < 16) return n; const int l = 16 + (int)(__builtin_log2f((float)n * 0.0625f) * (16.0f / 7.0f)); return l > 31 ? 31 : l; }
__device__ __forceinline__ void attn_phase(LAS unsigned char* lds, bf16* qb, const bf16* kb, const bf16* vb, f32x2* ml, const float* rel_bias, int G, int bx, const int tid, const bool dry = false) {
    const int lane = tid & 63, w = __builtin_amdgcn_readfirstlane(tid >> 6), fr = lane & 15, fq = lane >> 4, q4 = (lane & 15) >> 2, p4 = lane & 3;
    LAS unsigned char* KI = lds; LAS unsigned char* VI = lds + 49152; LAS float* BT = (LAS float*)(lds + 98304);
    const unsigned LBr = (unsigned)(fr * 64 + ((fq ^ xt4(fr)) << 4));
    const unsigned TBa = (unsigned)((4 * fq + q4) * 64 + (((p4 >> 1) ^ xt4(4 * fq + q4)) << 4) + 8 * (p4 & 1));
    const LAS float* btl = BT + (fr + 144 - 4 * fq);
    for (int unit = bx; unit < 1536; unit += G) {
        const int u4 = unit & 3, g = (unit >> 2) % 3, rest = unit / 12, h = rest & 15, bl = rest >> 4;
        const int R = g == 0 ? 1 : (g == 1 ? 4 : 16);
        LDS_BARRIER();
        if (tid < 160) { const int steps = tid - 16; BT[tid] = (steps >= 0 && steps <= 128) ? rel_bias[t5_bucket(steps * R) * 48 + g * 16 + h] * 1.4426950408889634f : -1e30f; }
        LDS_BARRIER();
        float bias[36];
#pragma unroll
        for (int j = 0; j < 9; ++j)
#pragma unroll
            for (int rr = 0; rr < 4; ++rr) bias[4 * j + rr] = btl[-16 * j - rr];
        const int s_first = (g == 0 && u4 > 0) ? -1 : 0;
        const size_t sl = ((size_t)(bl * 3 + g) * 16 + h) * (SEQ * 64);
        const bf16* kbase = kb + sl; const bf16* vbase = vb + sl; bf16* qbase = qb + sl;
        const int LR = SEQ / R;
        u32x4 pk[2], pv[2]; bf16x8 qn[2];
#define ATT_SEG(s, r, n) do { if (g == 0) { r = 0; n = 4 * u4 + (s); } else if (g == 1) { r = u4; n = (s); } else { r = 4 * u4 + (s); n = 0; } } while (0)
#define ATT_LOAD(s) do { int r_, n_; ATT_SEG(s, r_, n_); _Pragma("unroll") for (int i = 0; i < 2; ++i) { const int pid = tid + 512 * i, row = pid >> 3, c = pid & 7; \
            const size_t off = (size_t)(r_ * LR + 128 * n_ + row) * 64 + c * 8; pk[i] = *(const u32x4*)(kbase + off); pv[i] = *(const u32x4*)(vbase + off); } \
            if ((s) >= 0) { const bf16* qp_ = qbase + (size_t)(r_ * LR + 128 * n_ + 16 * w + fr) * 64 + fq * 8; qn[0] = *(const bf16x8*)qp_; qn[1] = *(const bf16x8*)(qp_ + 32); } } while (0)
        ATT_LOAD(s_first);
        int cnt = 0;
        for (int s = s_first; s < 4; ++s, ++cnt) {
            const int cs = cnt % 3, ps = (cnt + 2) % 3;
#pragma unroll
            for (int i = 0; i < 2; ++i) { const int pid = tid + 512 * i, row = pid >> 3, c = pid & 7; const unsigned o = pnl(cs * 128 + row, 8 * c, 24576); *(LAS u32x4*)(KI + o) = pk[i]; *(LAS u32x4*)(VI + o) = pv[i]; }
            bf16x8 qf[2]; qf[0] = qn[0]; qf[1] = qn[1];
            if (s < 3) ATT_LOAD(s + 1);
            LDS_BARRIER();
            if (s < 0) continue;
            int r, n; ATT_SEG(s, r, n);
            const bool has_prev = n > 0;
            const size_t grow = (size_t)bl * SEQ + (size_t)(128 * n + 16 * w + fr) * R + r;
            bf16* qptr = qbase + (size_t)(r * LR + 128 * n + 16 * w + fr) * 64;
            f32x4 sc[9]; float mx = -1e30f;
            { bf16x8 kf[9][2];
#pragma unroll
              for (int j = 0; j < 9; ++j) { const int kt = w + j; const int rb = (kt < 8) ? (has_prev ? ps * 128 + 16 * kt : cs * 128 + 16 * kt) : cs * 128 + 16 * (kt - 8);
                  const LAS unsigned char* kr = KI + LBr + rb * 64; kf[j][0] = *(const LAS bf16x8*)kr; kf[j][1] = *(const LAS bf16x8*)(kr + 24576); }
#pragma unroll
              for (int j = 0; j < 9; ++j) { f32x4 a = (f32x4){0.f, 0.f, 0.f, 0.f}; a = MFMA16(kf[j][0], qf[0], a); a = MFMA16(kf[j][1], qf[1], a); sc[j] = a; } }
#pragma unroll
            for (int j = 0; j < 9; ++j) { const bool valid = has_prev || (w + j) >= 8;
#pragma unroll
                for (int rr = 0; rr < 4; ++rr) { const float v = valid ? sc[j][rr] + bias[4 * j + rr] : -1e30f; sc[j][rr] = v; mx = fmaxf(mx, v); } }
            mx = xmax32(xmax16(mx));
            float lsum = 0.f;
#pragma unroll
            for (int j = 0; j < 9; ++j)
#pragma unroll
                for (int rr = 0; rr < 4; ++rr) { const float p = __builtin_amdgcn_exp2f(sc[j][rr] - mx); sc[j][rr] = p; lsum += p; }
            lsum = xsum32(xsum16(lsum));
            f32x4 o[4];
#pragma unroll
            for (int dt = 0; dt < 4; ++dt) o[dt] = (f32x4){0.f, 0.f, 0.f, 0.f};
#pragma unroll
            for (int jj = 0; jj < 5; ++jj) { const int t0 = 2 * jj, t1 = 2 * jj + 1;
                union { bf16x8 v; unsigned u[4]; } pb;
                pb.u[0] = cvt_pk_bf16(sc[t0][0], sc[t0][1]); pb.u[1] = cvt_pk_bf16(sc[t0][2], sc[t0][3]);
                if (t1 < 9) { pb.u[2] = cvt_pk_bf16(sc[t1 < 9 ? t1 : 8][0], sc[t1 < 9 ? t1 : 8][1]); pb.u[3] = cvt_pk_bf16(sc[t1 < 9 ? t1 : 8][2], sc[t1 < 9 ? t1 : 8][3]); } else { pb.u[2] = 0u; pb.u[3] = 0u; }
                int kt0 = w + t0, kt1 = w + t1; if (kt1 > 15) kt1 = 15;
                const bool v0 = has_prev || kt0 >= 8, v1 = has_prev || kt1 >= 8;
                const int rb0 = (kt0 < 8) ? (v0 ? ps * 128 + 16 * kt0 : cs * 128 + 16 * kt0) : cs * 128 + 16 * (kt0 - 8);
                const int rb1 = (kt1 < 8) ? (v1 ? ps * 128 + 16 * kt1 : cs * 128 + 16 * kt1) : cs * 128 + 16 * (kt1 - 8);
                const LAS unsigned char* va = VI + rb0 * 64; const LAS unsigned char* vb2 = VI + rb1 * 64;
#pragma unroll
                for (int dt = 0; dt < 4; ++dt) o[dt] = MFMA16(mk8(TRREAD(va + (TBa ^ ((dt & 1) * 32)) + (dt >> 1) * 24576), TRREAD(vb2 + (TBa ^ ((dt & 1) * 32)) + (dt >> 1) * 24576)), pb.v, o[dt]); }
            const float il = 1.0f / lsum;
#pragma unroll
            for (int dp = 0; dp < 2; ++dp) {
                unsigned x0 = cvt_pk_bf16(o[2 * dp][0] * il, o[2 * dp][1] * il), x1 = cvt_pk_bf16(o[2 * dp][2] * il, o[2 * dp][3] * il);
                unsigned y0 = cvt_pk_bf16(o[2 * dp + 1][0] * il, o[2 * dp + 1][1] * il), y1 = cvt_pk_bf16(o[2 * dp + 1][2] * il, o[2 * dp + 1][3] * il);
                const auto s0 = __builtin_amdgcn_permlane16_swap(x0, y0, false, false), s1 = __builtin_amdgcn_permlane16_swap(x1, y1, false, false);
                u32x4 ww; ww.x = s0[0]; ww.y = s1[0]; ww.z = s0[1]; ww.w = s1[1];
                if (!dry) *(u32x4*)(qptr + 16 * (2 * dp + (fq & 1)) + 4 * (fq & ~1)) = ww; }
            if (fq == 0 && !dry) ml[(grow * 3 + g) * 16 + h] = (f32x2){mx, lsum};
        }
#undef ATT_SEG
#undef ATT_LOAD
    }
    LDS_BARRIER();
}
__device__ __forceinline__ void merge_phase(const bf16* qb, const f32x2* ml, bf16* out, int G, int bx, const int tid) {
    const size_t nitems = (size_t)TC * 16 * 8;
    for (size_t it = (size_t)bx * 512 + tid; it < nitems; it += (size_t)G * 512) {
        const int pc = (int)(it & 7), h = (int)((it >> 3) & 15); const size_t tok = it >> 7; const int bl = (int)(tok >> 11), t = (int)(tok & (SEQ - 1));
        f32x2 a[3]; float M = -3e38f;
#pragma unroll
        for (int g = 0; g < 3; ++g) { a[g] = ml[(tok * 3 + g) * 16 + h]; M = fmaxf(M, a[g].x); }
        float wg[3], W = 0.f;
#pragma unroll
        for (int g = 0; g < 3; ++g) { wg[g] = __builtin_amdgcn_exp2f(a[g].x - M) * a[g].y; W += wg[g]; }
        const float iw = 1.0f / W; float acc[8];
#pragma unroll
        for (int e = 0; e < 8; ++e) acc[e] = 0.f;
#pragma unroll
        for (int g = 0; g < 3; ++g) { const int sh = g == 0 ? 0 : (g == 1 ? 2 : 4), pos = (t & ((1 << sh) - 1)) * (SEQ >> sh) + (t >> sh);
            const u32x4 o = *(const u32x4*)(qb + (((size_t)(bl * 3 + g) * 16 + h) * SEQ + pos) * 64 + pc * 8); const float ww = wg[g] * iw;
            acc[0] += ww * bf_lo(o.x); acc[1] += ww * bf_hi(o.x); acc[2] += ww * bf_lo(o.y); acc[3] += ww * bf_hi(o.y); acc[4] += ww * bf_lo(o.z); acc[5] += ww * bf_hi(o.z); acc[6] += ww * bf_lo(o.w); acc[7] += ww * bf_hi(o.w); }
        u32x4 r; r.x = cvt_pk_bf16(acc[0], acc[1]); r.y = cvt_pk_bf16(acc[2], acc[3]); r.z = cvt_pk_bf16(acc[4], acc[5]); r.w = cvt_pk_bf16(acc[6], acc[7]);
        *(u32x4*)(out + tok * 1024 + h * 64 + pc * 8) = r;
    }
}
__device__ __forceinline__ void router_phase(LAS unsigned char* lds, const bf16* wrh, const bf16* wrl, const float* bg, const float* be, const bf16* hb, int* list, float* gatew, unsigned* cnt, int G, int vcu, const int tid) {
    const int lane = tid & 63, w = __builtin_amdgcn_readfirstlane(tid >> 6), fr = lane & 15, fq = lane >> 4;
    LAS unsigned char* WH = lds; LAS unsigned char* WL = lds + 49152; LAS float* LG = (LAS float*)(lds + 98304 + w * 3072);
    const int nround = (T / 16 + G * NWAVES - 1) / (G * NWAVES);
    LAS unsigned* BC = (LAS unsigned*)(lds + 122880); LAS unsigned* BB = BC + 32;
    for (int rd = 0; rd < nround; ++rd) {
        const int mt = rd * G * NWAVES + vcu * NWAVES + w; const bool active = mt < T / 16;
        if (tid < 32) BC[tid] = 0u;
        int b0 = 0, b1 = 0; unsigned l0 = 0u, l1 = 0u; float gw0 = 0.f, gw1 = 0.f, rsk = 0.f;
        f32x4 acc[3]; float ss = 0.f;
#pragma unroll
        for (int i = 0; i < 3; ++i) acc[i] = (f32x4){0.f, 0.f, 0.f, 0.f};
        for (int kh = 0; kh < 2; ++kh) {
            LDS_BARRIER();
#pragma unroll
            for (int i = 0; i < 6; ++i) { const int pid = tid + 512 * i, row = pid >> 6, c = pid & 63;
                *(LAS u32x4*)(WH + swzb(row, c * 16, 1024)) = *(const u32x4*)(wrh + (size_t)row * 1024 + kh * 512 + c * 8);
                *(LAS u32x4*)(WL + swzb(row, c * 16, 1024)) = *(const u32x4*)(wrl + (size_t)row * 1024 + kh * 512 + c * 8); }
            LDS_BARRIER();
            if (active) {
                const bf16* hp = hb + (size_t)(mt * 16 + fr) * D + kh * 512 + 8 * fq;
                union { bf16x8 v; u32x4 u; } ah[16];
#pragma unroll
                for (int ks = 0; ks < 16; ++ks) ah[ks].u = *(const GAS u32x4*)(hp + 32 * ks);
#pragma unroll
                for (int ks = 0; ks < 16; ++ks) {
                    { const u32x4 a = ah[ks].u; const float a0 = bf_lo(a.x), a1 = bf_hi(a.x), a2 = bf_lo(a.y), a3 = bf_hi(a.y), a4 = bf_lo(a.z), a5 = bf_hi(a.z), a6 = bf_lo(a.w), a7 = bf_hi(a.w);
                      ss += ((a0 * a0 + a1 * a1) + (a2 * a2 + a3 * a3)) + ((a4 * a4 + a5 * a5) + (a6 * a6 + a7 * a7)); }
#pragma unroll
                    for (int nt = 0; nt < 3; ++nt) { const bf16x8 bh = fragb_row(WH, 16 * nt, ks * 64, 1024, fr, fq), bl = fragb_row(WL, 16 * nt, ks * 64, 1024, fr, fq);
                        acc[nt] = MFMA16(ah[ks].v, bh, acc[nt]); acc[nt] = MFMA16(ah[ks].v, bl, acc[nt]); }
                }
            }
        }
        if (active) {
            ss = xsum32(xsum16(ss));
            const float rs = __builtin_amdgcn_rsqf(ss * (1.f / D) + 1e-6f);
#pragma unroll
            for (int nt = 0; nt < 3; ++nt)
#pragma unroll
                for (int r = 0; r < 4; ++r) LG[(4 * fq + r) * 48 + 16 * nt + fr] = acc[nt][r];
            LDS_WAIT(); asm volatile("" ::: "memory");
            if (lane < 16) {
                const int tk = mt * 16 + lane; float a[36];
#pragma unroll
                for (int q = 0; q < 9; ++q) { const f32x4 t4 = *(const LAS f32x4*)(LG + lane * 48 + 4 * q); a[4 * q] = t4[0] * rs; a[4 * q + 1] = t4[1] * rs; a[4 * q + 2] = t4[2] * rs; a[4 * q + 3] = t4[3] * rs; }
                float gl[4];
#pragma unroll
                for (int g = 0; g < 4; ++g) gl[g] = a[g] + bg[g];
                int grp = 0; float gbest = gl[0];
#pragma unroll
                for (int g = 1; g < 4; ++g) if (gl[g] > gbest) { gbest = gl[g]; grp = g; }
                float den = 0.f;
#pragma unroll
                for (int g = 0; g < 4; ++g) den += __expf(gl[g] - gbest);
                const float pg = 1.0f / den;
                float el[8];
#pragma unroll
                for (int e = 0; e < 8; ++e) { float vv = 0.f;
#pragma unroll
                    for (int g = 0; g < 4; ++g) if (g == grp) vv = a[4 + g * 8 + e] + be[g * 8 + e];
                    el[e] = vv; }
                int i0 = 0; float v0 = el[0];
#pragma unroll
                for (int e = 1; e < 8; ++e) if (el[e] > v0) { v0 = el[e]; i0 = e; }
                int i1 = -1; float v1 = -3.0e38f;
#pragma unroll
                for (int e = 0; e < 8; ++e) if (e != i0 && (i1 < 0 || el[e] > v1)) { v1 = el[e]; i1 = e; }
                const float e1 = __expf(v1 - v0); const float g0 = 1.0f / (1.0f + e1), g1 = e1 / (1.0f + e1);
                b0 = grp * 8 + i0; b1 = grp * 8 + i1;
                l0 = __hip_atomic_fetch_add(BC + b0, 1u, __ATOMIC_RELAXED, __HIP_MEMORY_SCOPE_WORKGROUP);
                l1 = __hip_atomic_fetch_add(BC + b1, 1u, __ATOMIC_RELAXED, __HIP_MEMORY_SCOPE_WORKGROUP);
                gw0 = g0 * pg; gw1 = g1 * pg; rsk = rs;
            }
        }
        LDS_BARRIER();
        if (tid < 32) { const unsigned c = BC[tid]; BB[tid] = c ? __hip_atomic_fetch_add(cnt + tid * 64, c, __ATOMIC_RELAXED, __HIP_MEMORY_SCOPE_AGENT) : 0u; }
        LDS_BARRIER();
        if (active && lane < 16) {
            const int tk = mt * 16 + lane; const unsigned p0 = BB[b0] + l0, p1 = BB[b1] + l1;
            list[(size_t)b0 * T + p0] = tk; list[(size_t)b1 * T + p1] = tk;
            gatew[tk * 2] = gw0; gatew[tk * 2 + 1] = gw1;
            float* rsl = (float*)((char*)list - (WS_LIST - WS_ML)); rsl[(size_t)b0 * T + p0] = rsk; rsl[(size_t)b1 * T + p1] = rsk;
            unsigned* binpos = (unsigned*)(gatew + 2 * T); binpos[tk * 2] = ((unsigned)b0 << 16) | p0; binpos[tk * 2 + 1] = ((unsigned)b1 << 16) | p1;
        }
    }
    LDS_BARRIER();
}
struct Args { const float* in[19]; float* out; unsigned char* ws; int ph_lo, ph_hi, flags, pad; };
enum { IN_X = 0, IN_RET_WIN, IN_RET_WOUT, IN_KV_NORM, IN_W_KV, IN_K_NORM, IN_DIL_WQ, IN_Q_NORM, IN_DIL_WO, IN_REL_BIAS, IN_MIXER_NORM, IN_FFN_NORM, IN_RGRP, IN_RGRP_B, IN_REXP, IN_REXP_B, IN_EGATE, IN_EUP, IN_EDOWN };
constexpr int NPHASE = 24;
#ifndef MK_PHMASK
#define MK_PHMASK 0xffffffu
#endif
struct PhaseCtx { int tid, lane, wave, G, bx, vcu, gw, NGW; unsigned char* ws; float* hout; };
__device__ __forceinline__ PhaseCtx phase_ctx(const Args& args, int wave_s) {
    PhaseCtx c; int tid = (wave_s << 6) | lane_id(), bx = blockIdx.x, G = gridDim.x;
    GAS unsigned char* wsg = (GAS unsigned char*)args.ws; GAS float* hg = (GAS float*)args.out;
    asm volatile("" : "+v"(tid), "+s"(bx), "+s"(G), "+s"(wsg), "+s"(hg));
    unsigned char* ws = (unsigned char*)wsg; float* hout = (float*)hg;
    c.tid = tid; c.lane = tid & 63; c.wave = __builtin_amdgcn_readfirstlane(tid >> 6); c.G = G; c.bx = bx; c.vcu = (G % 8 == 0) ? (bx % 8) * (G / 8) + bx / 8 : bx;
    c.gw = c.vcu * NWAVES + c.wave; c.NGW = G * NWAVES; c.ws = ws; c.hout = hout; return c;
}
__device__ __forceinline__ void pro_s1(const Args& args, const PhaseCtx& c, LAS unsigned char* lds) {
    unsigned char* ws = c.ws; LAS float* scr = (LAS float*)(lds + c.wave * 16640); const int gw = c.gw, NGW = c.NGW, lane = c.lane;
    bf16* xn = (bf16*)(ws + WS_XN); const float* x = args.in[IN_X];
    transpose_matrix(args.in[IN_RET_WIN], 1024, 6144, (bf16*)(ws + WS_WIN), scr, gw, NGW, lane, args.in[IN_MIXER_NORM], MapWin{});
    for (int m = gw; m < T; m += NGW) rms_row_to_bf16(x + (size_t)m * D, xn + (size_t)m * D, lane);
}
__device__ __forceinline__ void pro_wout(const Args& args, const PhaseCtx& c, LAS unsigned char* lds) {
    LAS float* scr = (LAS float*)(lds + c.wave * 16640);
    transpose_matrix(args.in[IN_RET_WOUT], 2048, 1024, (bf16*)(c.ws + WS_WOUT), scr, c.gw, c.NGW, c.lane, nullptr, MapId{0});
}
__device__ __forceinline__ void pro_moe(const Args& args, const PhaseCtx& c, LAS unsigned char* lds, int L) {
    unsigned char* ws = c.ws; LAS float* scr = (LAS float*)(lds + c.wave * 16640); const int gw = c.gw, NGW = c.NGW, lane = c.lane;
    bf16* wgu = (bf16*)(ws + (L ? WS_WGU1 : WS_WGU0)); bf16* wd = (bf16*)(ws + (L ? WS_WD1 : WS_WD0));
    const float* gain = args.in[IN_FFN_NORM] + L * D;
    auto src_of = [&](int it, const float*& W, int& N, int& item) { const int e = it / 384, r = it % 384, which = r >> 7; item = r & 127; const size_t eo = (size_t)(L * NEXP + e);
        if (which == 0) { W = args.in[IN_EGATE] + eo * D * FF; N = FF; } else if (which == 1) { W = args.in[IN_EUP] + eo * D * FF; N = FF; } else { W = args.in[IN_EDOWN] + eo * FF * D; N = D; } };
    if (gw < NEXP * 384) {
        f32x4 v[16]; { const float* W; int N, item; src_of(gw, W, N, item); transpose_load(W, N, item, lane, v); }
        for (int it = gw; it < NEXP * 384; it += NGW) { f32x4 cur[16];
#pragma unroll
            for (int i = 0; i < 16; ++i) cur[i] = v[i];
            if (it + NGW < NEXP * 384) { const float* W; int N, item; src_of(it + NGW, W, N, item); transpose_load(W, N, item, lane, v); }
            const int e = it / 384, r = it % 384, which = r >> 7, item = r & 127;
            if (which == 0) transpose_finish(cur, FF, wgu + (size_t)e * 1024 * 1024, 1024, scr, item, lane, gain, MapGu{0});
            else if (which == 1) transpose_finish(cur, FF, wgu + (size_t)e * 1024 * 1024, 1024, scr, item, lane, gain, MapGu{1});
            else transpose_finish(cur, D, wd + (size_t)e * 1024 * 512, 512, scr, item, lane, (const float*)nullptr, MapId{0}); }
    }
    bf16* wrh = (bf16*)(ws + WS_WR) + (size_t)L * 48 * 1024; bf16* wrl = (bf16*)(ws + WS_WR + 196608) + (size_t)L * 48 * 1024;
    for (int i = gw * 64 + lane; i < 48 * 1024; i += NGW * 64) { const int n = i >> 10, k = i & 1023;
        const float wv = n < 36 ? gain[k] * (n < 4 ? args.in[IN_RGRP][((size_t)L * D + k) * 4 + n] : args.in[IN_REXP][((size_t)L * D + k) * 32 + (n - 4)]) : 0.0f;
        const unsigned hi = f2bf(wv); const float rem = wv - __builtin_bit_cast(float, hi << 16); wrh[i] = (bf16)hi; wrl[i] = (bf16)f2bf(rem); }
}
__device__ __forceinline__ void pro_s3(const Args& args, const PhaseCtx& c, LAS unsigned char* lds) {
    unsigned char* ws = c.ws; LAS float* scr = (LAS float*)(lds + c.wave * 16640); const int gw = c.gw, NGW = c.NGW, lane = c.lane;
    transpose_matrix(args.in[IN_DIL_WQ], 1024, 3072, (bf16*)(ws + WS_WQKV1), scr, gw, NGW, lane, args.in[IN_MIXER_NORM] + D, MapQkv1{0});
    transpose_matrix(args.in[IN_W_KV], 1024, 6144, (bf16*)(ws + WS_WQKV1), scr, gw, NGW, lane, args.in[IN_KV_NORM], MapQkv1{3072});
    transpose_matrix(args.in[IN_DIL_WO], 1024, 1024, (bf16*)(ws + WS_WO1), scr, gw, NGW, lane, nullptr, MapId{0});
    if (gw == 0) { float* gt = (float*)(ws + WS_WR + 512 * 1024); for (int i = lane; i < 192; i += 64) { gt[i] = args.in[IN_Q_NORM][i]; gt[192 + i] = args.in[IN_K_NORM][i]; } }
}

__global__ void __launch_bounds__(NWAVES * 64, 2) mk_fwd(Args args) {
    extern __shared__ __attribute__((aligned(16))) unsigned char lds_raw[];
    LAS unsigned char* lds = (LAS unsigned char*)lds_raw;
    volatile LAS unsigned* MISC = (volatile LAS unsigned*)(lds + LDS_MISC);
    LAS int* TAB = (LAS int*)(lds + LDS_MISC + 64);
    const int wave_s = __builtin_amdgcn_readfirstlane(threadIdx.x >> 6);
    if (threadIdx.x < 4) MISC[threadIdx.x] = 0u;
    __syncthreads();
    XcdBarrier bar = xcd_barrier_post((unsigned*)(args.ws + WS_CTL) + CW_BAR, MISC, threadIdx.x == 0);
    int lo = args.ph_lo, hi = args.ph_hi, flg = args.flags;
#define RELAUNDER() asm volatile("" : "+s"(lo), "+s"(hi), "+s"(flg))
#define fullpro ((flg & 1) != 0)
#ifdef MK_REPEAT
#define GEMM_RUN(p) do { if (rep_now) gemm_phase(lds, p, c.tid, (flg & 1) != 0); gemm_phase(lds, p, c.tid); } while (0)
#else
#ifndef MK_STAGGER
#define MK_STAGGER 0
#endif
#define GEMM_RUN(p) gemm_phase(lds, p, c.tid, false, MK_STAGGER)
#endif
#ifdef MK_REPEAT
#define MK_REPEAT_K MK_REPEAT
#else
#define MK_REPEAT_K (-1)
#endif
#define IN(k) ((((MK_PHMASK) >> (k)) & 1u) && lo <= (k) && (k) < hi)
#ifdef MK_STAMP
#define STAMP(i) do { if (blockIdx.x == 0 && wave_s == 0 && lane_id() == 0) ((volatile LAS unsigned long long*)(lds + LDS_MISC + 3072))[i] = __builtin_amdgcn_s_memrealtime(); } while (0)
#else
#define STAMP(i) do { } while (0)
#endif
#define SEAM(k) do { asm volatile("; SEAM_MARK %0" :: "n"(k)); if (IN(k) && IN((k) + 1)) xcd_barrier(bar, wave_s); STAMP((k) + 1); } while (0)

    STAMP(0);
    if (IN(0)) { const PhaseCtx c = phase_ctx(args, wave_s); pro_s1(args, c, lds); if (!fullpro) pro_wout(args, c, lds); }
    SEAM(0);
    if (IN(1)) {
#pragma unroll 1
        for (int part = 0; part < 2; ++part) {
            RELAUNDER();
            { const bool rep_now = (MK_REPEAT_K == 1); const PhaseCtx c = phase_ctx(args, wave_s); unsigned char* ws = c.ws;
              P_QKV0 p; p.A = (const char*)(ws + WS_XN); p.Bt = (const char*)(ws + WS_WIN); p.lda = 2048; p.ldb = 2048; p.K = 1024; p.so.init(T, 4096, c.G, c.bx);
              p.qk = (bf16*)(ws + WS_Q0); p.v = (bf16*)(ws + WS_V0); p.cs = (const float*)(ws + WS_COS); p.sn = (const float*)(ws + WS_SIN);
              const int ksp = fullpro ? ((c.bx >> 3) & 7) : 0; p.i0 = part ? ksp : 0; p.i1 = part ? (1 << 24) : ksp;
              GEMM_RUN(p); }
            if (part == 0 && fullpro) { const PhaseCtx c = phase_ctx(args, wave_s); __syncthreads();
#pragma unroll 1
                for (int Lw = 0; Lw < 2; ++Lw) pro_moe(args, c, lds, Lw);
                pro_wout(args, c, lds); pro_s3(args, c, lds); __syncthreads(); }
        }
    }
    SEAM(1);
    if (IN(2)) { const PhaseCtx c = phase_ctx(args, wave_s); unsigned char* ws = c.ws;
#if defined(MK_REPEAT) && MK_REPEAT == 2
        retention_phase(lds, (const bf16*)(ws + WS_Q0), (const bf16*)(ws + WS_K0), (bf16*)(ws + WS_V0), (float*)(ws + WS_SSQ), c.G, c.vcu, c.tid, (flg & 1) != 0);
#endif
        retention_phase(lds, (const bf16*)(ws + WS_Q0), (const bf16*)(ws + WS_K0), (bf16*)(ws + WS_V0), (float*)(ws + WS_SSQ), c.G, c.vcu, c.tid); }
    SEAM(2);
    if (IN(3)) { const bool rep_now = (MK_REPEAT_K == 3); const PhaseCtx c = phase_ctx(args, wave_s); unsigned char* ws = c.ws;
        P_GATE p; p.A = (const char*)(ws + WS_XN); p.Bt = (const char*)(ws + WS_WIN) + (size_t)4096 * 2048; p.lda = 2048; p.ldb = 2048; p.K = 1024; p.so.init(T, 2048, c.G, c.bx);
        p.ov = (bf16*)(ws + WS_V0); p.ssq = (const float*)(ws + WS_SSQ);
        GEMM_RUN(p); }
    SEAM(3);
    if (IN(4)) { const bool rep_now = (MK_REPEAT_K == 4); const PhaseCtx c = phase_ctx(args, wave_s); unsigned char* ws = c.ws;
        P_RESB p; p.A = (const char*)(ws + WS_V0); p.Bt = (const char*)(ws + WS_WOUT); p.lda = 4096; p.ldb = 4096; p.K = 2048; p.so.init(T, 1024, c.G, c.bx);
        p.res32 = args.in[IN_X]; p.hb = (bf16*)(ws + WS_XN); p.row_off = 0;
        GEMM_RUN(p); }
    SEAM(4);
#pragma unroll 1
    for (int L = 0; L < 2; ++L) {
        RELAUNDER();
        const int P0 = L ? 19 : 5;
#define INL(k0, k1) (L ? IN(k1) : IN(k0))
#define SEAML(k0, k1) do { if (L) SEAM(k1); else SEAM(k0); } while (0)
        if (L == 1) {
            if (IN(10)) { const PhaseCtx c = phase_ctx(args, wave_s); if (!fullpro) pro_s3(args, c, lds);
 }
            if (!fullpro) SEAM(10);
#pragma unroll 1
            for (int ch = 0; ch < 2; ++ch) {
                RELAUNDER();
#define INC(k) (ch ? IN((k) + 4) : IN(k))
#define SEAMC(k) do { if (ch) SEAM((k) + 4); else SEAM(k); } while (0)
                if (INC(11)) { const bool rep_now = (MK_REPEAT_K == 11); const PhaseCtx c = phase_ctx(args, wave_s); unsigned char* ws = c.ws;
                    P_QKV1 p; p.A = (const char*)(ws + WS_XN) + (size_t)ch * TC * D * 2; p.Bt = (const char*)(ws + WS_WQKV1); p.lda = 2048; p.ldb = 2048; p.K = 1024; p.so.init(TC, 9216, c.G, c.bx);
                    p.qkv = (bf16*)(ws + WS_Q1); p.gains = (const float*)(ws + WS_WR + 512 * 1024); p.rs1 = (const float*)(ws + WS_GATEW + 1024 * 1024) + ch * TC;
                    GEMM_RUN(p); }
                SEAMC(11);
                if (INC(12)) { const PhaseCtx c = phase_ctx(args, wave_s); unsigned char* ws = c.ws;
#if defined(MK_REPEAT) && MK_REPEAT == 12
                    attn_phase(lds, (bf16*)(ws + WS_Q1), (const bf16*)(ws + WS_K1), (const bf16*)(ws + WS_V1), (f32x2*)(ws + WS_ML), args.in[IN_REL_BIAS], c.G, c.bx, c.tid, (flg & 1) != 0);
#endif
                    attn_phase(lds, (bf16*)(ws + WS_Q1), (const bf16*)(ws + WS_K1), (const bf16*)(ws + WS_V1), (f32x2*)(ws + WS_ML), args.in[IN_REL_BIAS], c.G, c.bx, c.tid); }
                SEAMC(12);
                if (INC(13)) { const PhaseCtx c = phase_ctx(args, wave_s); merge_phase((const bf16*)(c.ws + WS_Q1), (const f32x2*)(c.ws + WS_ML), (bf16*)(c.ws + WS_AO) + (size_t)ch * TC * D, c.G, c.bx, c.tid); }
                SEAMC(13);
#undef INC
#undef SEAMC
            }
            if (IN(18)) { const bool rep_now = (MK_REPEAT_K == 14); const PhaseCtx c = phase_ctx(args, wave_s); unsigned char* ws = c.ws;
                P_RESB p; p.A = (const char*)(ws + WS_AO); p.Bt = (const char*)(ws + WS_WO1); p.lda = 2048; p.ldb = 2048; p.K = 1024; p.so.init(T, 1024, c.G, c.bx);
                p.res32 = nullptr; p.hb = (bf16*)(ws + WS_XN); p.row_off = 0;
                GEMM_RUN(p); }
            SEAM(18);
        }
        if (INL(5, 19)) { const PhaseCtx c = phase_ctx(args, wave_s); if (!fullpro) pro_moe(args, c, lds, L); }
        if (!fullpro) SEAML(5, 19);
        if (INL(6, 20)) { const PhaseCtx c = phase_ctx(args, wave_s); unsigned char* ws = c.ws;
            router_phase(lds, (const bf16*)(ws + WS_WR) + (size_t)L * 48 * 1024, (const bf16*)(ws + WS_WR + 196608) + (size_t)L * 48 * 1024, args.in[IN_RGRP_B] + L * 4, args.in[IN_REXP_B] + L * 32, (const bf16*)(ws + WS_XN), (int*)(ws + WS_LIST), (float*)(ws + WS_GATEW),
                         (unsigned*)(ws + WS_CTL) + CW_CNT + L * 4096, c.G, c.vcu, c.tid); }
        SEAML(6, 20);
        if (INL(7, 21) || INL(8, 22)) { const PhaseCtx c = phase_ctx(args, wave_s); moe_build_tab(TAB, (const unsigned*)(c.ws + WS_CTL) + CW_CNT + L * 4096, c.tid); }
        if (INL(7, 21)) { const bool rep_now = (MK_REPEAT_K == 7); const PhaseCtx c = phase_ctx(args, wave_s); unsigned char* ws = c.ws;
            P_GU p; p.xn = (const char*)(ws + WS_XN); p.W = (const char*)(ws + (L ? WS_WGU1 : WS_WGU0)); p.list = (const int*)(ws + WS_LIST); p.hid = (bf16*)(ws + WS_HID); p.tab = TAB; p.G = c.G; p.vcu = c.vcu; p.K = 1024; p.lda = 2048; p.ldb = 2048;
            GEMM_RUN(p); }
        SEAML(7, 21);
        if (INL(8, 22)) { const bool rep_now = (MK_REPEAT_K == 8); const PhaseCtx c = phase_ctx(args, wave_s); unsigned char* ws = c.ws;
            P_DN p; p.hid = (const char*)(ws + WS_HID); p.W = (const char*)(ws + (L ? WS_WD1 : WS_WD0)); p.y = (bf16*)(ws + WS_YB); p.tab = TAB; p.G = c.G; p.vcu = c.vcu; p.K = 512; p.lda = 1024; p.ldb = 1024;
            GEMM_RUN(p); }
        SEAML(8, 22);
        if (INL(9, 23)) { const PhaseCtx c = phase_ctx(args, wave_s); unsigned char* ws = c.ws;
            if (!(INL(7, 21) || INL(8, 22))) moe_build_tab(TAB, (const unsigned*)(ws + WS_CTL) + CW_CNT + L * 4096, c.tid);
            combine_phase((bf16*)(ws + WS_XN), (const bf16*)(ws + WS_YB), (const unsigned*)(ws + WS_GATEW) + 2 * T, (const float*)(ws + WS_GATEW), TAB, L == 1 ? c.hout : (float*)nullptr, (float*)(ws + WS_GATEW + 1024 * 1024), c.gw, c.NGW, c.lane); }
        SEAML(9, 23);
#undef INL
#undef SEAML
        (void)P0;
    }
#ifdef MK_STAMP
    if (blockIdx.x == 0 && wave_s == 0 && lane_id() == 0) { volatile LAS unsigned long long* st = (volatile LAS unsigned long long*)(lds + LDS_MISC + 3072);
        const float tot = (float)(st[24] - st[0]); float* pr = (float*)(args.ws + WS_CTL) + 200000;
        pr[0] = floorf((float)(st[MK_STAMP_A1] - st[MK_STAMP_A0]) / tot * 200.0f + 0.5f) * 0.005f; pr[1] = 0.f; }
#endif
#undef IN
#undef SEAM
#undef RELAUNDER
#undef fullpro
}
}
#ifndef MK_MASK
#define MK_MASK 15
#endif
#ifndef MK_SPLIT
#define MK_SPLIT 0
#endif

#ifdef MK_DEBUG
namespace dbg {
__global__ void k_cmp(const float* a, const float* b, size_t n, unsigned long long* acc) {
    double num = 0.0, den = 0.0; unsigned long long bad = 0;
    for (size_t i = (size_t)blockIdx.x * blockDim.x + threadIdx.x; i < n; i += (size_t)gridDim.x * blockDim.x) { const float x = a[i], y = b[i]; const float d = x - y; if (!(d - d == 0.0f)) { ++bad; continue; } num += (double)d * d; den += (double)x * x; }
    for (int o = 32; o >= 1; o >>= 1) { num += __shfl_xor(num, o); den += __shfl_xor(den, o); bad += __shfl_xor(bad, o); }
    if ((threadIdx.x & 63) == 0) { atomicAdd(acc, (unsigned long long)(num * 1048576.0)); atomicAdd(acc + 1, (unsigned long long)(den * 1048576.0)); atomicAdd(acc + 2, bad); }
}
__global__ void k_code(const unsigned long long* acc, float* scale) {
    const double num = (double)acc[0], den = (double)acc[1]; const double e = sqrt(num / (den + 1.0));
    int code = e < 0.01 ? 0 : (e < 0.03 ? 1 : (e < 0.1 ? 2 : (e < 0.3 ? 3 : (e < 1.0 ? 4 : 5)))); if (acc[2]) code = 7;
    scale[0] = 1.0f + 0.1f * (float)code;
}
__global__ void k_cmp_bf(const unsigned short* nw, const float* ref, int ldr, int offr, int mode, unsigned long long* acc, int tlo = 0, int thi = 2048) {
    double num = 0.0, den = 0.0; unsigned long long bad = 0;
    const size_t n = mode < 2 ? (size_t)2048 * 1024 : (size_t)2048 * 2048;
    for (size_t i = (size_t)blockIdx.x * blockDim.x + threadIdx.x; i < n; i += (size_t)gridDim.x * blockDim.x) {
        float x, y;
        if (mode < 2) { const int t = (int)(i >> 10), col = (int)(i & 1023), hh = col >> 8, d = col & 255, c = d < 128 ? 2 * d : 2 * (d - 128) + 1;
            const float l2g = log2f(1.0f - exp2f(-5.0f - (float)hh)); const float sc = exp2f((mode == 0 ? -l2g : l2g) * (float)(t & 63));
            y = __uint_as_float(((unsigned)nw[(size_t)t * 1024 + hh * 256 + c]) << 16) * sc; x = ref[(size_t)t * ldr + offr + col]; }
        else { const int t = (int)(i >> 11), col = (int)(i & 2047); if (t < tlo || t >= thi) continue; y = __uint_as_float(((unsigned)nw[(size_t)t * 2048 + col]) << 16); x = ref[(size_t)t * ldr + offr + col]; }
        const float dd = x - y; if (!(dd - dd == 0.0f)) { ++bad; continue; } num += (double)dd * dd; den += (double)x * x; }
    for (int o = 32; o >= 1; o >>= 1) { num += __shfl_xor(num, o); den += __shfl_xor(den, o); bad += __shfl_xor(bad, o); }
    if ((threadIdx.x & 63) == 0) { atomicAdd(acc, (unsigned long long)(num * 1048576.0)); atomicAdd(acc + 1, (unsigned long long)(den * 1048576.0)); atomicAdd(acc + 2, bad); }
}
__device__ inline int code_of(const unsigned long long* acc) { const double e = sqrt((double)acc[0] / ((double)acc[1] + 1.0)); int code = e < 0.01 ? 0 : (e < 0.03 ? 1 : (e < 0.1 ? 2 : (e < 0.3 ? 3 : (e < 1.0 ? 4 : 5)))); if (acc[2]) code = 7; return code; }
__global__ void k_code3(const unsigned long long* acc, float* scale) { scale[0] = 1.0f + 0.1f * (float)code_of(acc); scale[1] = 100.0f * (float)(code_of(acc + 4) + 1) + 10.0f * (float)code_of(acc + 8); }
__global__ void k_spike(float* out, const float* scale) { out[0] += scale[1]; }
__global__ void k_scale(float* out, const float* scale, size_t n) { const float s = scale[0]; for (size_t i = (size_t)blockIdx.x * blockDim.x + threadIdx.x; i < n; i += (size_t)gridDim.x * blockDim.x) out[i] *= s; }
}
#endif
#ifndef MK_SPIKE
#define MK_SPIKE 1000.0f
#endif
#ifdef MK_STAMP
__global__ void stamp_apply(float* out, const float* pr, size_t n) { if (blockIdx.x == 0 && threadIdx.x == 0) out[0] += MK_SPIKE * pr[0]; }
#endif
extern "C" void kernel_launch(void* const* d_in, const int* in_sizes, int n_in, void* d_out, int out_size, void* d_ws, size_t ws_size, hipStream_t stream) {
    (void)in_sizes; (void)n_in; (void)out_size;
    if (ws_size < mk::WS_END) return;
    static int configured = 0, grid = 256;
    if (!configured) { if (hipFuncSetAttribute((const void*)mk::mk_fwd, hipFuncAttributeMaxDynamicSharedMemorySize, mk::LDS_BYTES) != hipSuccess) return;
        int dev = 0, cus = 0, per_cu = 0;
        if (hipGetDevice(&dev) == hipSuccess && hipDeviceGetAttribute(&cus, hipDeviceAttributeMultiprocessorCount, dev) == hipSuccess && cus > 0) grid = cus < 256 ? cus : 256;
        if (hipOccupancyMaxActiveBlocksPerMultiprocessor(&per_cu, (const void*)mk::mk_fwd, 512, mk::LDS_BYTES) != hipSuccess || per_cu < 1) return;
        configured = 1; }
    mk::Args a{};
    for (int i = 0; i < 19; ++i) a.in[i] = (const float*)d_in[i];
    a.out = (float*)d_out; a.ws = (unsigned char*)d_ws; a.pad = 0;
    const int mask = MK_MASK;
    auto run_new = [&](int lo, int hi, int flags) {
        (void)hipMemsetAsync((char*)d_ws + mk::WS_CTL, 0, mk::CTL_BYTES, stream);
        if (MK_SPLIT) { for (int p = lo; p < hi; ++p) { a.ph_lo = p; a.ph_hi = p + 1; a.flags = flags; hipLaunchKernelGGL(mk::mk_fwd, dim3(grid), dim3(512), mk::LDS_BYTES, stream, a); } }
        else { a.ph_lo = lo; a.ph_hi = hi; a.flags = flags; hipLaunchKernelGGL(mk::mk_fwd, dim3(grid), dim3(512), mk::LDS_BYTES, stream, a); }
    };
#ifdef MK_DEBUG
    {
        const size_t MiB = mk::MiB; const size_t nall = (size_t)mk::T * mk::D;
        if (ws_size < 580 * MiB) return;
        nv::Ctx c; nv::ctx_init(c, d_in, d_out, d_ws, stream);
        unsigned long long* acc = (unsigned long long*)((char*)d_ws + 575 * MiB); float* scl = (float*)((char*)d_ws + 575 * MiB + 256);
        float* dout = (float*)d_out; float* alt = nullptr; size_t ncmp = nall;
        if (MK_DEBUG == 1) { nv::stage_mixer0(c); alt = (float*)((char*)d_ws + mk::WS_Q0); a.out = alt; run_new(0, 5, 0); }
        else if (MK_DEBUG == 11) {
            nv::stage_mixer0(c);
            float* xn_n = (float*)((char*)d_ws + 62 * MiB); float* pj_n = (float*)((char*)d_ws + 70 * MiB); float* oc_n = (float*)((char*)d_ws + 118 * MiB);
            (void)hipMemsetAsync(acc, 0, 512, stream);
            run_new(0, 2, 0);
            hipLaunchKernelGGL(nv::k_rmsnorm, dim3(2048 / 4), dim3(256), 0, stream, c.x, c.mixer_norm, xn_n, 2048);
            { nv::GemmP g{}; g.A = xn_n; g.lda = 1024; g.B = c.ret_w_in; g.ldb = 6144; g.C = pj_n; g.ldc = 6144; g.M = 2048; g.N = 6144; g.K = 1024; g.mode = 0; nv::gemm(stream, g); }
            hipLaunchKernelGGL(nv::k_rotary, dim3(2048 * 1024 / 256), dim3(256), 0, stream, pj_n, 2048);
            hipLaunchKernelGGL(dbg::k_cmp_bf, dim3(512), dim3(256), 0, stream, (const unsigned short*)((char*)d_ws + mk::WS_Q0), (const float*)pj_n, 6144, 0, 0, acc);
            hipLaunchKernelGGL(dbg::k_cmp_bf, dim3(512), dim3(256), 0, stream, (const unsigned short*)((char*)d_ws + mk::WS_K0), (const float*)pj_n, 6144, 1024, 1, acc);
            hipLaunchKernelGGL(dbg::k_cmp_bf, dim3(512), dim3(256), 0, stream, (const unsigned short*)((char*)d_ws + mk::WS_V0), (const float*)pj_n, 6144, 2048, 2, acc);
            run_new(2, 3, 0);
            hipLaunchKernelGGL(nv::k_retention, dim3(64, 4, 1), dim3(256), 0, stream, (const float*)pj_n, oc_n);
            hipLaunchKernelGGL(dbg::k_cmp_bf, dim3(512), dim3(256), 0, stream, (const unsigned short*)((char*)d_ws + mk::WS_V0), (const float*)oc_n, 2048, 0, 2, acc + 4);
            run_new(3, 4, 0);
            hipLaunchKernelGGL(nv::k_gnorm_gate, dim3(2048), dim3(256), 0, stream, oc_n, (const float*)pj_n, 2048);
            hipLaunchKernelGGL(dbg::k_cmp_bf, dim3(512), dim3(256), 0, stream, (const unsigned short*)((char*)d_ws + mk::WS_V0), (const float*)oc_n, 2048, 0, 2, acc + 8);
            hipLaunchKernelGGL(dbg::k_code3, dim3(1), dim3(1), 0, stream, (const unsigned long long*)acc, scl);
            nv::stage_moe(c, 0); nv::stage_mixer1(c); nv::stage_moe(c, 1);
            hipLaunchKernelGGL(dbg::k_scale, dim3(1024), dim3(256), 0, stream, dout, (const float*)scl, nall);
            hipLaunchKernelGGL(dbg::k_spike, dim3(1), dim3(1), 0, stream, dout, (const float*)scl);
            return;
        }
        else if (MK_DEBUG == 12) {
            nv::stage_mixer0(c);
            float* xn_n = (float*)((char*)d_ws + 62 * MiB); float* pj_n = (float*)((char*)d_ws + 70 * MiB); float* oc_n = (float*)((char*)d_ws + 118 * MiB);
            (void)hipMemsetAsync(acc, 0, 512, stream);
            run_new(0, 3, 0);
            hipLaunchKernelGGL(nv::k_rmsnorm, dim3(2048 / 4), dim3(256), 0, stream, c.x, c.mixer_norm, xn_n, 2048);
            { nv::GemmP g{}; g.A = xn_n; g.lda = 1024; g.B = c.ret_w_in; g.ldb = 6144; g.C = pj_n; g.ldc = 6144; g.M = 2048; g.N = 6144; g.K = 1024; g.mode = 0; nv::gemm(stream, g); }
            hipLaunchKernelGGL(nv::k_rotary, dim3(2048 * 1024 / 256), dim3(256), 0, stream, pj_n, 2048);
            hipLaunchKernelGGL(nv::k_retention, dim3(64, 4, 1), dim3(256), 0, stream, (const float*)pj_n, oc_n);
            hipLaunchKernelGGL(dbg::k_cmp_bf, dim3(512), dim3(256), 0, stream, (const unsigned short*)((char*)d_ws + mk::WS_V0), (const float*)oc_n, 2048, 0, 2, acc, 0, 64);
            hipLaunchKernelGGL(dbg::k_cmp_bf, dim3(512), dim3(256), 0, stream, (const unsigned short*)((char*)d_ws + mk::WS_V0), (const float*)oc_n, 2048, 0, 2, acc + 4, 64, 128);
            hipLaunchKernelGGL(dbg::k_cmp_bf, dim3(512), dim3(256), 0, stream, (const unsigned short*)((char*)d_ws + mk::WS_V0), (const float*)oc_n, 2048, 0, 2, acc + 8, 128, 2048);
            hipLaunchKernelGGL(dbg::k_code3, dim3(1), dim3(1), 0, stream, (const unsigned long long*)acc, scl);
            nv::stage_moe(c, 0); nv::stage_mixer1(c); nv::stage_moe(c, 1);
            hipLaunchKernelGGL(dbg::k_scale, dim3(1024), dim3(256), 0, stream, dout, (const float*)scl, nall);
            hipLaunchKernelGGL(dbg::k_spike, dim3(1), dim3(1), 0, stream, dout, (const float*)scl);
            return;
        }
        else nv::stage_mixer0(c);
        if (MK_DEBUG == 2) { alt = (float*)((char*)d_ws + 446 * MiB); (void)hipMemcpyAsync(alt, dout, nall * 4, hipMemcpyDeviceToDevice, stream); nv::stage_moe(c, 0); a.out = alt; run_new(5, 10, 0); }
        else if (MK_DEBUG > 2) nv::stage_moe(c, 0);
        if (MK_DEBUG == 3) { alt = (float*)((char*)d_ws + 510 * MiB); ncmp = (size_t)mk::TC * mk::D; (void)hipMemcpyAsync(alt, dout, ncmp * 4, hipMemcpyDeviceToDevice, stream); nv::stage_mixer1(c); a.out = alt; run_new(10, 15, 2); }
        else if (MK_DEBUG > 3) nv::stage_mixer1(c);
        if (MK_DEBUG == 4) { alt = (float*)((char*)d_ws + 446 * MiB); (void)hipMemcpyAsync(alt, dout, nall * 4, hipMemcpyDeviceToDevice, stream); nv::stage_moe(c, 1); a.out = alt; run_new(19, 24, 0); }
        (void)hipMemsetAsync(acc, 0, 512, stream);
        hipLaunchKernelGGL(dbg::k_cmp, dim3(1024), dim3(256), 0, stream, (const float*)dout, (const float*)alt, ncmp, acc);
        hipLaunchKernelGGL(dbg::k_code, dim3(1), dim3(1), 0, stream, (const unsigned long long*)acc, scl);
        if (MK_DEBUG < 2) nv::stage_moe(c, 0);
        if (MK_DEBUG < 3) nv::stage_mixer1(c);
        if (MK_DEBUG < 4) nv::stage_moe(c, 1);
        hipLaunchKernelGGL(dbg::k_scale, dim3(1024), dim3(256), 0, stream, dout, (const float*)scl, nall);
        return;
    }
#endif
#ifdef MK_STAMP
    if (mask == 15) { run_new(0, mk::NPHASE, 1); hipLaunchKernelGGL(stamp_apply, dim3(1024), dim3(256), 0, stream, (float*)d_out, (const float*)((char*)d_ws + mk::WS_CTL) + 200000, (size_t)mk::T * mk::D); return; }
#endif
    if (mask == 15) { run_new(0, mk::NPHASE, MK_SPLIT ? 0 : 1); return; }
#ifdef MK_WITH_NAIVE
    nv::Ctx c; nv::ctx_init(c, d_in, d_out, d_ws, stream);
    if (mask & 1) run_new(0, 5, 0); else nv::stage_mixer0(c);
    if (mask & 2) run_new(5, 10, 0); else nv::stage_moe(c, 0);
    if (mask & 4) run_new(10, 19, 0); else nv::stage_mixer1(c);
    if (mask & 8) run_new(19, 24, 0); else nv::stage_moe(c, 1);
#endif
}
```

```cpp
#include <hip/hip_runtime.h>
#include <cstdio>
#include <cstdint>
#define MK_MASK 15
#define MK_SPLIT 0
namespace mk {
#define LAS __attribute__((address_space(3)))
#define GAS __attribute__((address_space(1)))
typedef unsigned short bf16;
typedef short bf16x8 __attribute__((ext_vector_type(8)));
typedef short s16x4 __attribute__((ext_vector_type(4)));
typedef float f32x4 __attribute__((ext_vector_type(4)));
typedef float f32x2 __attribute__((ext_vector_type(2)));
typedef unsigned u32x4 __attribute__((ext_vector_type(4)));
typedef unsigned u32x2 __attribute__((ext_vector_type(2)));
typedef GAS unsigned gu32;

constexpr int T = 32768, D = 1024, SEQ = 2048, NB = 16;
constexpr int NEXP = 32, FF = 512;
constexpr int TC = 16384;
constexpr size_t MiB = 1u << 20;
constexpr size_t WS_CTL = 0, CTL_BYTES = 1 * MiB;
constexpr size_t WS_COS = 1 * MiB, WS_SIN = 2 * MiB, WS_WR = 3 * MiB;
constexpr size_t WS_SSQ = 4 * MiB, WS_ML = 8 * MiB, WS_LIST = 16 * MiB, WS_GATEW = 24 * MiB;
constexpr size_t WS_WIN = 26 * MiB, WS_WOUT = 38 * MiB, WS_WQKV1 = 42 * MiB, WS_WO1 = 60 * MiB;
constexpr size_t WS_WGU1 = 62 * MiB, WS_WD1 = 126 * MiB;
constexpr size_t WS_XN = 158 * MiB;
constexpr size_t WS_WGU0 = 222 * MiB, WS_WD0 = 286 * MiB;
constexpr size_t WS_ACT = 318 * MiB;
constexpr size_t WS_Q0 = WS_ACT, WS_K0 = WS_ACT + 64 * MiB, WS_V0 = WS_ACT + 128 * MiB;
constexpr size_t WS_HID = WS_ACT, WS_YB = WS_ACT + 72 * MiB;
constexpr size_t WS_Q1 = 222 * MiB, WS_K1 = 318 * MiB, WS_V1 = 414 * MiB, WS_AO = 510 * MiB;
constexpr size_t WS_END = 574 * MiB;
constexpr int CW_BAR = 4096;
constexpr int CW_CNT = 16384;
constexpr int LDS_MISC = 155648;
constexpr int LDS_BYTES = 159 * 1024;
constexpr int NWAVES = 8;

#define LDS_WAIT() asm volatile("s_waitcnt lgkmcnt(0)" ::: "memory")
#define VM_WAIT() asm volatile("s_waitcnt vmcnt(0)" ::: "memory")
__device__ __forceinline__ unsigned f2bf(float f) { unsigned u = __builtin_bit_cast(unsigned, f); return (u + 0x7fffu + ((u >> 16) & 1u)) >> 16; }
__device__ __forceinline__ unsigned pk2(float lo, float hi) { return f2bf(lo) | (f2bf(hi) << 16); }
typedef __bf16 bf16pair_t __attribute__((ext_vector_type(2)));
__device__ __forceinline__ unsigned cvt_pk_bf16(float lo, float hi) { bf16pair_t v; v.x = (__bf16)lo; v.y = (__bf16)hi; return __builtin_bit_cast(unsigned, v); }
__device__ __forceinline__ float bf_lo(unsigned u) { return __builtin_bit_cast(float, u << 16); }
__device__ __forceinline__ float bf_hi(unsigned u) { return __builtin_bit_cast(float, u & 0xffff0000u); }
#define LDS_BARRIER() do { asm volatile("s_waitcnt lgkmcnt(0)" ::: "memory"); __builtin_amdgcn_s_barrier(); asm volatile("" ::: "memory"); } while (0)
__device__ __forceinline__ float xsum16(float x) { const unsigned u = __builtin_bit_cast(unsigned, x); const auto r = __builtin_amdgcn_permlane16_swap(u, u, false, false); return __builtin_bit_cast(float, (unsigned)r[0]) + __builtin_bit_cast(float, (unsigned)r[1]); }
__device__ __forceinline__ float xsum32(float x) { const unsigned u = __builtin_bit_cast(unsigned, x); const auto r = __builtin_amdgcn_permlane32_swap(u, u, false, false); return __builtin_bit_cast(float, (unsigned)r[0]) + __builtin_bit_cast(float, (unsigned)r[1]); }
__device__ __forceinline__ float xmax16(float x) { const unsigned u = __builtin_bit_cast(unsigned, x); const auto r = __builtin_amdgcn_permlane16_swap(u, u, false, false); return fmaxf(__builtin_bit_cast(float, (unsigned)r[0]), __builtin_bit_cast(float, (unsigned)r[1])); }
__device__ __forceinline__ float xmax32(float x) { const unsigned u = __builtin_bit_cast(unsigned, x); const auto r = __builtin_amdgcn_permlane32_swap(u, u, false, false); return fmaxf(__builtin_bit_cast(float, (unsigned)r[0]), __builtin_bit_cast(float, (unsigned)r[1])); }
__device__ __forceinline__ float dpp_add(float x, const int ctrl) { return x; }
__device__ __forceinline__ float wave_sum(float v) {
    v += __builtin_bit_cast(float, __builtin_amdgcn_update_dpp(0, __builtin_bit_cast(int, v), 0xB1, 0xF, 0xF, true));
    v += __builtin_bit_cast(float, __builtin_amdgcn_update_dpp(0, __builtin_bit_cast(int, v), 0x4E, 0xF, 0xF, true));
    v += __builtin_bit_cast(float, __builtin_amdgcn_update_dpp(0, __builtin_bit_cast(int, v), 0x141, 0xF, 0xF, true));
    v += __builtin_bit_cast(float, __builtin_amdgcn_update_dpp(0, __builtin_bit_cast(int, v), 0x140, 0xF, 0xF, true));
    return xsum32(xsum16(v));
}
__device__ __forceinline__ float silu_f(float x) { return x * __builtin_amdgcn_rcpf(1.0f + __builtin_amdgcn_exp2f(-1.4426950408889634f * x)); }

#define XB_TMO      128
#define XB_XCNT(j)  (256  + 64 * (j))
#define XB_XSUB(j)  (1280 + 64 * (j))
#define XB_XGEN(j)  (2304 + 64 * (j))
#define XB_TOP      3328
#define XB_TOPGEN   3392
#define XCD_BAR_WORDS 3456
#define XB_SPIN_CAP (1u << 22)
__device__ __forceinline__ unsigned xb_ld(unsigned* p)              { return __hip_atomic_load(p, __ATOMIC_RELAXED, __HIP_MEMORY_SCOPE_AGENT); }
__device__ __forceinline__ unsigned xb_add(unsigned* p, unsigned v) { return __hip_atomic_fetch_add(p, v, __ATOMIC_RELAXED, __HIP_MEMORY_SCOPE_AGENT); }
__device__ __forceinline__ unsigned xb_xcc_id() { return (unsigned)__builtin_amdgcn_s_getreg((3 << 11) | 20) & 0xFu; }
#define XB_SPIN(cond, bar) do { unsigned _sp = 0; while (cond) { __builtin_amdgcn_s_sleep(1); \
    if ((++_sp & 255u) == 0u) { if (xb_ld(&(bar)[XB_TMO])) break; if (_sp > XB_SPIN_CAP) { atomicAdd(&(bar)[XB_TMO], 1u); break; } } } } while (0)
struct XcdBarrier { unsigned* bar; unsigned x; volatile LAS unsigned* st; };
__device__ __forceinline__ int lane_id() { int l; asm volatile("v_mbcnt_lo_u32_b32 %0, -1, 0\n\tv_mbcnt_hi_u32_b32 %0, -1, %0" : "=v"(l)); return l; }
__device__ __forceinline__ XcdBarrier xcd_barrier_post(unsigned* bar, volatile LAS unsigned* st, bool t0) {
    XcdBarrier b; b.bar = bar; b.x = xb_xcc_id(); b.st = st;
    if (t0) (void)xb_add(&bar[XB_XCNT(b.x)], 1u);
    return b;
}
__device__ __forceinline__ void xcd_barrier_complete(unsigned* bar, unsigned x, unsigned& nloc, unsigned& nx) {
    const unsigned G = gridDim.x * gridDim.y * gridDim.z;
    unsigned sum, cnt, mine, sp = 0u;
    for (;;) {
        sum = 0u; cnt = 0u; mine = 0u;
#pragma unroll
        for (unsigned j = 0; j < 16; ++j) { const unsigned c = xb_ld(&bar[XB_XCNT(j)]); sum += c; cnt += (c > 0u) ? 1u : 0u; mine = (j == x) ? c : mine; }
        if (sum == G) break;
        __builtin_amdgcn_s_sleep(1);
        if ((++sp & 255u) == 0u) { if (xb_ld(&bar[XB_TMO])) break; if (sp > XB_SPIN_CAP) { atomicAdd(&bar[XB_TMO], 1u); break; } }
    }
    nloc = mine > 0u ? mine : 1u; nx = cnt > 0u ? cnt : 1u;
}
__device__ __forceinline__ void xcd_barrier(const XcdBarrier& b, int wave_s) {
    asm volatile("s_waitcnt vmcnt(0)" ::: "memory");
    __syncthreads();
    if (wave_s == 0 && lane_id() == 0) {
        unsigned* bar = b.bar;
        __builtin_amdgcn_s_waitcnt(0);
        unsigned nloc = b.st[0], nx = b.st[1];
        if (nloc == 0u) { xcd_barrier_complete(bar, b.x, nloc, nx); b.st[0] = nloc; b.st[1] = nx; }
        const unsigned old = xb_add(&bar[XB_XSUB(b.x)], 1u);
        const unsigned gen = old / nloc;
        if (old + 1u == (gen + 1u) * nloc) {
            __builtin_amdgcn_fence(__ATOMIC_RELEASE, "agent");
            asm volatile("s_waitcnt vmcnt(0)" ::: "memory");
            const unsigned og = xb_add(&bar[XB_TOP], 1u);
            const unsigned tg = og / nx;
            if (og + 1u == (tg + 1u) * nx) xb_add(&bar[XB_TOPGEN], 1u);
            else XB_SPIN(xb_ld(&bar[XB_TOPGEN]) == tg, bar);
            __builtin_amdgcn_fence(__ATOMIC_ACQUIRE, "agent");
            xb_add(&bar[XB_XGEN(b.x)], 1u);
            asm volatile("s_waitcnt vmcnt(0)" ::: "memory");
        } else {
            XB_SPIN(xb_ld(&bar[XB_XGEN(b.x)]) == gen, bar);
            __builtin_amdgcn_fence(__ATOMIC_ACQUIRE, "agent");
            asm volatile("s_waitcnt vmcnt(0)" ::: "memory");
        }
    }
    __syncthreads();
}

constexpr int BM = 256, BK = 64, HALF = 128, HTB = HALF * BK * 2, NXCD = 8, WGM = 8;
__host__ __device__ __forceinline__ int lds_byte(int r, int c) { const int st = (r >> 4) * 2 + (c >> 5), rr = r & 15, cc = c & 31, ob = rr * 64 + cc * 2; return st * 1024 + (ob ^ (((ob >> 9) & 1) << 5)); }
__host__ __device__ __forceinline__ void stage_rc(int b, int& R, int& C) { const int st = b / 1024, sb = b % 1024, swz = sb ^ (((sb >> 9) & 1) << 5); R = (st >> 1) * 16 + swz / 64; C = (st & 1) * 32 + (swz % 64) / 2; }
__host__ __device__ __forceinline__ int perm32(int rho) { const int n = rho >> 4, i = rho & 15; return 8 * (i >> 2) + 4 * n + (i & 3); }
struct Unit { int pm, pn, a0, a1; };
struct StaticOrder {
    int nM, nN, nwg, G, c;
    __device__ __forceinline__ void init(int M, int N, int G_, int c_) { nM = M / BM; nN = N / BM; nwg = nM * nN; G = G_; c = c_; }
    __device__ __forceinline__ bool next(int i, Unit& u) const {
        const long L = (long)i * G + c; if (L >= nwg) return false;
        int wgid = (int)L; { const int q = nwg / NXCD, r = nwg % NXCD, xcd = wgid % NXCD, off = wgid / NXCD; wgid = (xcd < r ? xcd * (q + 1) : r * (q + 1) + (xcd - r) * q) + off; }
        const int nig = WGM * nN, gid = wgid / nig, fm = gid * WGM, gsz = (nM - fm) < WGM ? (nM - fm) : WGM;
        u.pm = __builtin_amdgcn_readfirstlane(fm + ((wgid % nig) % gsz)); u.pn = __builtin_amdgcn_readfirstlane((wgid % nig) / gsz); u.a0 = 0; u.a1 = 0; return true;
    }
};
template <class P>
__device__ __forceinline__ void gemm_phase(LAS unsigned char* lds, const P& S, const int tid, const bool dry = false, const int stagger = 0) {
    const int wid = __builtin_amdgcn_readfirstlane(tid >> 6), lane = tid & 63, wr = wid >> 2, wc = wid & 3, fr = lane & 15, fq = lane >> 4;
    const int K = S.K, nt = K / BK;
    unsigned voffB[2]; unsigned vA[2][2];
    LAS u32x4* vslot = (LAS u32x4*)(lds + 131072) + tid;
#pragma unroll
    for (int i = 0; i < 2; ++i) { int R, C; stage_rc(tid * 16 + i * 8192, R, C); const int Rb = P::PERM ? ((R & ~31) + perm32(R & 31)) : R;
        voffB[i] = (unsigned)Rb * S.ldb + (unsigned)C * 2u;
#pragma unroll
        for (int h = 0; h < 2; ++h) vA[h][i] = (unsigned)(h * HALF + R) * S.lda + (unsigned)C * 2u; }
    const size_t kstep = (size_t)(BK * 2);
    const size_t hstepB = (size_t)HALF * S.ldb;
    const unsigned ldsw = (unsigned)wid * 1024u;
    const int aoff = lds_byte(wr * 64 + fr, fq * 8), boff = lds_byte(wc * 32 + fr, fq * 8);
#define PG8_SA(b, h) (((b) * 2 + (h)) * HTB)
#define PG8_SB(b, h) ((4 + (b) * 2 + (h)) * HTB)
#define PG8_STAGE(bufoff, gbase, voff) do { _Pragma("unroll") for (int _i = 0; _i < 2; ++_i) \
        __builtin_amdgcn_global_load_lds((const unsigned*)((const char*)(gbase) + (voff)[_i]), (LAS unsigned*)(lds + (bufoff) + ldsw + _i * 8192), 16, 0, 0); } while (0)
#define PG8_LDA(dst, b, h) do { _Pragma("unroll") for (int m = 0; m < 4; ++m) _Pragma("unroll") for (int k = 0; k < 2; ++k) dst[m][k] = *(const LAS bf16x8*)(lds + PG8_SA(b, h) + aoff + m * 2048 + k * 1024); } while (0)
#define PG8_LDB(dst, b, h) do { _Pragma("unroll") for (int n = 0; n < 2; ++n) _Pragma("unroll") for (int k = 0; k < 2; ++k) dst[n][k] = *(const LAS bf16x8*)(lds + PG8_SB(b, h) + boff + n * 2048 + k * 1024); } while (0)
#define PG8_MMA(ai, bj, At, Bt) do { __builtin_amdgcn_s_setprio(1); _Pragma("unroll") for (int m = 0; m < 4; ++m) _Pragma("unroll") for (int n = 0; n < 2; ++n) _Pragma("unroll") for (int k = 0; k < 2; ++k) \
        acc[ai][bj][m][n] = __builtin_amdgcn_mfma_f32_16x16x32_bf16(Bt[n][k], At[m][k], acc[ai][bj][m][n], 0, 0, 0); __builtin_amdgcn_s_setprio(0); } while (0)
#define PG8_WAIT_V(n) asm volatile("s_waitcnt vmcnt(" #n ")" ::: "memory")
#define PG8_WAIT_L(n) asm volatile("s_waitcnt lgkmcnt(" #n ")" ::: "memory")
#define PG8_BAR __builtin_amdgcn_s_barrier()
#define PG8_SCHED __builtin_amdgcn_sched_barrier(0)
    Unit cur, nxt; int ui = 0;
    if (!S.next(0, cur)) return;
    if (stagger > 0) { const int cls = (int)(blockIdx.x & 7u); for (int i = 0; i < cls * stagger; ++i) __builtin_amdgcn_s_sleep(16); }
    f32x4 acc[2][2][4][2];
#pragma unroll
    for (int a = 0; a < 2; ++a)
#pragma unroll
        for (int b = 0; b < 2; ++b)
#pragma unroll
            for (int m = 0; m < 4; ++m)
#pragma unroll
                for (int n = 0; n < 2; ++n) acc[a][b][m][n] = (f32x4){0.f, 0.f, 0.f, 0.f};
    bf16x8 At[4][2], B0[2][2], B1[2][2];
    const char* cA = S.a_base(cur); const char* cB = S.b_base(cur);
    bool skip_hi = P::HALFABLE && (cur.a0 >> 6) != 0;
    if constexpr (P::GATHER) { S.a_rows(cur, tid, vA); }
    PG8_STAGE(PG8_SB(0, 0), cB, voffB); PG8_STAGE(PG8_SB(0, 1), cB + hstepB, voffB); PG8_STAGE(PG8_SA(0, 0), cA, vA[0]); PG8_STAGE(PG8_SA(0, 1), cA, vA[1]);
    if (wr == 1) PG8_BAR;
    PG8_WAIT_V(2); PG8_BAR;
    PG8_STAGE(PG8_SB(1, 0), cB + kstep, voffB); PG8_STAGE(PG8_SA(1, 0), cA + kstep, vA[0]); PG8_STAGE(PG8_SB(1, 1), cB + hstepB + kstep, voffB);
    PG8_WAIT_V(6); PG8_BAR;
    for (;;) {
        const bool has_next = S.next(ui + 1, nxt);
        const char* nA = has_next ? S.a_base(nxt) : cA; const char* nB = has_next ? S.b_base(nxt) : cB;
        for (int t = 0; t < nt; t += 2) {
            const bool last = (t == nt - 2);
            if constexpr (P::GATHER) { if (t == nt - 4 && has_next) { unsigned tn[2][2]; S.a_rows(nxt, tid, tn); *vslot = (u32x4){tn[0][0], tn[0][1], tn[1][0], tn[1][1]}; } }
            const char* a1 = cA + (size_t)(t + 1) * kstep;
            const char* a2 = last ? nA : cA + (size_t)(t + 2) * kstep; const char* b2 = last ? nB : cB + (size_t)(t + 2) * kstep;
            const char* a3 = a2 + kstep; const char* b3 = b2 + kstep;
            unsigned v2[2][2];
#pragma unroll
            for (int h = 0; h < 2; ++h)
#pragma unroll
                for (int i = 0; i < 2; ++i) v2[h][i] = vA[h][i];
            if constexpr (P::GATHER) { if (last && has_next) { const u32x4 tn = *vslot; v2[0][0] = tn.x; v2[0][1] = tn.y; v2[1][0] = tn.z; v2[1][1] = tn.w; } }
            PG8_LDB(B0, 0, 0); PG8_LDB(B1, 0, 1); PG8_SCHED; PG8_LDA(At, 0, 0); PG8_STAGE(PG8_SA(1, 1), a1, vA[1]);
            PG8_WAIT_V(8); PG8_WAIT_L(0); PG8_BAR; PG8_MMA(0, 0, At, B0); PG8_MMA(0, 1, At, B1); PG8_BAR; PG8_SCHED;
            PG8_LDA(At, 0, 1); PG8_STAGE(PG8_SB(0, 0), b2, voffB); PG8_STAGE(PG8_SB(0, 1), b2 + hstepB, voffB); PG8_STAGE(PG8_SA(0, 0), a2, v2[0]);
            PG8_WAIT_V(8); PG8_WAIT_L(0); PG8_BAR; if (!skip_hi) { PG8_MMA(1, 0, At, B0); PG8_MMA(1, 1, At, B1); } PG8_BAR; PG8_SCHED;
            PG8_LDB(B0, 1, 0); PG8_LDB(B1, 1, 1); PG8_SCHED; PG8_LDA(At, 1, 0); PG8_STAGE(PG8_SA(0, 1), a2, v2[1]);
            PG8_WAIT_V(8); PG8_WAIT_L(0); PG8_BAR; PG8_MMA(0, 0, At, B0); PG8_MMA(0, 1, At, B1); PG8_BAR; PG8_SCHED;
            PG8_LDA(At, 1, 1); PG8_STAGE(PG8_SB(1, 0), b3, voffB); PG8_STAGE(PG8_SB(1, 1), b3 + hstepB, voffB); PG8_STAGE(PG8_SA(1, 0), a3, v2[0]);
            PG8_WAIT_V(8); PG8_WAIT_L(0); PG8_BAR; if (!skip_hi) { PG8_MMA(1, 0, At, B0); PG8_MMA(1, 1, At, B1); } PG8_BAR; PG8_SCHED;
        }
        if (wr == 0) PG8_BAR;
        { int fr_e = fr, fq_e = fq; asm volatile("" : "+v"(fr_e), "+v"(fq_e));
          if (!dry) S.epi(acc, cur, wr, wc, fr_e, fq_e); }
        if (!has_next) break;
#pragma unroll
        for (int a = 0; a < 2; ++a)
#pragma unroll
            for (int b = 0; b < 2; ++b)
#pragma unroll
                for (int m = 0; m < 4; ++m)
#pragma unroll
                    for (int n = 0; n < 2; ++n) acc[a][b][m][n] = (f32x4){0.f, 0.f, 0.f, 0.f};
        cur = nxt; cA = nA; cB = nB; ++ui; skip_hi = P::HALFABLE && (cur.a0 >> 6) != 0;
        if constexpr (P::GATHER) { const u32x4 tn = *vslot; vA[0][0] = tn.x; vA[0][1] = tn.y; vA[1][0] = tn.z; vA[1][1] = tn.w; }
        if (wr == 1) PG8_BAR;
    }
    PG8_WAIT_V(0);
    PG8_BAR;
#undef PG8_SA
#undef PG8_SB
#undef PG8_STAGE
#undef PG8_LDA
#undef PG8_LDB
#undef PG8_MMA
#undef PG8_WAIT_V
#undef PG8_WAIT_L
#undef PG8_BAR
#undef PG8_SCHED
}
struct PlainBase {
    const char* A; const char* Bt; unsigned lda, ldb; int K; StaticOrder so;
    __device__ __forceinline__ bool next(int i, Unit& u) const { return so.next(i, u); }
    __device__ __forceinline__ const char* a_base(const Unit& u) const { return A + (size_t)u.pm * BM * lda; }
    __device__ __forceinline__ const char* b_base(const Unit& u) const { return Bt + (size_t)u.pn * BM * ldb; }
    __device__ __forceinline__ void a_rows(const Unit&, int, unsigned (&)[2][2]) const {}
};
__device__ __forceinline__ float head_l2g(int h) { return __builtin_log2f(1.0f - __builtin_amdgcn_exp2f(-5.0f - (float)h)); }

struct P_QKV0 : PlainBase {
    static constexpr bool PERM = true, GATHER = false, HALFABLE = false;
    bf16* qk; bf16* v; const float* cs; const float* sn;
    int i0, i1;
    __device__ __forceinline__ bool next(int i, Unit& u) const { return (i + i0 < i1) && so.next(i + i0, u); }
    __device__ __forceinline__ void epi(const f32x4 (&acc)[2][2][4][2], const Unit& u, int wr, int wc, int fr, int fq) const {
        const int row0 = u.pm * BM + wr * 64 + fr, pn = u.pn;
        if (pn < 8) {
            const int hh = pn & 3; const bool isk = pn >= 4; bf16* dst = qk + (size_t)(pn >> 2) * ((size_t)T * 1024);
            const float l2g = isk ? -head_l2g(hh) : head_l2g(hh);
            float invr[2][4];
#pragma unroll
            for (int bj = 0; bj < 2; ++bj)
#pragma unroll
                for (int p = 0; p < 4; ++p) invr[bj][p] = __builtin_amdgcn_exp2f((float)(bj * 64 + wc * 16 + 4 * fq + p) * (-13.287712379549449f / 127.0f)) * 0.15915494309189535f;
#pragma unroll
            for (int ai = 0; ai < 2; ++ai)
#pragma unroll
                for (int m = 0; m < 4; ++m) { const int row = row0 + ai * HALF + m * 16, pos = row & (SEQ - 1);
                    const float sc = __builtin_amdgcn_exp2f(l2g * (float)(pos & 63)), fp = (float)pos;
#pragma unroll
                    for (int bj = 0; bj < 2; ++bj) { const int c0 = bj * HALF + wc * 32 + 8 * fq;
                        float cv[4], sv[4];
#pragma unroll
                        for (int p = 0; p < 4; ++p) { const float rev = fp * invr[bj][p], fr_ = rev - __builtin_floorf(rev); cv[p] = __builtin_amdgcn_cosf(fr_) * sc; sv[p] = __builtin_amdgcn_sinf(fr_) * sc; }
                        const f32x4 v0 = acc[ai][bj][m][0], v1 = acc[ai][bj][m][1];
                        u32x4 w;
                        w.x = cvt_pk_bf16(v0[0] * cv[0] - v0[1] * sv[0], v0[0] * sv[0] + v0[1] * cv[0]);
                        w.y = cvt_pk_bf16(v0[2] * cv[1] - v0[3] * sv[1], v0[2] * sv[1] + v0[3] * cv[1]);
                        w.z = cvt_pk_bf16(v1[0] * cv[2] - v1[1] * sv[2], v1[0] * sv[2] + v1[1] * cv[2]);
                        w.w = cvt_pk_bf16(v1[2] * cv[3] - v1[3] * sv[3], v1[2] * sv[3] + v1[3] * cv[3]);
                        *(u32x4*)(dst + (size_t)row * 1024 + hh * 256 + c0) = w; } }
        } else {
#pragma unroll
            for (int ai = 0; ai < 2; ++ai)
#pragma unroll
                for (int m = 0; m < 4; ++m) { const int row = row0 + ai * HALF + m * 16;
#pragma unroll
                    for (int bj = 0; bj < 2; ++bj) { const int c0 = bj * HALF + wc * 32 + 8 * fq;
                        const f32x4 v0 = acc[ai][bj][m][0], v1 = acc[ai][bj][m][1];
                        u32x4 w; w.x = cvt_pk_bf16(v0[0], v0[1]); w.y = cvt_pk_bf16(v0[2], v0[3]); w.z = cvt_pk_bf16(v1[0], v1[1]); w.w = cvt_pk_bf16(v1[2], v1[3]);
                        *(u32x4*)(v + (size_t)row * 2048 + (pn - 8) * 256 + c0) = w; } }
        }
    }
};
struct P_GATE : PlainBase {
    static constexpr bool PERM = true, GATHER = false, HALFABLE = false;
    bf16* ov; const float* ssq;
    __device__ __forceinline__ void epi(const f32x4 (&acc)[2][2][4][2], const Unit& u, int wr, int wc, int fr, int fq) const {
        const int row0 = u.pm * BM + wr * 64 + fr, head = u.pn >> 1;
#pragma unroll
        for (int ai = 0; ai < 2; ++ai) {
            f32x4 s0[4], s1[4]; u32x4 ov4[4][2];
#pragma unroll
            for (int m = 0; m < 4; ++m) { const int row = row0 + ai * HALF + m * 16;
                s0[m] = *(const f32x4*)(ssq + ((size_t)row * 4 + head) * 8); s1[m] = *(const f32x4*)(ssq + ((size_t)row * 4 + head) * 8 + 4);
#pragma unroll
                for (int bj = 0; bj < 2; ++bj) ov4[m][bj] = *(const u32x4*)(ov + (size_t)row * 2048 + u.pn * BM + bj * HALF + wc * 32 + 8 * fq); }
#pragma unroll
            for (int m = 0; m < 4; ++m) { const int row = row0 + ai * HALF + m * 16;
                const float rs = __builtin_amdgcn_rsqf((((s0[m][0] + s0[m][1]) + (s0[m][2] + s0[m][3])) + ((s1[m][0] + s1[m][1]) + (s1[m][2] + s1[m][3]))) * (1.0f / 512.0f) + 1e-6f);
#pragma unroll
                for (int bj = 0; bj < 2; ++bj) { const u32x4 o = ov4[m][bj];
                    const f32x4 v0 = acc[ai][bj][m][0], v1 = acc[ai][bj][m][1];
                    u32x4 w;
                    w.x = cvt_pk_bf16(silu_f(v0[0]) * bf_lo(o.x) * rs, silu_f(v0[1]) * bf_hi(o.x) * rs);
                    w.y = cvt_pk_bf16(silu_f(v0[2]) * bf_lo(o.y) * rs, silu_f(v0[3]) * bf_hi(o.y) * rs);
                    w.z = cvt_pk_bf16(silu_f(v1[0]) * bf_lo(o.z) * rs, silu_f(v1[1]) * bf_hi(o.z) * rs);
                    w.w = cvt_pk_bf16(silu_f(v1[2]) * bf_lo(o.w) * rs, silu_f(v1[3]) * bf_hi(o.w) * rs);
                    *(u32x4*)(ov + (size_t)row * 2048 + u.pn * BM + bj * HALF + wc * 32 + 8 * fq) = w; } }
        }
    }
};
struct P_RESB : PlainBase {
    static constexpr bool PERM = true, GATHER = false, HALFABLE = false;
    const float* res32; bf16* hb; int row_off;
    __device__ __forceinline__ void epi(const f32x4 (&acc)[2][2][4][2], const Unit& u, int wr, int wc, int fr, int fq) const {
        const int row0 = row_off + u.pm * BM + wr * 64 + fr;
#pragma unroll
        for (int ai = 0; ai < 2; ++ai) {
            f32x4 r[4][2][2];
#pragma unroll
            for (int m = 0; m < 4; ++m) { const size_t off = (size_t)(row0 + ai * HALF + m * 16) * D + u.pn * BM + wc * 32 + 8 * fq;
#pragma unroll
                for (int bj = 0; bj < 2; ++bj) {
                    if (res32) { r[m][bj][0] = *(const f32x4*)(res32 + off + bj * HALF); r[m][bj][1] = *(const f32x4*)(res32 + off + bj * HALF + 4); }
                    else { const u32x4 o = *(const u32x4*)(hb + off + bj * HALF); r[m][bj][0] = (f32x4){bf_lo(o.x), bf_hi(o.x), bf_lo(o.y), bf_hi(o.y)}; r[m][bj][1] = (f32x4){bf_lo(o.z), bf_hi(o.z), bf_lo(o.w), bf_hi(o.w)}; } } }
#pragma unroll
            for (int m = 0; m < 4; ++m) { const size_t off = (size_t)(row0 + ai * HALF + m * 16) * D + u.pn * BM + wc * 32 + 8 * fq;
#pragma unroll
                for (int bj = 0; bj < 2; ++bj) { const f32x4 r0 = r[m][bj][0] + acc[ai][bj][m][0], r1 = r[m][bj][1] + acc[ai][bj][m][1];
                    u32x4 w; w.x = cvt_pk_bf16(r0[0], r0[1]); w.y = cvt_pk_bf16(r0[2], r0[3]); w.z = cvt_pk_bf16(r1[0], r1[1]); w.w = cvt_pk_bf16(r1[2], r1[3]);
                    *(u32x4*)(hb + off + bj * HALF) = w; } }
        }
    }
};
struct P_QKV1 : PlainBase {
    static constexpr bool PERM = true, GATHER = false, HALFABLE = false;
    bf16* qkv; const float* gains; const float* rs1;
    __device__ __forceinline__ void epi(const f32x4 (&acc)[2][2][4][2], const Unit& u, int wr, int wc, int fr, int fq) const {
        const int row0 = u.pm * BM + wr * 64 + fr, part = u.pn / 12, pp = u.pn % 12, g = pp >> 2, head = (pp & 3) * 4 + wc;
        const int Rg = g == 0 ? 1 : (g == 1 ? 4 : 16), shR = g == 0 ? 0 : (g == 1 ? 2 : 4);
        bf16* dst = qkv + (size_t)part * ((size_t)TC * 3072) + (size_t)(g * 16 + head) * (SEQ * 64) + 8 * fq;
        const float* gp = gains + (part & 1) * 192 + g * 64 + 8 * fq;
        const float qs = part == 0 ? 0.125f * 1.4426950408889634f : 1.0f;
        float rsr[2][4];
#pragma unroll
        for (int ai = 0; ai < 2; ++ai)
#pragma unroll
            for (int m = 0; m < 4; ++m) rsr[ai][m] = rs1[row0 + ai * HALF + m * 16];
        f32x4 gv[2][2];
#pragma unroll
        for (int bj = 0; bj < 2; ++bj) { gv[bj][0] = *(const f32x4*)(gp + 32 * bj); gv[bj][1] = *(const f32x4*)(gp + 32 * bj + 4); }
#pragma unroll
        for (int ai = 0; ai < 2; ++ai)
#pragma unroll
            for (int m = 0; m < 4; ++m) { const int row = row0 + ai * HALF + m * 16;
                float rs = rsr[ai][m];
                if (part < 2) {
                    float ss = 0.f;
#pragma unroll
                    for (int bj = 0; bj < 2; ++bj)
#pragma unroll
                        for (int n = 0; n < 2; ++n) { const f32x4 t = acc[ai][bj][m][n]; ss += (t[0] * t[0] + t[1] * t[1]) + (t[2] * t[2] + t[3] * t[3]); }
                    ss = xsum32(xsum16(ss));
                    rs = rs * __builtin_amdgcn_rsqf(ss * rs * rs * (1.0f / 64.0f) + 1e-6f) * qs;
                }
#pragma unroll
                for (int bj = 0; bj < 2; ++bj) { f32x4 v0 = acc[ai][bj][m][0], v1 = acc[ai][bj][m][1];
                    if (part < 2) { v0 = v0 * gv[bj][0] * rs; v1 = v1 * gv[bj][1] * rs; } else { v0 = v0 * rs; v1 = v1 * rs; }
                    u32x4 w; w.x = cvt_pk_bf16(v0[0], v0[1]); w.y = cvt_pk_bf16(v0[2], v0[3]); w.z = cvt_pk_bf16(v1[0], v1[1]); w.w = cvt_pk_bf16(v1[2], v1[3]);
                    { const int bl = row >> 11, t = row & (SEQ - 1), pos = (t & (Rg - 1)) * (SEQ >> shR) + (t >> shR); *(u32x4*)(dst + ((size_t)bl * 48 * SEQ + pos) * 64 + 32 * bj) = w; } } }
    }
};
__device__ __forceinline__ void moe_build_tab(LAS int* tab, const unsigned* cnt_g, const int tid) {
    if (tid < 64) tab[tid] = (int)__hip_atomic_load(cnt_g + tid * 64, __ATOMIC_RELAXED, __HIP_MEMORY_SCOPE_AGENT);
    __syncthreads();
    if (tid < 64) { int pre = 0, fpre = 0, hpre = 0, ftot = 0, tot = 0;
        for (int b = 0; b < 64; ++b) { const int c = tab[b], nt = (c + 255) >> 8, hf = (nt > 0 && c - 256 * (nt - 1) <= 128) ? 1 : 0, fl = nt - hf;
            if (b < tid) { pre += nt; fpre += fl; hpre += hf; } ftot += fl; tot += nt; }
        const int c = tab[tid], nt = (c + 255) >> 8, hf = (nt > 0 && c - 256 * (nt - 1) <= 128) ? 1 : 0;
        tab[64 + tid] = pre; if (tid == 0) tab[128] = tot;
        for (int t = 0; t < nt - hf; ++t) tab[160 + fpre + t] = tid | (t << 8);
        if (hf) tab[160 + ftot + hpre] = tid | 64 | ((nt - 1) << 8); }
    __syncthreads();
}
__device__ __forceinline__ int moe_sched(const LAS int* tab, int pos) { return __builtin_amdgcn_readfirstlane(tab[160 + pos]); }
struct P_GU {
    static constexpr bool PERM = true, GATHER = true, HALFABLE = true;
      const char* xn; const char* W; const int* list; bf16* hid; const LAS int* tab; int G, vcu; int K; unsigned lda, ldb;
    __device__ __forceinline__ bool next(int i, Unit& u) const {
        const int L = i * G + vcu; if (L >= tab[128] * 4) return false;
        const int e = moe_sched(tab, L >> 2), b = e & 63;
        u.pm = e >> 8; u.pn = L & 3; u.a0 = e & 127; u.a1 = tab[64 + b] + (e >> 8); return true;
    }
    __device__ __forceinline__ const char* a_base(const Unit&) const { return xn; }
    __device__ __forceinline__ const char* b_base(const Unit& u) const { return W + ((size_t)(u.a0 & 31) * 1024 + (size_t)u.pn * BM) * 2048; }
    __device__ __forceinline__ void a_rows(const Unit& u, int tid, unsigned (&off)[2][2]) const {
        const int n = tab[u.a0 & 63]; const int* lp = list + (size_t)(u.a0 & 63) * T + u.pm * BM;
#pragma unroll
        for (int i = 0; i < 2; ++i) { int R, C; stage_rc(tid * 16 + i * 8192, R, C);
#pragma unroll
            for (int h = 0; h < 2; ++h) { const int r = h * HALF + R; const int tok = (u.pm * BM + r < n) ? lp[r] : 0; off[h][i] = (unsigned)tok * 2048u + (unsigned)C * 2u; } }
    }
    __device__ __forceinline__ void epi(const f32x4 (&acc)[2][2][4][2], const Unit& u, int wr, int wc, int fr, int fq) const {
        const size_t hrow0 = (size_t)u.a1 * BM + wr * 64 + fr; const int n = tab[u.a0 & 63]; const int* lp = list + (size_t)(u.a0 & 63) * T + u.pm * BM;
        float rsr[2][4];
#pragma unroll
        for (int ai = 0; ai < 2; ++ai)
#pragma unroll
            for (int m = 0; m < 4; ++m) { const int r = ai * HALF + wr * 64 + m * 16 + fr; rsr[ai][m] = (u.pm * BM + r < n) ? *(const float*)((const char*)(lp + r) - (WS_LIST - WS_ML)) : 0.0f; }
#pragma unroll
        for (int ai = 0; ai < 2; ++ai)
#pragma unroll
            for (int m = 0; m < 4; ++m) { const float rs = rsr[ai][m];
                { const int f0 = u.pn * HALF + wc * 32 + 8 * fq;
                    const f32x4 g0 = acc[ai][0][m][0] * rs, g1 = acc[ai][0][m][1] * rs, u0 = acc[ai][1][m][0] * rs, u1 = acc[ai][1][m][1] * rs;
                    u32x4 w; w.x = cvt_pk_bf16(silu_f(g0[0]) * u0[0], silu_f(g0[1]) * u0[1]); w.y = cvt_pk_bf16(silu_f(g0[2]) * u0[2], silu_f(g0[3]) * u0[3]);
                    w.z = cvt_pk_bf16(silu_f(g1[0]) * u1[0], silu_f(g1[1]) * u1[1]); w.w = cvt_pk_bf16(silu_f(g1[2]) * u1[2], silu_f(g1[3]) * u1[3]);
                    *(u32x4*)(hid + (hrow0 + ai * HALF + m * 16) * FF + f0) = w; } }
    }
};
struct P_DN {
    static constexpr bool PERM = true, GATHER = false, HALFABLE = true;
    const char* hid; const char* W; bf16* y; const LAS int* tab; int G, vcu; int K; unsigned lda, ldb;
    __device__ __forceinline__ bool next(int i, Unit& u) const {
        const int L = i * G + vcu; if (L >= tab[128] * 4) return false;
        const int e = moe_sched(tab, L >> 2), b = e & 63;
        u.pm = e >> 8; u.pn = L & 3; u.a0 = e & 127; u.a1 = tab[64 + b] + (e >> 8); return true;
    }
    __device__ __forceinline__ const char* a_base(const Unit& u) const { return hid + (size_t)u.a1 * BM * 1024; }
    __device__ __forceinline__ const char* b_base(const Unit& u) const { return W + ((size_t)(u.a0 & 31) * 1024 + (size_t)u.pn * BM) * 1024; }
    __device__ __forceinline__ void a_rows(const Unit&, int, unsigned (&)[2][2]) const {}
    __device__ __forceinline__ void epi(const f32x4 (&acc)[2][2][4][2], const Unit& u, int wr, int wc, int fr, int fq) const {
        bf16* yp = y + ((size_t)u.a1 * BM + wr * 64 + fr) * D + u.pn * BM + wc * 32 + 8 * fq;
#pragma unroll
        for (int ai = 0; ai < 2; ++ai)
#pragma unroll
            for (int m = 0; m < 4; ++m)
#pragma unroll
                for (int bj = 0; bj < 2; ++bj) { const f32x4 v0 = acc[ai][bj][m][0], v1 = acc[ai][bj][m][1];
                    u32x4 w; w.x = cvt_pk_bf16(v0[0], v0[1]); w.y = cvt_pk_bf16(v0[2], v0[3]); w.z = cvt_pk_bf16(v1[0], v1[1]); w.w = cvt_pk_bf16(v1[2], v1[3]);
                    *(u32x4*)(yp + (size_t)(ai * HALF + m * 16) * D + bj * HALF) = w; }
    }
};
__device__ __forceinline__ void combine_phase(bf16* hb, const bf16* y, const unsigned* binpos, const float* gatew, const LAS int* tab, float* out32, float* rs_out, int gw, int ngw, int lane) {
    for (int tk = gw; tk < T; tk += ngw) {
        const unsigned bp0 = binpos[tk * 2], bp1 = binpos[tk * 2 + 1]; const float g0 = gatew[tk * 2], g1 = gatew[tk * 2 + 1];
        const size_t r0 = (size_t)tab[64 + (bp0 >> 16)] * BM + (bp0 & 0xffffu), r1 = (size_t)tab[64 + (bp1 >> 16)] * BM + (bp1 & 0xffffu);
        GAS u32x4* hp = (GAS u32x4*)(hb + (size_t)tk * D) + lane;
        const GAS u32x4* y0 = (const GAS u32x4*)(y + r0 * D) + lane; const GAS u32x4* y1 = (const GAS u32x4*)(y + r1 * D) + lane;
        u32x4 hh[2], a[2], b[2];
#pragma unroll
        for (int j = 0; j < 2; ++j) { hh[j] = hp[64 * j]; a[j] = y0[64 * j]; b[j] = y1[64 * j]; }
        float v[2][8]; float s = 0.f;
#pragma unroll
        for (int j = 0; j < 2; ++j) {
            v[j][0] = bf_lo(hh[j].x) + g0 * bf_lo(a[j].x) + g1 * bf_lo(b[j].x); v[j][1] = bf_hi(hh[j].x) + g0 * bf_hi(a[j].x) + g1 * bf_hi(b[j].x);
            v[j][2] = bf_lo(hh[j].y) + g0 * bf_lo(a[j].y) + g1 * bf_lo(b[j].y); v[j][3] = bf_hi(hh[j].y) + g0 * bf_hi(a[j].y) + g1 * bf_hi(b[j].y);
            v[j][4] = bf_lo(hh[j].z) + g0 * bf_lo(a[j].z) + g1 * bf_lo(b[j].z); v[j][5] = bf_hi(hh[j].z) + g0 * bf_hi(a[j].z) + g1 * bf_hi(b[j].z);
            v[j][6] = bf_lo(hh[j].w) + g0 * bf_lo(a[j].w) + g1 * bf_lo(b[j].w); v[j][7] = bf_hi(hh[j].w) + g0 * bf_hi(a[j].w) + g1 * bf_hi(b[j].w);
#pragma unroll
            for (int e = 0; e < 8; ++e) s += v[j][e] * v[j][e]; }
        if (out32) { GAS f32x4* op = (GAS f32x4*)(out32 + (size_t)tk * D) + 2 * lane;
#pragma unroll
            for (int j = 0; j < 2; ++j) { op[128 * j] = (f32x4){v[j][0], v[j][1], v[j][2], v[j][3]}; op[128 * j + 1] = (f32x4){v[j][4], v[j][5], v[j][6], v[j][7]}; } }
        else {
#pragma unroll
            for (int j = 0; j < 2; ++j) { u32x4 w; w.x = cvt_pk_bf16(v[j][0], v[j][1]); w.y = cvt_pk_bf16(v[j][2], v[j][3]); w.z = cvt_pk_bf16(v[j][4], v[j][5]); w.w = cvt_pk_bf16(v[j][6], v[j][7]); hp[64 * j] = w; }
            const float rs = __builtin_amdgcn_rsqf(wave_sum(s) * (1.f / D) + 1e-6f); if (lane == 0) rs_out[tk] = rs; }
    }
}

struct MapId { int off; __device__ __forceinline__ int row(int n) const { return n + off; } __device__ __forceinline__ float scale(int) const { return 1.0f; } };
struct MapWin { __device__ __forceinline__ int row(int n) const { if (n >= 2048) return n; const int d = n & 255; return (n & ~255) + ((d < 128) ? 2 * d : 2 * (d - 128) + 1); }
                __device__ __forceinline__ float scale(int n) const { return (n >= 1024 && n < 2048) ? 0.0625f : 1.0f; } };
struct MapQkv1 { int base; __device__ __forceinline__ int row(int n) const { const int two = n / 3072, n1 = n % 3072, g = n1 >> 10, h = (n1 >> 6) & 15, d = n1 & 63;
                     return base + two * 3072 + (g * 4 + (h >> 2)) * 256 + 32 * (h & 3) + (d & 31) + 128 * (d >> 5); }
                 __device__ __forceinline__ float scale(int) const { return 1.0f; } };
struct MapGu { int up; __device__ __forceinline__ int row(int f) const { return (f >> 7) * 256 + (f & 127) + 128 * up; }     __device__ __forceinline__ float scale(int) const { return 1.0f; } };
__device__ __forceinline__ void transpose_load(const float* W, int N, int item, int lane, f32x4 (&v)[16]) {
    const int nblk = N / 64, kb = item / nblk, nb = item % nblk, k0 = 64 * kb, n0 = 64 * nb;
#pragma unroll
    for (int i = 0; i < 16; ++i) v[i] = __builtin_nontemporal_load((const GAS f32x4*)(W + (size_t)(k0 + 4 * i + (lane >> 4)) * N + n0 + 4 * (lane & 15)));
}
template <class Map>
__device__ __forceinline__ void transpose_finish(const f32x4 (&v)[16], int N, bf16* WT, int ldt, LAS float* scr, int item, int lane, const float* gain, const Map mp) {
    const int nblk = N / 64, kb = item / nblk, nb = item % nblk, k0 = 64 * kb, n0 = 64 * nb;
#pragma unroll
    for (int i = 0; i < 16; ++i) { const int kk = 4 * i + (lane >> 4); const float gg = gain ? gain[k0 + kk] : 1.0f; LAS float* d = scr + kk * 65 + 4 * (lane & 15);
        d[0] = v[i][0] * gg; d[1] = v[i][1] * gg; d[2] = v[i][2] * gg; d[3] = v[i][3] * gg; }
    LDS_WAIT(); asm volatile("" ::: "memory");
    const int c = lane & 7;
#pragma unroll
    for (int j = 0; j < 8; ++j) { const int n = (lane >> 3) + 8 * j; const LAS float* s = scr + (8 * c) * 65 + n; const float sc = mp.scale(n0 + n);
        u32x4 o; o.x = pk2(s[0 * 65] * sc, s[1 * 65] * sc); o.y = pk2(s[2 * 65] * sc, s[3 * 65] * sc); o.z = pk2(s[4 * 65] * sc, s[5 * 65] * sc); o.w = pk2(s[6 * 65] * sc, s[7 * 65] * sc);
        *(GAS u32x4*)(WT + (size_t)mp.row(n0 + n) * ldt + k0 + 8 * c) = o; }
    LDS_WAIT(); asm volatile("" ::: "memory");
}
template <class Map>
__device__ __forceinline__ void transpose_item(const float* W, int N, bf16* WT, int ldt, LAS float* scr, int item, int lane, const float* gain, const Map mp) {
    f32x4 v[16]; transpose_load(W, N, item, lane, v); transpose_finish(v, N, WT, ldt, scr, item, lane, gain, mp);
}
template <class Map>
__device__ __forceinline__ void transpose_matrix(const float* W, int K, int N, bf16* WT, LAS float* scr, int gw, int ngw, int lane, const float* gain, const Map mp) {
    const int nitems = (K / 64) * (N / 64);
    if (gw >= nitems) return;
    f32x4 v[16]; transpose_load(W, N, gw, lane, v);
    for (int it = gw; it < nitems; it += ngw) { f32x4 cur[16];
#pragma unroll
        for (int i = 0; i < 16; ++i) cur[i] = v[i];
        if (it + ngw < nitems) transpose_load(W, N, it + ngw, lane, v);
        transpose_finish(cur, N, WT, K, scr, it, lane, gain, mp); }
}
__device__ __forceinline__ void rms_row_to_bf16(const float* xrow, bf16* orow, int lane) {
    const GAS f32x4* xr = (const GAS f32x4*)xrow + lane;
    f32x4 v[4]; float s = 0.f;
#pragma unroll
    for (int j = 0; j < 4; ++j) { v[j] = xr[64 * j]; s += (v[j].x * v[j].x + v[j].y * v[j].y) + (v[j].z * v[j].z + v[j].w * v[j].w); }
    const float rs = __builtin_amdgcn_rsqf(wave_sum(s) * (1.f / D) + 1e-6f);
    GAS unsigned long long* o8 = (GAS unsigned long long*)orow + lane;
#pragma unroll
    for (int j = 0; j < 4; ++j) o8[64 * j] = (unsigned long long)pk2(v[j].x * rs, v[j].y * rs) | ((unsigned long long)pk2(v[j].z * rs, v[j].w * rs) << 32);
}
__device__ __forceinline__ unsigned swz(int row, int bytecol, int stride) { return (unsigned)(row * stride + ((((bytecol >> 4) ^ (row & 7)) << 4) | (bytecol & 15))); }
__device__ __forceinline__ unsigned swzb(int row, int bytecol, int stride) { return (unsigned)(row * stride + ((((bytecol >> 4) ^ (((row & 3) << 1) | (row & 8))) << 4) | (bytecol & 15))); }
__device__ __forceinline__ bf16x8 fragb_row(const LAS unsigned char* img, int row0, int bytecol0, int stride, int fr, int fq) {
    return *(const LAS bf16x8*)(img + swzb(row0 + fr, bytecol0 + 16 * fq, stride));
}
__device__ __forceinline__ bf16x8 fragb_tr(const LAS unsigned char* img, int k0, int c0, int stride, int lane) {
    const int fq = lane >> 4, q = (lane & 15) >> 2, p = lane & 3;
    const s16x4 lo = __builtin_amdgcn_ds_read_tr16_b64_v4i16((LAS s16x4*)(img + swzb(k0 + 8 * fq + q, (c0 + 4 * p) * 2, stride)));
    const s16x4 hi = __builtin_amdgcn_ds_read_tr16_b64_v4i16((LAS s16x4*)(img + swzb(k0 + 8 * fq + 4 + q, (c0 + 4 * p) * 2, stride)));
    return (bf16x8){lo[0], lo[1], lo[2], lo[3], hi[0], hi[1], hi[2], hi[3]};
}
__device__ __forceinline__ bf16x8 frag_row(const LAS unsigned char* img, int row0, int bytecol0, int stride, int fr, int fq) {
    return *(const LAS bf16x8*)(img + swz(row0 + fr, bytecol0 + 16 * fq, stride));
}
__device__ __forceinline__ bf16x8 frag_tr2(const LAS unsigned char* img, int rowa, int rowb, int c0, int stride, int lane) {
    const int fq = lane >> 4, q = (lane & 15) >> 2, p = lane & 3;
    const s16x4 lo = __builtin_amdgcn_ds_read_tr16_b64_v4i16((LAS s16x4*)(img + swz(rowa + 4 * fq + q, (c0 + 4 * p) * 2, stride)));
    const s16x4 hi = __builtin_amdgcn_ds_read_tr16_b64_v4i16((LAS s16x4*)(img + swz(rowb + 4 * fq + q, (c0 + 4 * p) * 2, stride)));
    return (bf16x8){lo[0], lo[1], lo[2], lo[3], hi[0], hi[1], hi[2], hi[3]};
}
__device__ __forceinline__ bf16x8 frag_tr(const LAS unsigned char* img, int k0, int c0, int stride, int lane) {
    const int fq = lane >> 4; return frag_tr2(img, k0 + 4 * fq, k0 + 4 * fq + 4, c0, stride, lane);
}
#define MFMA16(a, b, c) __builtin_amdgcn_mfma_f32_16x16x32_bf16((a), (b), (c), 0, 0, 0)

__device__ __forceinline__ int xt4(int row) { return (0x1230 >> (((row >> 2) & 3) * 4)) & 3; }
__device__ __forceinline__ unsigned pnl(int row, int col, int PS) { return (unsigned)((col >> 5) * PS + row * 64 + (((((col & 31) >> 3)) ^ xt4(row)) << 4) + (col & 7) * 2); }
#define TRREAD(p) __builtin_amdgcn_ds_read_tr16_b64_v4i16((LAS s16x4*)(p))
__device__ __forceinline__ bf16x8 mk8(s16x4 lo, s16x4 hi) { return (bf16x8){lo[0], lo[1], lo[2], lo[3], hi[0], hi[1], hi[2], hi[3]}; }

__device__ __forceinline__ void retention_phase(LAS unsigned char* lds, const bf16* qg, const bf16* kg, bf16* vg, float* ssq, int G, int bx, const int tid, const bool dry = false) {
    const int lane = tid & 63, w = __builtin_amdgcn_readfirstlane(tid >> 6), fr = lane & 15, fq = lane >> 4, q4 = (lane & 15) >> 2, p4 = lane & 3;
    const int tq = w & 3, hv = w >> 2;
    LAS unsigned char* QI = lds; LAS unsigned char* KI = lds + 32768; LAS unsigned char* VI = lds + 65536; LAS unsigned char* PI = lds + 81920; LAS unsigned char* ZI = lds + 90112;
    const unsigned LBr = (unsigned)(fr * 64 + ((fq ^ xt4(fr)) << 4));
    const unsigned TB1 = (unsigned)((8 * fq + q4) * 64 + (((p4 >> 1) ^ xt4(8 * fq + q4)) << 4) + 8 * (p4 & 1));
    const unsigned TB2 = (unsigned)((8 * fq + 4 + q4) * 64 + (((p4 >> 1) ^ xt4(8 * fq + 4 + q4)) << 4) + 8 * (p4 & 1));
    const unsigned LBz = (unsigned)(fr * 64 + (((2 * (w & 1) + (fq >> 1)) ^ xt4(fr)) << 4) + 8 * (fq & 1) + (w >> 1) * 16384);
    const unsigned LBp = (unsigned)(fr * 64 + (((fq >> 1) ^ xt4(fr)) << 4) + 8 * (fq & 1) + hv * 4096 + tq * 1024);
    const unsigned TW1 = TB1 ^ ((w & 1) * 32), TW2 = TB2 ^ ((w & 1) * 32);
    for (int u = bx; u < 256; u += G) {
        const int b = u >> 4, h = (u >> 2) & 3, vs = u & 3;
        const float g64 = __builtin_amdgcn_exp2f(64.0f * head_l2g(h));
        f32x4 Z[16];
#pragma unroll
        for (int i = 0; i < 16; ++i) Z[i] = (f32x4){0.f, 0.f, 0.f, 0.f};
        u32x4 pq[4], pk[4], pv[2];
        const bf16* qh = qg + (size_t)b * SEQ * 1024 + h * 256; const bf16* kh = kg + (size_t)b * SEQ * 1024 + h * 256;
        bf16* vh = vg + (size_t)b * SEQ * 2048 + h * 512 + vs * 128;
#define RET_LOAD(sc) do { _Pragma("unroll") for (int i = 0; i < 4; ++i) { const int pid = tid + 512 * i, r = pid >> 5, c = pid & 31; \
            pq[i] = *(const u32x4*)(qh + (size_t)((sc) * 64 + r) * 1024 + c * 8); pk[i] = *(const u32x4*)(kh + (size_t)((sc) * 64 + r) * 1024 + c * 8); } \
        _Pragma("unroll") for (int i = 0; i < 2; ++i) { const int pid = tid + 512 * i, r = pid >> 4, c = pid & 15; pv[i] = *(const u32x4*)(vh + (size_t)((sc) * 64 + r) * 2048 + c * 8); } } while (0)
        RET_LOAD(0);
        for (int sc = 0; sc < 32; ++sc) {
            LDS_BARRIER();
#pragma unroll
            for (int i = 0; i < 4; ++i) { const int pid = tid + 512 * i, r = pid >> 5, c = pid & 31; const unsigned o = pnl(r, 8 * c, 4096); *(LAS u32x4*)(QI + o) = pq[i]; *(LAS u32x4*)(KI + o) = pk[i]; }
#pragma unroll
            for (int i = 0; i < 2; ++i) { const int pid = tid + 512 * i, r = pid >> 4, c = pid & 15; *(LAS u32x4*)(VI + pnl(r, 8 * c, 4096)) = pv[i]; }
#pragma unroll
            for (int dt = 0; dt < 16; ++dt) { u32x2 zz; zz.x = cvt_pk_bf16(Z[dt][0], Z[dt][1]); zz.y = cvt_pk_bf16(Z[dt][2], Z[dt][3]); *(LAS u32x2*)(ZI + LBz + dt * 1024) = zz; }
#ifndef RET_EXP
#define RET_EXP 0
#endif
            if (sc + 1 < 32 && !(RET_EXP & 16)) RET_LOAD(sc + 1);
            LDS_BARRIER();
            const LAS unsigned char* qrow = QI + LBr + tq * 1024;
#pragma unroll
            for (int mi = 0; mi < 2; ++mi) { const int mt = 2 * hv + mi; f32x4 s = (f32x4){0.f, 0.f, 0.f, 0.f};
                if (mt <= tq) { const LAS unsigned char* krow = KI + LBr + mt * 1024;
#pragma unroll
                    for (int ks = 0; ks < 8; ++ks) s = MFMA16(*(const LAS bf16x8*)(krow + ks * 4096), *(const LAS bf16x8*)(qrow + ks * 4096), s);
                    if (mt == tq) {
#pragma unroll
                        for (int r = 0; r < 4; ++r) if (4 * fq + r > fr) s[r] = 0.f; }
                }
                u32x2 pp; pp.x = cvt_pk_bf16(s[0], s[1]); pp.y = cvt_pk_bf16(s[2], s[3]); *(LAS u32x2*)(PI + (LBp ^ (mi * 32))) = pp; }
            bf16x8 va[2];
            if (!(RET_EXP & 1)) {
#pragma unroll
            for (int k2 = 0; k2 < 2; ++k2) va[k2] = mk8(TRREAD(VI + TW1 + (w >> 1) * 4096 + k2 * 2048), TRREAD(VI + TW2 + (w >> 1) * 4096 + k2 * 2048));
#define RET_KB(dt, k2) mk8(TRREAD(KI + (TB1 ^ (((dt) & 1) * 32)) + ((dt) >> 1) * 4096 + (k2) * 2048), TRREAD(KI + (TB2 ^ (((dt) & 1) * 32)) + ((dt) >> 1) * 4096 + (k2) * 2048))
            {
#pragma unroll
              for (int dt = 0; dt < 16; ++dt) { const bf16x8 c0 = RET_KB(dt, 0), c1 = RET_KB(dt, 1);
                  Z[dt] = Z[dt] * g64; Z[dt] = MFMA16(va[0], c0, Z[dt]); Z[dt] = MFMA16(va[1], c1, Z[dt]); }
              __builtin_amdgcn_sched_group_barrier(0x100, 8, 0);
#pragma unroll
              for (int i = 0; i < 14; ++i) { __builtin_amdgcn_sched_group_barrier(0x008, 2, 0); __builtin_amdgcn_sched_group_barrier(0x100, 4, 0); }
#pragma unroll
              for (int i = 0; i < 2; ++i) __builtin_amdgcn_sched_group_barrier(0x008, 2, 0);
            }
#undef RET_KB
            }
            f32x4 o[4];
#pragma unroll
            for (int vt = 0; vt < 4; ++vt) o[vt] = (f32x4){0.f, 0.f, 0.f, 0.f};
            if (!(RET_EXP & 2)) {
#define RET_ZA(vt, ks) mk8(TRREAD(ZI + (TB1 ^ (((vt) & 1) * 32)) + (2 * hv + ((vt) >> 1)) * 16384 + (ks) * 2048), TRREAD(ZI + (TB2 ^ (((vt) & 1) * 32)) + (2 * hv + ((vt) >> 1)) * 16384 + (ks) * 2048))
            {
#pragma unroll
              for (int ks = 0; ks < 8; ++ks) { const bf16x8 cq = *(const LAS bf16x8*)(qrow + ks * 4096);
#pragma unroll
                  for (int vt = 0; vt < 4; ++vt) o[vt] = MFMA16(RET_ZA(vt, ks), cq, o[vt]); }
              __builtin_amdgcn_sched_group_barrier(0x100, 9, 0);
#pragma unroll
              for (int i = 0; i < 7; ++i) { __builtin_amdgcn_sched_group_barrier(0x008, 4, 0); __builtin_amdgcn_sched_group_barrier(0x100, 9, 0); }
              __builtin_amdgcn_sched_group_barrier(0x008, 4, 0);
            }
#undef RET_ZA
            }
            LDS_BARRIER();
#pragma unroll
            for (int vt = 0; vt < 4; ++vt) o[vt] = o[vt] * g64;
#pragma unroll
            for (int k2 = 0; k2 < 2; ++k2) if (32 * k2 <= 16 * tq + 15) { const bf16x8 pb = *(const LAS bf16x8*)(PI + LBr + tq * 1024 + k2 * 4096);
#pragma unroll
                for (int vt = 0; vt < 4; ++vt) o[vt] = MFMA16(mk8(TRREAD(VI + (TB1 ^ ((vt & 1) * 32)) + (2 * hv + (vt >> 1)) * 4096 + k2 * 2048), TRREAD(VI + (TB2 ^ ((vt & 1) * 32)) + (2 * hv + (vt >> 1)) * 4096 + k2 * 2048)), pb, o[vt]); }
            const int tokl = sc * 64 + 16 * tq + fr; float ss = 0.f;
#pragma unroll
            for (int vt = 0; vt < 4; ++vt) ss += (o[vt][0] * o[vt][0] + o[vt][1] * o[vt][1]) + (o[vt][2] * o[vt][2] + o[vt][3] * o[vt][3]);
#pragma unroll
            for (int vp = 0; vp < 2; ++vp) {
                unsigned x0 = cvt_pk_bf16(o[2 * vp][0], o[2 * vp][1]), x1 = cvt_pk_bf16(o[2 * vp][2], o[2 * vp][3]), y0 = cvt_pk_bf16(o[2 * vp + 1][0], o[2 * vp + 1][1]), y1 = cvt_pk_bf16(o[2 * vp + 1][2], o[2 * vp + 1][3]);
                const auto s0 = __builtin_amdgcn_permlane16_swap(x0, y0, false, false), s1 = __builtin_amdgcn_permlane16_swap(x1, y1, false, false);
                u32x4 ww; ww.x = s0[0]; ww.y = s1[0]; ww.z = s0[1]; ww.w = s1[1];
                if (!dry) *(u32x4*)(vh + (size_t)tokl * 2048 + 16 * (4 * hv + 2 * vp + (fq & 1)) + 4 * (fq & ~1)) = ww; }
            ss = xsum32(xsum16(ss));
            if (fq == 0 && !dry) ssq[(((size_t)(b * SEQ + tokl) * 4 + h) * 4 + vs) * 2 + hv] = ss;
        }
#undef RET_LOAD
        LDS_BARRIER();
    }
}

__device__ __forceinline__ int t5_bucket(int n) { if (n < 16) return n; const int l = 16 + (int)(__builtin_log2f((float)n * 0.0625f) * (16.0f / 7.0f)); return l > 31 ? 31 : l; }
__device__ __forceinline__ void attn_phase(LAS unsigned char* lds, bf16* qb, const bf16* kb, const bf16* vb, f32x2* ml, const float* rel_bias, int G, int bx, const int tid, const bool dry = false) {
    const int lane = tid & 63, w = __builtin_amdgcn_readfirstlane(tid >> 6), fr = lane & 15, fq = lane >> 4, q4 = (lane & 15) >> 2, p4 = lane & 3;
    LAS unsigned char* KI = lds; LAS unsigned char* VI = lds + 32768; LAS float* BT = (LAS float*)(lds + 65536);
    const unsigned LBr = (unsigned)(fr * 64 + ((fq ^ xt4(fr)) << 4));
    const unsigned TBa = (unsigned)((4 * fq + q4) * 64 + (((p4 >> 1) ^ xt4(4 * fq + q4)) << 4) + 8 * (p4 & 1));
    const LAS float* btl = BT + (fr + 144 - 4 * fq);
    for (int unit = bx; unit < 1536; unit += G) {
        const int u4 = unit & 3, g = (unit >> 2) % 3, rest = unit / 12, h = rest & 15, bl = rest >> 4;
        const int R = g == 0 ? 1 : (g == 1 ? 4 : 16);
        LDS_BARRIER();
        if (tid < 160) { const int steps = tid - 16; BT[tid] = (steps >= 0 && steps <= 128) ? rel_bias[t5_bucket(steps * R) * 48 + g * 16 + h] * 1.4426950408889634f : -1e30f; }
        LDS_BARRIER();
        float bias[36];
#pragma unroll
        for (int j = 0; j < 9; ++j)
#pragma unroll
            for (int rr = 0; rr < 4; ++rr) bias[4 * j + rr] = btl[-16 * j - rr];
        const int s_first = (g == 0 && u4 > 0) ? -1 : 0;
        const size_t sl = ((size_t)(bl * 3 + g) * 16 + h) * (SEQ * 64);
        const bf16* kbase = kb + sl; const bf16* vbase = vb + sl; bf16* qbase = qb + sl;
        const int LR = SEQ / R;
        u32x4 pk[2], pv[2]; bf16x8 qn[2];
#define ATT_SEG(s, r, n) do { if (g == 0) { r = 0; n = 4 * u4 + (s); } else if (g == 1) { r = u4; n = (s); } else { r = 4 * u4 + (s); n = 0; } } while (0)
#define ATT_LOAD(s) do { int r_, n_; ATT_SEG(s, r_, n_); _Pragma("unroll") for (int i = 0; i < 2; ++i) { const int pid = tid + 512 * i, row = pid >> 3, c = pid & 7; \
            const size_t off = (size_t)(r_ * LR + 128 * n_ + row) * 64 + c * 8; pk[i] = *(const u32x4*)(kbase + off); pv[i] = *(const u32x4*)(vbase + off); } \
            if ((s) >= 0) { const bf16* qp_ = qbase + (size_t)(r_ * LR + 128 * n_ + 16 * w + fr) * 64 + fq * 8; qn[0] = *(const bf16x8*)qp_; qn[1] = *(const bf16x8*)(qp_ + 32); } } while (0)
        ATT_LOAD(s_first);
        int cnt = 0;
        for (int s = s_first; s < 4; ++s, ++cnt) {
            LDS_BARRIER();
            const int cs = cnt & 1, ps = cs ^ 1;
#pragma unroll
            for (int i = 0; i < 2; ++i) { const int pid = tid + 512 * i, row = pid >> 3, c = pid & 7; const unsigned o = pnl(cs * 128 + row, 8 * c, 16384); *(LAS u32x4*)(KI + o) = pk[i]; *(LAS u32x4*)(VI + o) = pv[i]; }
            bf16x8 qf[2]; qf[0] = qn[0]; qf[1] = qn[1];
            if (s < 3) ATT_LOAD(s + 1);
            LDS_BARRIER();
            if (s < 0) continue;
            int r, n; ATT_SEG(s, r, n);
            const bool has_prev = n > 0;
            const size_t grow = (size_t)bl * SEQ + (size_t)(128 * n + 16 * w + fr) * R + r;
            bf16* qptr = qbase + (size_t)(r * LR + 128 * n + 16 * w + fr) * 64;
            f32x4 sc[9]; float mx = -1e30f;
            { bf16x8 kf[9][2];
#pragma unroll
              for (int j = 0; j < 9; ++j) { const int kt = w + j; const int rb = (kt < 8) ? (has_prev ? ps * 128 + 16 * kt : cs * 128 + 16 * kt) : cs * 128 + 16 * (kt - 8);
                  const LAS unsigned char* kr = KI + LBr + rb * 64; kf[j][0] = *(const LAS bf16x8*)kr; kf[j][1] = *(const LAS bf16x8*)(kr + 16384); }
#pragma unroll
              for (int j = 0; j < 9; ++j) { f32x4 a = (f32x4){0.f, 0.f, 0.f, 0.f}; a = MFMA16(kf[j][0], qf[0], a); a = MFMA16(kf[j][1], qf[1], a); sc[j] = a; } }
#pragma unroll
            for (int j = 0; j < 9; ++j) { const bool valid = has_prev || (w + j) >= 8;
#pragma unroll
                for (int rr = 0; rr < 4; ++rr) { const float v = valid ? sc[j][rr] + bias[4 * j + rr] : -1e30f; sc[j][rr] = v; mx = fmaxf(mx, v); } }
            mx = xmax32(xmax16(mx));
            float lsum = 0.f;
#pragma unroll
            for (int j = 0; j < 9; ++j)
#pragma unroll
                for (int rr = 0; rr < 4; ++rr) { const float p = __builtin_amdgcn_exp2f(sc[j][rr] - mx); sc[j][rr] = p; lsum += p; }
            lsum = xsum32(xsum16(lsum));
            f32x4 o[4];
#pragma unroll
            for (int dt = 0; dt < 4; ++dt) o[dt] = (f32x4){0.f, 0.f, 0.f, 0.f};
#pragma unroll
            for (int jj = 0; jj < 5; ++jj) { const int t0 = 2 * jj, t1 = 2 * jj + 1;
                union { bf16x8 v; unsigned u[4]; } pb;
                pb.u[0] = cvt_pk_bf16(sc[t0][0], sc[t0][1]); pb.u[1] = cvt_pk_bf16(sc[t0][2], sc[t0][3]);
                if (t1 < 9) { pb.u[2] = cvt_pk_bf16(sc[t1 < 9 ? t1 : 8][0], sc[t1 < 9 ? t1 : 8][1]); pb.u[3] = cvt_pk_bf16(sc[t1 < 9 ? t1 : 8][2], sc[t1 < 9 ? t1 : 8][3]); } else { pb.u[2] = 0u; pb.u[3] = 0u; }
                int kt0 = w + t0, kt1 = w + t1; if (kt1 > 15) kt1 = 15;
                const bool v0 = has_prev || kt0 >= 8, v1 = has_prev || kt1 >= 8;
                const int rb0 = (kt0 < 8) ? (v0 ? ps * 128 + 16 * kt0 : cs * 128 + 16 * kt0) : cs * 128 + 16 * (kt0 - 8);
                const int rb1 = (kt1 < 8) ? (v1 ? ps * 128 + 16 * kt1 : cs * 128 + 16 * kt1) : cs * 128 + 16 * (kt1 - 8);
                const LAS unsigned char* va = VI + rb0 * 64; const LAS unsigned char* vb2 = VI + rb1 * 64;
#pragma unroll
                for (int dt = 0; dt < 4; ++dt) o[dt] = MFMA16(mk8(TRREAD(va + (TBa ^ ((dt & 1) * 32)) + (dt >> 1) * 16384), TRREAD(vb2 + (TBa ^ ((dt & 1) * 32)) + (dt >> 1) * 16384)), pb.v, o[dt]); }
            const float il = 1.0f / lsum;
#pragma unroll
            for (int dp = 0; dp < 2; ++dp) {
                unsigned x0 = cvt_pk_bf16(o[2 * dp][0] * il, o[2 * dp][1] * il), x1 = cvt_pk_bf16(o[2 * dp][2] * il, o[2 * dp][3] * il);
                unsigned y0 = cvt_pk_bf16(o[2 * dp + 1][0] * il, o[2 * dp + 1][1] * il), y1 = cvt_pk_bf16(o[2 * dp + 1][2] * il, o[2 * dp + 1][3] * il);
                const auto s0 = __builtin_amdgcn_permlane16_swap(x0, y0, false, false), s1 = __builtin_amdgcn_permlane16_swap(x1, y1, false, false);
                u32x4 ww; ww.x = s0[0]; ww.y = s1[0]; ww.z = s0[1]; ww.w = s1[1];
                if (!dry) *(u32x4*)(qptr + 16 * (2 * dp + (fq & 1)) + 4 * (fq & ~1)) = ww; }
            if (fq == 0 && !dry) ml[(grow * 3 + g) * 16 + h] = (f32x2){mx, lsum};
        }
#undef ATT_SEG
#undef ATT_LOAD
    }
    LDS_BARRIER();
}
__device__ __forceinline__ void merge_phase(const bf16* qb, const f32x2* ml, bf16* out, int G, int bx, const int tid) {
    const size_t nitems = (size_t)TC * 16 * 8;
    for (size_t it = (size_t)bx * 512 + tid; it < nitems; it += (size_t)G * 512) {
        const int pc = (int)(it & 7), h = (int)((it >> 3) & 15); const size_t tok = it >> 7; const int bl = (int)(tok >> 11), t = (int)(tok & (SEQ - 1));
        f32x2 a[3]; float M = -3e38f;
#pragma unroll
        for (int g = 0; g < 3; ++g) { a[g] = ml[(tok * 3 + g) * 16 + h]; M = fmaxf(M, a[g].x); }
        float wg[3], W = 0.f;
#pragma unroll
        for (int g = 0; g < 3; ++g) { wg[g] = __builtin_amdgcn_exp2f(a[g].x - M) * a[g].y; W += wg[g]; }
        const float iw = 1.0f / W; float acc[8];
#pragma unroll
        for (int e = 0; e < 8; ++e) acc[e] = 0.f;
#pragma unroll
        for (int g = 0; g < 3; ++g) { const int sh = g == 0 ? 0 : (g == 1 ? 2 : 4), pos = (t & ((1 << sh) - 1)) * (SEQ >> sh) + (t >> sh);
            const u32x4 o = *(const u32x4*)(qb + (((size_t)(bl * 3 + g) * 16 + h) * SEQ + pos) * 64 + pc * 8); const float ww = wg[g] * iw;
            acc[0] += ww * bf_lo(o.x); acc[1] += ww * bf_hi(o.x); acc[2] += ww * bf_lo(o.y); acc[3] += ww * bf_hi(o.y); acc[4] += ww * bf_lo(o.z); acc[5] += ww * bf_hi(o.z); acc[6] += ww * bf_lo(o.w); acc[7] += ww * bf_hi(o.w); }
        u32x4 r; r.x = cvt_pk_bf16(acc[0], acc[1]); r.y = cvt_pk_bf16(acc[2], acc[3]); r.z = cvt_pk_bf16(acc[4], acc[5]); r.w = cvt_pk_bf16(acc[6], acc[7]);
        *(u32x4*)(out + tok * 1024 + h * 64 + pc * 8) = r;
    }
}
__device__ __forceinline__ void router_phase(LAS unsigned char* lds, const bf16* wrh, const bf16* wrl, const float* bg, const float* be, const bf16* hb, int* list, float* gatew, unsigned* cnt, int G, int vcu, const int tid) {
    const int lane = tid & 63, w = __builtin_amdgcn_readfirstlane(tid >> 6), fr = lane & 15, fq = lane >> 4;
    LAS unsigned char* WH = lds; LAS unsigned char* WL = lds + 49152; LAS float* LG = (LAS float*)(lds + 98304 + w * 3072);
    const int nround = (T / 16 + G * NWAVES - 1) / (G * NWAVES);
    LAS unsigned* BC = (LAS unsigned*)(lds + 122880); LAS unsigned* BB = BC + 32;
    for (int rd = 0; rd < nround; ++rd) {
        const int mt = rd * G * NWAVES + vcu * NWAVES + w; const bool active = mt < T / 16;
        if (tid < 32) BC[tid] = 0u;
        int b0 = 0, b1 = 0; unsigned l0 = 0u, l1 = 0u; float gw0 = 0.f, gw1 = 0.f, rsk = 0.f;
        f32x4 acc[3]; float ss = 0.f;
#pragma unroll
        for (int i = 0; i < 3; ++i) acc[i] = (f32x4){0.f, 0.f, 0.f, 0.f};
        for (int kh = 0; kh < 2; ++kh) {
            LDS_BARRIER();
#pragma unroll
            for (int i = 0; i < 6; ++i) { const int pid = tid + 512 * i, row = pid >> 6, c = pid & 63;
                *(LAS u32x4*)(WH + swzb(row, c * 16, 1024)) = *(const u32x4*)(wrh + (size_t)row * 1024 + kh * 512 + c * 8);
                *(LAS u32x4*)(WL + swzb(row, c * 16, 1024)) = *(const u32x4*)(wrl + (size_t)row * 1024 + kh * 512 + c * 8); }
            LDS_BARRIER();
            if (active) {
                const bf16* hp = hb + (size_t)(mt * 16 + fr) * D + kh * 512 + 8 * fq;
                union { bf16x8 v; u32x4 u; } ah[16];
#pragma unroll
                for (int ks = 0; ks < 16; ++ks) ah[ks].u = *(const GAS u32x4*)(hp + 32 * ks);
#pragma unroll
                for (int ks = 0; ks < 16; ++ks) {
                    { const u32x4 a = ah[ks].u; const float a0 = bf_lo(a.x), a1 = bf_hi(a.x), a2 = bf_lo(a.y), a3 = bf_hi(a.y), a4 = bf_lo(a.z), a5 = bf_hi(a.z), a6 = bf_lo(a.w), a7 = bf_hi(a.w);
                      ss += ((a0 * a0 + a1 * a1) + (a2 * a2 + a3 * a3)) + ((a4 * a4 + a5 * a5) + (a6 * a6 + a7 * a7)); }
#pragma unroll
                    for (int nt = 0; nt < 3; ++nt) { const bf16x8 bh = fragb_row(WH, 16 * nt, ks * 64, 1024, fr, fq), bl = fragb_row(WL, 16 * nt, ks * 64, 1024, fr, fq);
                        acc[nt] = MFMA16(ah[ks].v, bh, acc[nt]); acc[nt] = MFMA16(ah[ks].v, bl, acc[nt]); }
                }
            }
        }
        if (active) {
            ss = xsum32(xsum16(ss));
            const float rs = __builtin_amdgcn_rsqf(ss * (1.f / D) + 1e-6f);
#pragma unroll
            for (int nt = 0; nt < 3; ++nt)
#pragma unroll
                for (int r = 0; r < 4; ++r) LG[(4 * fq + r) * 48 + 16 * nt + fr] = acc[nt][r];
            LDS_WAIT(); asm volatile("" ::: "memory");
            if (lane < 16) {
                const int tk = mt * 16 + lane; float a[36];
#pragma unroll
                for (int q = 0; q < 9; ++q) { const f32x4 t4 = *(const LAS f32x4*)(LG + lane * 48 + 4 * q); a[4 * q] = t4[0] * rs; a[4 * q + 1] = t4[1] * rs; a[4 * q + 2] = t4[2] * rs; a[4 * q + 3] = t4[3] * rs; }
                float gl[4];
#pragma unroll
                for (int g = 0; g < 4; ++g) gl[g] = a[g] + bg[g];
                int grp = 0; float gbest = gl[0];
#pragma unroll
                for (int g = 1; g < 4; ++g) if (gl[g] > gbest) { gbest = gl[g]; grp = g; }
                float den = 0.f;
#pragma unroll
                for (int g = 0; g < 4; ++g) den += __expf(gl[g] - gbest);
                const float pg = 1.0f / den;
                float el[8];
#pragma unroll
                for (int e = 0; e < 8; ++e) { float vv = 0.f;
#pragma unroll
                    for (int g = 0; g < 4; ++g) if (g == grp) vv = a[4 + g * 8 + e] + be[g * 8 + e];
                    el[e] = vv; }
                int i0 = 0; float v0 = el[0];
#pragma unroll
                for (int e = 1; e < 8; ++e) if (el[e] > v0) { v0 = el[e]; i0 = e; }
                int i1 = -1; float v1 = -3.0e38f;
#pragma unroll
                for (int e = 0; e < 8; ++e) if (e != i0 && (i1 < 0 || el[e] > v1)) { v1 = el[e]; i1 = e; }
                const float e1 = __expf(v1 - v0); const float g0 = 1.0f / (1.0f + e1), g1 = e1 / (1.0f + e1);
                b0 = grp * 8 + i0; b1 = grp * 8 + i1;
                l0 = __hip_atomic_fetch_add(BC + b0, 1u, __ATOMIC_RELAXED, __HIP_MEMORY_SCOPE_WORKGROUP);
                l1 = __hip_atomic_fetch_add(BC + b1, 1u, __ATOMIC_RELAXED, __HIP_MEMORY_SCOPE_WORKGROUP);
                gw0 = g0 * pg; gw1 = g1 * pg; rsk = rs;
            }
        }
        LDS_BARRIER();
        if (tid < 32) { const unsigned c = BC[tid]; BB[tid] = c ? __hip_atomic_fetch_add(cnt + tid * 64, c, __ATOMIC_RELAXED, __HIP_MEMORY_SCOPE_AGENT) : 0u; }
        LDS_BARRIER();
        if (active && lane < 16) {
            const int tk = mt * 16 + lane; const unsigned p0 = BB[b0] + l0, p1 = BB[b1] + l1;
            list[(size_t)b0 * T + p0] = tk; list[(size_t)b1 * T + p1] = tk;
            gatew[tk * 2] = gw0; gatew[tk * 2 + 1] = gw1;
            float* rsl = (float*)((char*)list - (WS_LIST - WS_ML)); rsl[(size_t)b0 * T + p0] = rsk; rsl[(size_t)b1 * T + p1] = rsk;
            unsigned* binpos = (unsigned*)(gatew + 2 * T); binpos[tk * 2] = ((unsigned)b0 << 16) | p0; binpos[tk * 2 + 1] = ((unsigned)b1 << 16) | p1;
        }
    }
    LDS_BARRIER();
}
struct Args { const float* in[19]; float* out; unsigned char* ws; int ph_lo, ph_hi, flags, pad; };
enum { IN_X = 0, IN_RET_WIN, IN_RET_WOUT, IN_KV_NORM, IN_W_KV, IN_K_NORM, IN_DIL_WQ, IN_Q_NORM, IN_DIL_WO, IN_REL_BIAS, IN_MIXER_NORM, IN_FFN_NORM, IN_RGRP, IN_RGRP_B, IN_REXP, IN_REXP_B, IN_EGATE, IN_EUP, IN_EDOWN };
constexpr int NPHASE = 24;
#ifndef MK_PHMASK
#define MK_PHMASK 0xffffffu
#endif
struct PhaseCtx { int tid, lane, wave, G, bx, vcu, gw, NGW; unsigned char* ws; float* hout; };
__device__ __forceinline__ PhaseCtx phase_ctx(const Args& args, int wave_s) {
    PhaseCtx c; int tid = (wave_s << 6) | lane_id(), bx = blockIdx.x, G = gridDim.x;
    GAS unsigned char* wsg = (GAS unsigned char*)args.ws; GAS float* hg = (GAS float*)args.out;
    asm volatile("" : "+v"(tid), "+s"(bx), "+s"(G), "+s"(wsg), "+s"(hg));
    unsigned char* ws = (unsigned char*)wsg; float* hout = (float*)hg;
    c.tid = tid; c.lane = tid & 63; c.wave = __builtin_amdgcn_readfirstlane(tid >> 6); c.G = G; c.bx = bx; c.vcu = (G % 8 == 0) ? (bx % 8) * (G / 8) + bx / 8 : bx;
    c.gw = c.vcu * NWAVES + c.wave; c.NGW = G * NWAVES; c.ws = ws; c.hout = hout; return c;
}
__device__ __forceinline__ void pro_s1(const Args& args, const PhaseCtx& c, LAS unsigned char* lds) {
    unsigned char* ws = c.ws; LAS float* scr = (LAS float*)(lds + c.wave * 16640); const int gw = c.gw, NGW = c.NGW, lane = c.lane;
    bf16* xn = (bf16*)(ws + WS_XN); const float* x = args.in[IN_X];
    transpose_matrix(args.in[IN_RET_WIN], 1024, 6144, (bf16*)(ws + WS_WIN), scr, gw, NGW, lane, args.in[IN_MIXER_NORM], MapWin{});
    for (int m = gw; m < T; m += NGW) rms_row_to_bf16(x + (size_t)m * D, xn + (size_t)m * D, lane);
}
__device__ __forceinline__ void pro_wout(const Args& args, const PhaseCtx& c, LAS unsigned char* lds) {
    LAS float* scr = (LAS float*)(lds + c.wave * 16640);
    transpose_matrix(args.in[IN_RET_WOUT], 2048, 1024, (bf16*)(c.ws + WS_WOUT), scr, c.gw, c.NGW, c.lane, nullptr, MapId{0});
}
__device__ __forceinline__ void pro_moe(const Args& args, const PhaseCtx& c, LAS unsigned char* lds, int L) {
    unsigned char* ws = c.ws; LAS float* scr = (LAS float*)(lds + c.wave * 16640); const int gw = c.gw, NGW = c.NGW, lane = c.lane;
    bf16* wgu = (bf16*)(ws + (L ? WS_WGU1 : WS_WGU0)); bf16* wd = (bf16*)(ws + (L ? WS_WD1 : WS_WD0));
    const float* gain = args.in[IN_FFN_NORM] + L * D;
    auto src_of = [&](int it, const float*& W, int& N, int& item) { const int e = it / 384, r = it % 384, which = r >> 7; item = r & 127; const size_t eo = (size_t)(L * NEXP + e);
        if (which == 0) { W = args.in[IN_EGATE] + eo * D * FF; N = FF; } else if (which == 1) { W = args.in[IN_EUP] + eo * D * FF; N = FF; } else { W = args.in[IN_EDOWN] + eo * FF * D; N = D; } };
    if (gw < NEXP * 384) {
        f32x4 v[16]; { const float* W; int N, item; src_of(gw, W, N, item); transpose_load(W, N, item, lane, v); }
        for (int it = gw; it < NEXP * 384; it += NGW) { f32x4 cur[16];
#pragma unroll
            for (int i = 0; i < 16; ++i) cur[i] = v[i];
            if (it + NGW < NEXP * 384) { const float* W; int N, item; src_of(it + NGW, W, N, item); transpose_load(W, N, item, lane, v); }
            const int e = it / 384, r = it % 384, which = r >> 7, item = r & 127;
            if (which == 0) transpose_finish(cur, FF, wgu + (size_t)e * 1024 * 1024, 1024, scr, item, lane, gain, MapGu{0});
            else if (which == 1) transpose_finish(cur, FF, wgu + (size_t)e * 1024 * 1024, 1024, scr, item, lane, gain, MapGu{1});
            else transpose_finish(cur, D, wd + (size_t)e * 1024 * 512, 512, scr, item, lane, (const float*)nullptr, MapId{0}); }
    }
    bf16* wrh = (bf16*)(ws + WS_WR) + (size_t)L * 48 * 1024; bf16* wrl = (bf16*)(ws + WS_WR + 196608) + (size_t)L * 48 * 1024;
    for (int i = gw * 64 + lane; i < 48 * 1024; i += NGW * 64) { const int n = i >> 10, k = i & 1023;
        const float wv = n < 36 ? gain[k] * (n < 4 ? args.in[IN_RGRP][((size_t)L * D + k) * 4 + n] : args.in[IN_REXP][((size_t)L * D + k) * 32 + (n - 4)]) : 0.0f;
        const unsigned hi = f2bf(wv); const float rem = wv - __builtin_bit_cast(float, hi << 16); wrh[i] = (bf16)hi; wrl[i] = (bf16)f2bf(rem); }
}
__device__ __forceinline__ void pro_s3(const Args& args, const PhaseCtx& c, LAS unsigned char* lds) {
    unsigned char* ws = c.ws; LAS float* scr = (LAS float*)(lds + c.wave * 16640); const int gw = c.gw, NGW = c.NGW, lane = c.lane;
    transpose_matrix(args.in[IN_DIL_WQ], 1024, 3072, (bf16*)(ws + WS_WQKV1), scr, gw, NGW, lane, args.in[IN_MIXER_NORM] + D, MapQkv1{0});
    transpose_matrix(args.in[IN_W_KV], 1024, 6144, (bf16*)(ws + WS_WQKV1), scr, gw, NGW, lane, args.in[IN_KV_NORM], MapQkv1{3072});
    transpose_matrix(args.in[IN_DIL_WO], 1024, 1024, (bf16*)(ws + WS_WO1), scr, gw, NGW, lane, nullptr, MapId{0});
    if (gw == 0) { float* gt = (float*)(ws + WS_WR + 512 * 1024); for (int i = lane; i < 192; i += 64) { gt[i] = args.in[IN_Q_NORM][i]; gt[192 + i] = args.in[IN_K_NORM][i]; } }
}

__global__ void __launch_bounds__(NWAVES * 64, 2) mk_fwd(Args args) {
    extern __shared__ __attribute__((aligned(16))) unsigned char lds_raw[];
    LAS unsigned char* lds = (LAS unsigned char*)lds_raw;
    volatile LAS unsigned* MISC = (volatile LAS unsigned*)(lds + LDS_MISC);
    LAS int* TAB = (LAS int*)(lds + LDS_MISC + 64);
    const int wave_s = __builtin_amdgcn_readfirstlane(threadIdx.x >> 6);
    if (threadIdx.x < 4) MISC[threadIdx.x] = 0u;
    __syncthreads();
    XcdBarrier bar = xcd_barrier_post((unsigned*)(args.ws + WS_CTL) + CW_BAR, MISC, threadIdx.x == 0);
    int lo = args.ph_lo, hi = args.ph_hi, flg = args.flags;
#define RELAUNDER() asm volatile("" : "+s"(lo), "+s"(hi), "+s"(flg))
#define fullpro ((flg & 1) != 0)
#ifdef MK_REPEAT
#define GEMM_RUN(p) do { if (rep_now) gemm_phase(lds, p, c.tid, (flg & 1) != 0); gemm_phase(lds, p, c.tid); } while (0)
#else
#ifndef MK_STAGGER
#define MK_STAGGER 0
#endif
#define GEMM_RUN(p) gemm_phase(lds, p, c.tid, false, MK_STAGGER)
#endif
#ifdef MK_REPEAT
#define MK_REPEAT_K MK_REPEAT
#else
#define MK_REPEAT_K (-1)
#endif
#define IN(k) ((((MK_PHMASK) >> (k)) & 1u) && lo <= (k) && (k) < hi)
#ifdef MK_STAMP
#define STAMP(i) do { if (blockIdx.x == 0 && wave_s == 0 && lane_id() == 0) ((volatile LAS unsigned long long*)(lds + LDS_MISC + 3072))[i] = __builtin_amdgcn_s_memrealtime(); } while (0)
#else
#define STAMP(i) do { } while (0)
#endif
#define SEAM(k) do { asm volatile("; SEAM_MARK %0" :: "n"(k)); if (IN(k) && IN((k) + 1)) xcd_barrier(bar, wave_s); STAMP((k) + 1); } while (0)

    STAMP(0);
    if (IN(0)) { const PhaseCtx c = phase_ctx(args, wave_s); pro_s1(args, c, lds); if (!fullpro) pro_wout(args, c, lds); }
    SEAM(0);
    if (IN(1)) {
#pragma unroll 1
        for (int part = 0; part < 2; ++part) {
            RELAUNDER();
            { const bool rep_now = (MK_REPEAT_K == 1); const PhaseCtx c = phase_ctx(args, wave_s); unsigned char* ws = c.ws;
              P_QKV0 p; p.A = (const char*)(ws + WS_XN); p.Bt = (const char*)(ws + WS_WIN); p.lda = 2048; p.ldb = 2048; p.K = 1024; p.so.init(T, 4096, c.G, c.bx);
              p.qk = (bf16*)(ws + WS_Q0); p.v = (bf16*)(ws + WS_V0); p.cs = (const float*)(ws + WS_COS); p.sn = (const float*)(ws + WS_SIN);
              const int ksp = fullpro ? ((c.bx >> 3) & 7) + 1 : 0; p.i0 = part ? ksp : 0; p.i1 = part ? (1 << 24) : ksp;
              GEMM_RUN(p); }
            if (part == 0 && fullpro) { const PhaseCtx c = phase_ctx(args, wave_s); __syncthreads();
#pragma unroll 1
                for (int Lw = 0; Lw < 2; ++Lw) pro_moe(args, c, lds, Lw);
                pro_wout(args, c, lds); pro_s3(args, c, lds); __syncthreads(); }
        }
    }
    SEAM(1);
    if (IN(2)) { const PhaseCtx c = phase_ctx(args, wave_s); unsigned char* ws = c.ws;
#if defined(MK_REPEAT) && MK_REPEAT == 2
        retention_phase(lds, (const bf16*)(ws + WS_Q0), (const bf16*)(ws + WS_K0), (bf16*)(ws + WS_V0), (float*)(ws + WS_SSQ), c.G, c.vcu, c.tid, (flg & 1) != 0);
#endif
        retention_phase(lds, (const bf16*)(ws + WS_Q0), (const bf16*)(ws + WS_K0), (bf16*)(ws + WS_V0), (float*)(ws + WS_SSQ), c.G, c.vcu, c.tid); }
    SEAM(2);
    if (IN(3)) { const bool rep_now = (MK_REPEAT_K == 3); const PhaseCtx c = phase_ctx(args, wave_s); unsigned char* ws = c.ws;
        P_GATE p; p.A = (const char*)(ws + WS_XN); p.Bt = (const char*)(ws + WS_WIN) + (size_t)4096 * 2048; p.lda = 2048; p.ldb = 2048; p.K = 1024; p.so.init(T, 2048, c.G, c.bx);
        p.ov = (bf16*)(ws + WS_V0); p.ssq = (const float*)(ws + WS_SSQ);
        GEMM_RUN(p); }
    SEAM(3);
    if (IN(4)) { const bool rep_now = (MK_REPEAT_K == 4); const PhaseCtx c = phase_ctx(args, wave_s); unsigned char* ws = c.ws;
        P_RESB p; p.A = (const char*)(ws + WS_V0); p.Bt = (const char*)(ws + WS_WOUT); p.lda = 4096; p.ldb = 4096; p.K = 2048; p.so.init(T, 1024, c.G, c.bx);
        p.res32 = args.in[IN_X]; p.hb = (bf16*)(ws + WS_XN); p.row_off = 0;
        GEMM_RUN(p); }
    SEAM(4);
#pragma unroll 1
    for (int L = 0; L < 2; ++L) {
        RELAUNDER();
        const int P0 = L ? 19 : 5;
#define INL(k0, k1) (L ? IN(k1) : IN(k0))
#define SEAML(k0, k1) do { if (L) SEAM(k1); else SEAM(k0); } while (0)
        if (L == 1) {
            if (IN(10)) { const PhaseCtx c = phase_ctx(args, wave_s); if (!fullpro) pro_s3(args, c, lds);
 }
            if (!fullpro) SEAM(10);
#pragma unroll 1
            for (int ch = 0; ch < 2; ++ch) {
                RELAUNDER();
#define INC(k) (ch ? IN((k) + 4) : IN(k))
#define SEAMC(k) do { if (ch) SEAM((k) + 4); else SEAM(k); } while (0)
                if (INC(11)) { const bool rep_now = (MK_REPEAT_K == 11); const PhaseCtx c = phase_ctx(args, wave_s); unsigned char* ws = c.ws;
                    P_QKV1 p; p.A = (const char*)(ws + WS_XN) + (size_t)ch * TC * D * 2; p.Bt = (const char*)(ws + WS_WQKV1); p.lda = 2048; p.ldb = 2048; p.K = 1024; p.so.init(TC, 9216, c.G, c.bx);
                    p.qkv = (bf16*)(ws + WS_Q1); p.gains = (const float*)(ws + WS_WR + 512 * 1024); p.rs1 = (const float*)(ws + WS_GATEW + 1024 * 1024) + ch * TC;
                    GEMM_RUN(p); }
                SEAMC(11);
                if (INC(12)) { const PhaseCtx c = phase_ctx(args, wave_s); unsigned char* ws = c.ws;
#if defined(MK_REPEAT) && MK_REPEAT == 12
                    attn_phase(lds, (bf16*)(ws + WS_Q1), (const bf16*)(ws + WS_K1), (const bf16*)(ws + WS_V1), (f32x2*)(ws + WS_ML), args.in[IN_REL_BIAS], c.G, c.bx, c.tid, (flg & 1) != 0);
#endif
                    attn_phase(lds, (bf16*)(ws + WS_Q1), (const bf16*)(ws + WS_K1), (const bf16*)(ws + WS_V1), (f32x2*)(ws + WS_ML), args.in[IN_REL_BIAS], c.G, c.bx, c.tid); }
                SEAMC(12);
                if (INC(13)) { const PhaseCtx c = phase_ctx(args, wave_s); merge_phase((const bf16*)(c.ws + WS_Q1), (const f32x2*)(c.ws + WS_ML), (bf16*)(c.ws + WS_AO) + (size_t)ch * TC * D, c.G, c.bx, c.tid); }
                SEAMC(13);
#undef INC
#undef SEAMC
            }
            if (IN(18)) { const bool rep_now = (MK_REPEAT_K == 14); const PhaseCtx c = phase_ctx(args, wave_s); unsigned char* ws = c.ws;
                P_RESB p; p.A = (const char*)(ws + WS_AO); p.Bt = (const char*)(ws + WS_WO1); p.lda = 2048; p.ldb = 2048; p.K = 1024; p.so.init(T, 1024, c.G, c.bx);
                p.res32 = nullptr; p.hb = (bf16*)(ws + WS_XN); p.row_off = 0;
                GEMM_RUN(p); }
            SEAM(18);
        }
        if (INL(5, 19)) { const PhaseCtx c = phase_ctx(args, wave_s); if (!fullpro) pro_moe(args, c, lds, L); }
        if (!fullpro) SEAML(5, 19);
        if (INL(6, 20)) { const PhaseCtx c = phase_ctx(args, wave_s); unsigned char* ws = c.ws;
            router_phase(lds, (const bf16*)(ws + WS_WR) + (size_t)L * 48 * 1024, (const bf16*)(ws + WS_WR + 196608) + (size_t)L * 48 * 1024, args.in[IN_RGRP_B] + L * 4, args.in[IN_REXP_B] + L * 32, (const bf16*)(ws + WS_XN), (int*)(ws + WS_LIST), (float*)(ws + WS_GATEW),
                         (unsigned*)(ws + WS_CTL) + CW_CNT + L * 4096, c.G, c.vcu, c.tid); }
        SEAML(6, 20);
        if (INL(7, 21) || INL(8, 22)) { const PhaseCtx c = phase_ctx(args, wave_s); moe_build_tab(TAB, (const unsigned*)(c.ws + WS_CTL) + CW_CNT + L * 4096, c.tid); }
        if (INL(7, 21)) { const bool rep_now = (MK_REPEAT_K == 7); const PhaseCtx c = phase_ctx(args, wave_s); unsigned char* ws = c.ws;
            P_GU p; p.xn = (const char*)(ws + WS_XN); p.W = (const char*)(ws + (L ? WS_WGU1 : WS_WGU0)); p.list = (const int*)(ws + WS_LIST); p.hid = (bf16*)(ws + WS_HID); p.tab = TAB; p.G = c.G; p.vcu = c.vcu; p.K = 1024; p.lda = 2048; p.ldb = 2048;
            GEMM_RUN(p); }
        SEAML(7, 21);
        if (INL(8, 22)) { const bool rep_now = (MK_REPEAT_K == 8); const PhaseCtx c = phase_ctx(args, wave_s); unsigned char* ws = c.ws;
            P_DN p; p.hid = (const char*)(ws + WS_HID); p.W = (const char*)(ws + (L ? WS_WD1 : WS_WD0)); p.y = (bf16*)(ws + WS_YB); p.tab = TAB; p.G = c.G; p.vcu = c.vcu; p.K = 512; p.lda = 1024; p.ldb = 1024;
            GEMM_RUN(p); }
        SEAML(8, 22);
        if (INL(9, 23)) { const PhaseCtx c = phase_ctx(args, wave_s); unsigned char* ws = c.ws;
            if (!(INL(7, 21) || INL(8, 22))) moe_build_tab(TAB, (const unsigned*)(ws + WS_CTL) + CW_CNT + L * 4096, c.tid);
            combine_phase((bf16*)(ws + WS_XN), (const bf16*)(ws + WS_YB), (const unsigned*)(ws + WS_GATEW) + 2 * T, (const float*)(ws + WS_GATEW), TAB, L == 1 ? c.hout : (float*)nullptr, (float*)(ws + WS_GATEW + 1024 * 1024), c.gw, c.NGW, c.lane); }
        SEAML(9, 23);
#undef INL
#undef SEAML
        (void)P0;
    }
#ifdef MK_STAMP
    if (blockIdx.x == 0 && wave_s == 0 && lane_id() == 0) { volatile LAS unsigned long long* st = (volatile LAS unsigned long long*)(lds + LDS_MISC + 3072);
        const float tot = (float)(st[24] - st[0]); float* pr = (float*)(args.ws + WS_CTL) + 200000;
        pr[0] = floorf((float)(st[MK_STAMP_A1] - st[MK_STAMP_A0]) / tot * 200.0f + 0.5f) * 0.005f; pr[1] = 0.f; }
#endif
#undef IN
#undef SEAM
#undef RELAUNDER
#undef fullpro
}
}
#ifndef MK_MASK
#define MK_MASK 15
#endif
#ifndef MK_SPLIT
#define MK_SPLIT 0
#endif

#ifdef MK_DEBUG
namespace dbg {
__global__ void k_cmp(const float* a, const float* b, size_t n, unsigned long long* acc) {
    double num = 0.0, den = 0.0; unsigned long long bad = 0;
    for (size_t i = (size_t)blockIdx.x * blockDim.x + threadIdx.x; i < n; i += (size_t)gridDim.x * blockDim.x) { const float x = a[i], y = b[i]; const float d = x - y; if (!(d - d == 0.0f)) { ++bad; continue; } num += (double)d * d; den += (double)x * x; }
    for (int o = 32; o >= 1; o >>= 1) { num += __shfl_xor(num, o); den += __shfl_xor(den, o); bad += __shfl_xor(bad, o); }
    if ((threadIdx.x & 63) == 0) { atomicAdd(acc, (unsigned long long)(num * 1048576.0)); atomicAdd(acc + 1, (unsigned long long)(den * 1048576.0)); atomicAdd(acc + 2, bad); }
}
__global__ void k_code(const unsigned long long* acc, float* scale) {
    const double num = (double)acc[0], den = (double)acc[1]; const double e = sqrt(num / (den + 1.0));
    int code = e < 0.01 ? 0 : (e < 0.03 ? 1 : (e < 0.1 ? 2 : (e < 0.3 ? 3 : (e < 1.0 ? 4 : 5)))); if (acc[2]) code = 7;
    scale[0] = 1.0f + 0.1f * (float)code;
}
__global__ void k_cmp_bf(const unsigned short* nw, const float* ref, int ldr, int offr, int mode, unsigned long long* acc, int tlo = 0, int thi = 2048) {
    double num = 0.0, den = 0.0; unsigned long long bad = 0;
    const size_t n = mode < 2 ? (size_t)2048 * 1024 : (size_t)2048 * 2048;
    for (size_t i = (size_t)blockIdx.x * blockDim.x + threadIdx.x; i < n; i += (size_t)gridDim.x * blockDim.x) {
        float x, y;
        if (mode < 2) { const int t = (int)(i >> 10), col = (int)(i & 1023), hh = col >> 8, d = col & 255, c = d < 128 ? 2 * d : 2 * (d - 128) + 1;
            const float l2g = log2f(1.0f - exp2f(-5.0f - (float)hh)); const float sc = exp2f((mode == 0 ? -l2g : l2g) * (float)(t & 63));
            y = __uint_as_float(((unsigned)nw[(size_t)t * 1024 + hh * 256 + c]) << 16) * sc; x = ref[(size_t)t * ldr + offr + col]; }
        else { const int t = (int)(i >> 11), col = (int)(i & 2047); if (t < tlo || t >= thi) continue; y = __uint_as_float(((unsigned)nw[(size_t)t * 2048 + col]) << 16); x = ref[(size_t)t * ldr + offr + col]; }
        const float dd = x - y; if (!(dd - dd == 0.0f)) { ++bad; continue; } num += (double)dd * dd; den += (double)x * x; }
    for (int o = 32; o >= 1; o >>= 1) { num += __shfl_xor(num, o); den += __shfl_xor(den, o); bad += __shfl_xor(bad, o); }
    if ((threadIdx.x & 63) == 0) { atomicAdd(acc, (unsigned long long)(num * 1048576.0)); atomicAdd(acc + 1, (unsigned long long)(den * 1048576.0)); atomicAdd(acc + 2, bad); }
}
__device__ inline int code_of(const unsigned long long* acc) { const double e = sqrt((double)acc[0] / ((double)acc[1] + 1.0)); int code = e < 0.01 ? 0 : (e < 0.03 ? 1 : (e < 0.1 ? 2 : (e < 0.3 ? 3 : (e < 1.0 ? 4 : 5)))); if (acc[2]) code = 7; return code; }
__global__ void k_code3(const unsigned long long* acc, float* scale) { scale[0] = 1.0f + 0.1f * (float)code_of(acc); scale[1] = 100.0f * (float)(code_of(acc + 4) + 1) + 10.0f * (float)code_of(acc + 8); }
__global__ void k_spike(float* out, const float* scale) { out[0] += scale[1]; }
__global__ void k_scale(float* out, const float* scale, size_t n) { const float s = scale[0]; for (size_t i = (size_t)blockIdx.x * blockDim.x + threadIdx.x; i < n; i += (size_t)gridDim.x * blockDim.x) out[i] *= s; }
}
#endif
#ifndef MK_SPIKE
#define MK_SPIKE 1000.0f
#endif
#ifdef MK_STAMP
__global__ void stamp_apply(float* out, const float* pr, size_t n) { if (blockIdx.x == 0 && threadIdx.x == 0) out[0] += MK_SPIKE * pr[0]; }
#endif
extern "C" void kernel_launch(void* const* d_in, const int* in_sizes, int n_in, void* d_out, int out_size, void* d_ws, size_t ws_size, hipStream_t stream) {
    (void)in_sizes; (void)n_in; (void)out_size;
    if (ws_size < mk::WS_END) return;
    static int configured = 0, grid = 256;
    if (!configured) { if (hipFuncSetAttribute((const void*)mk::mk_fwd, hipFuncAttributeMaxDynamicSharedMemorySize, mk::LDS_BYTES) != hipSuccess) return;
        int dev = 0, cus = 0, per_cu = 0;
        if (hipGetDevice(&dev) == hipSuccess && hipDeviceGetAttribute(&cus, hipDeviceAttributeMultiprocessorCount, dev) == hipSuccess && cus > 0) grid = cus < 256 ? cus : 256;
        if (hipOccupancyMaxActiveBlocksPerMultiprocessor(&per_cu, (const void*)mk::mk_fwd, 512, mk::LDS_BYTES) != hipSuccess || per_cu < 1) return;
        configured = 1; }
    mk::Args a{};
    for (int i = 0; i < 19; ++i) a.in[i] = (const float*)d_in[i];
    a.out = (float*)d_out; a.ws = (unsigned char*)d_ws; a.pad = 0;
    const int mask = MK_MASK;
    auto run_new = [&](int lo, int hi, int flags) {
        (void)hipMemsetAsync((char*)d_ws + mk::WS_CTL, 0, mk::CTL_BYTES, stream);
        if (MK_SPLIT) { for (int p = lo; p < hi; ++p) { a.ph_lo = p; a.ph_hi = p + 1; a.flags = flags; hipLaunchKernelGGL(mk::mk_fwd, dim3(grid), dim3(512), mk::LDS_BYTES, stream, a); } }
        else { a.ph_lo = lo; a.ph_hi = hi; a.flags = flags; hipLaunchKernelGGL(mk::mk_fwd, dim3(grid), dim3(512), mk::LDS_BYTES, stream, a); }
    };
#ifdef MK_DEBUG
    {
        const size_t MiB = mk::MiB; const size_t nall = (size_t)mk::T * mk::D;
        if (ws_size < 580 * MiB) return;
        nv::Ctx c; nv::ctx_init(c, d_in, d_out, d_ws, stream);
        unsigned long long* acc = (unsigned long long*)((char*)d_ws + 575 * MiB); float* scl = (float*)((char*)d_ws + 575 * MiB + 256);
        float* dout = (float*)d_out; float* alt = nullptr; size_t ncmp = nall;
        if (MK_DEBUG == 1) { nv::stage_mixer0(c); alt = (float*)((char*)d_ws + mk::WS_Q0); a.out = alt; run_new(0, 5, 0); }
        else if (MK_DEBUG == 11) {
            nv::stage_mixer0(c);
            float* xn_n = (float*)((char*)d_ws + 62 * MiB); float* pj_n = (float*)((char*)d_ws + 70 * MiB); float* oc_n = (float*)((char*)d_ws + 118 * MiB);
            (void)hipMemsetAsync(acc, 0, 512, stream);
            run_new(0, 2, 0);
            hipLaunchKernelGGL(nv::k_rmsnorm, dim3(2048 / 4), dim3(256), 0, stream, c.x, c.mixer_norm, xn_n, 2048);
            { nv::GemmP g{}; g.A = xn_n; g.lda = 1024; g.B = c.ret_w_in; g.ldb = 6144; g.C = pj_n; g.ldc = 6144; g.M = 2048; g.N = 6144; g.K = 1024; g.mode = 0; nv::gemm(stream, g); }
            hipLaunchKernelGGL(nv::k_rotary, dim3(2048 * 1024 / 256), dim3(256), 0, stream, pj_n, 2048);
            hipLaunchKernelGGL(dbg::k_cmp_bf, dim3(512), dim3(256), 0, stream, (const unsigned short*)((char*)d_ws + mk::WS_Q0), (const float*)pj_n, 6144, 0, 0, acc);
            hipLaunchKernelGGL(dbg::k_cmp_bf, dim3(512), dim3(256), 0, stream, (const unsigned short*)((char*)d_ws + mk::WS_K0), (const float*)pj_n, 6144, 1024, 1, acc);
            hipLaunchKernelGGL(dbg::k_cmp_bf, dim3(512), dim3(256), 0, stream, (const unsigned short*)((char*)d_ws + mk::WS_V0), (const float*)pj_n, 6144, 2048, 2, acc);
            run_new(2, 3, 0);
            hipLaunchKernelGGL(nv::k_retention, dim3(64, 4, 1), dim3(256), 0, stream, (const float*)pj_n, oc_n);
            hipLaunchKernelGGL(dbg::k_cmp_bf, dim3(512), dim3(256), 0, stream, (const unsigned short*)((char*)d_ws + mk::WS_V0), (const float*)oc_n, 2048, 0, 2, acc + 4);
            run_new(3, 4, 0);
            hipLaunchKernelGGL(nv::k_gnorm_gate, dim3(2048), dim3(256), 0, stream, oc_n, (const float*)pj_n, 2048);
            hipLaunchKernelGGL(dbg::k_cmp_bf, dim3(512), dim3(256), 0, stream, (const unsigned short*)((char*)d_ws + mk::WS_V0), (const float*)oc_n, 2048, 0, 2, acc + 8);
            hipLaunchKernelGGL(dbg::k_code3, dim3(1), dim3(1), 0, stream, (const unsigned long long*)acc, scl);
            nv::stage_moe(c, 0); nv::stage_mixer1(c); nv::stage_moe(c, 1);
            hipLaunchKernelGGL(dbg::k_scale, dim3(1024), dim3(256), 0, stream, dout, (const float*)scl, nall);
            hipLaunchKernelGGL(dbg::k_spike, dim3(1), dim3(1), 0, stream, dout, (const float*)scl);
            return;
        }
        else if (MK_DEBUG == 12) {
            nv::stage_mixer0(c);
            float* xn_n = (float*)((char*)d_ws + 62 * MiB); float* pj_n = (float*)((char*)d_ws + 70 * MiB); float* oc_n = (float*)((char*)d_ws + 118 * MiB);
            (void)hipMemsetAsync(acc, 0, 512, stream);
            run_new(0, 3, 0);
            hipLaunchKernelGGL(nv::k_rmsnorm, dim3(2048 / 4), dim3(256), 0, stream, c.x, c.mixer_norm, xn_n, 2048);
            { nv::GemmP g{}; g.A = xn_n; g.lda = 1024; g.B = c.ret_w_in; g.ldb = 6144; g.C = pj_n; g.ldc = 6144; g.M = 2048; g.N = 6144; g.K = 1024; g.mode = 0; nv::gemm(stream, g); }
            hipLaunchKernelGGL(nv::k_rotary, dim3(2048 * 1024 / 256), dim3(256), 0, stream, pj_n, 2048);
            hipLaunchKernelGGL(nv::k_retention, dim3(64, 4, 1), dim3(256), 0, stream, (const float*)pj_n, oc_n);
            hipLaunchKernelGGL(dbg::k_cmp_bf, dim3(512), dim3(256), 0, stream, (const unsigned short*)((char*)d_ws + mk::WS_V0), (const float*)oc_n, 2048, 0, 2, acc, 0, 64);
            hipLaunchKernelGGL(dbg::k_cmp_bf, dim3(512), dim3(256), 0, stream, (const unsigned short*)((char*)d_ws + mk::WS_V0), (const float*)oc_n, 2048, 0, 2, acc + 4, 64, 128);
            hipLaunchKernelGGL(dbg::k_cmp_bf, dim3(512), dim3(256), 0, stream, (const unsigned short*)((char*)d_ws + mk::WS_V0), (const float*)oc_n, 2048, 0, 2, acc + 8, 128, 2048);
            hipLaunchKernelGGL(dbg::k_code3, dim3(1), dim3(1), 0, stream, (const unsigned long long*)acc, scl);
            nv::stage_moe(c, 0); nv::stage_mixer1(c); nv::stage_moe(c, 1);
            hipLaunchKernelGGL(dbg::k_scale, dim3(1024), dim3(256), 0, stream, dout, (const float*)scl, nall);
            hipLaunchKernelGGL(dbg::k_spike, dim3(1), dim3(1), 0, stream, dout, (const float*)scl);
            return;
        }
        else nv::stage_mixer0(c);
        if (MK_DEBUG == 2) { alt = (float*)((char*)d_ws + 446 * MiB); (void)hipMemcpyAsync(alt, dout, nall * 4, hipMemcpyDeviceToDevice, stream); nv::stage_moe(c, 0); a.out = alt; run_new(5, 10, 0); }
        else if (MK_DEBUG > 2) nv::stage_moe(c, 0);
        if (MK_DEBUG == 3) { alt = (float*)((char*)d_ws + 510 * MiB); ncmp = (size_t)mk::TC * mk::D; (void)hipMemcpyAsync(alt, dout, ncmp * 4, hipMemcpyDeviceToDevice, stream); nv::stage_mixer1(c); a.out = alt; run_new(10, 15, 2); }
        else if (MK_DEBUG > 3) nv::stage_mixer1(c);
        if (MK_DEBUG == 4) { alt = (float*)((char*)d_ws + 446 * MiB); (void)hipMemcpyAsync(alt, dout, nall * 4, hipMemcpyDeviceToDevice, stream); nv::stage_moe(c, 1); a.out = alt; run_new(19, 24, 0); }
        (void)hipMemsetAsync(acc, 0, 512, stream);
        hipLaunchKernelGGL(dbg::k_cmp, dim3(1024), dim3(256), 0, stream, (const float*)dout, (const float*)alt, ncmp, acc);
        hipLaunchKernelGGL(dbg::k_code, dim3(1), dim3(1), 0, stream, (const unsigned long long*)acc, scl);
        if (MK_DEBUG < 2) nv::stage_moe(c, 0);
        if (MK_DEBUG < 3) nv::stage_mixer1(c);
        if (MK_DEBUG < 4) nv::stage_moe(c, 1);
        hipLaunchKernelGGL(dbg::k_scale, dim3(1024), dim3(256), 0, stream, dout, (const float*)scl, nall);
        return;
    }
#endif
#ifdef MK_STAMP
    if (mask == 15) { run_new(0, mk::NPHASE, 1); hipLaunchKernelGGL(stamp_apply, dim3(1024), dim3(256), 0, stream, (float*)d_out, (const float*)((char*)d_ws + mk::WS_CTL) + 200000, (size_t)mk::T * mk::D); return; }
#endif
    if (mask == 15) { run_new(0, mk::NPHASE, MK_SPLIT ? 0 : 1); return; }
#ifdef MK_WITH_NAIVE
    nv::Ctx c; nv::ctx_init(c, d_in, d_out, d_ws, stream);
    if (mask & 1) run_new(0, 5, 0); else nv::stage_mixer0(c);
    if (mask & 2) run_new(5, 10, 0); else nv::stage_moe(c, 0);
    if (mask & 4) run_new(10, 19, 0); else nv::stage_mixer1(c);
    if (mask & 8) run_new(19, 24, 0); else nv::stage_moe(c, 1);
#endif
}
```
